# Optimizing an MI355X kernel written in HIP

```python
import jax, jax.numpy as jnp
from jax import lax
import numpy as np

D_MODEL = 2048
BATCH = 2
SEQ = 4096
DEPTH = 1

PLE_DIM = 256
GRID_W = 64
ATT_HEADS = 8
ATT_KV_HEADS = 2
HEAD_DIM = 128
ROPE_BASE = 10000.0
Q_BLOCK = 128
GLA_HEADS = 4
GLA_DK = 128
GLA_DV = 256
GLA_RANK = 16
GLA_TAU = 16.0
GLA_CHUNK = 64
N_EXPERTS = 32
TOP_K = 4
D_FF = D_MODEL
SWIGLU_LIMIT = 7.0
SWIGLU_ALPHA = 1.702
MOE_BLOCK = 128
ATT_Q = ATT_HEADS * HEAD_DIM
ATT_KV = ATT_KV_HEADS * HEAD_DIM
GLA_K = GLA_HEADS * GLA_DK
GLA_V = GLA_HEADS * GLA_DV
IN_SPLITS = (ATT_Q, ATT_KV, ATT_KV, GLA_K, GLA_K, GLA_V, GLA_V, GLA_RANK, GLA_RANK, D_MODEL, D_MODEL)
IN_WIDTH = ATT_Q + 2 * ATT_KV + 2 * GLA_K + 2 * GLA_V + 2 * GLA_RANK + 2 * D_MODEL
DN_ALPHA = (2 * DEPTH) ** 0.25
DN_BETA = (8 * DEPTH) ** -0.25
LN_EPS = 1e-5
RMS_EPS = 1e-6

kernel_name = "hybrid_gqa_gla_moe_deepnorm_encoder"


def layer_norm(x, g, b):
    xf = x.astype(jnp.float32)
    mu = jnp.mean(xf, -1, keepdims=True)
    var = jnp.mean(jnp.square(xf - mu), -1, keepdims=True)
    return ((xf - mu) * lax.rsqrt(var + LN_EPS) * g + b).astype(x.dtype)


def rms_norm(x, g):
    xf = x.astype(jnp.float32)
    return (xf * lax.rsqrt(jnp.mean(xf * xf, -1, keepdims=True) + RMS_EPS) * g).astype(x.dtype)


def axial_rope(seq_len):
    rows = seq_len // GRID_W
    row = jnp.repeat(jnp.arange(rows), GRID_W)
    col = jnp.tile(jnp.arange(GRID_W), rows)
    n_pairs = HEAD_DIM // 4
    inv_freq = ROPE_BASE ** (-jnp.arange(n_pairs, dtype=jnp.float32) / n_pairs)
    ang = jnp.concatenate([row[:, None] * inv_freq, col[:, None] * inv_freq], -1)
    return jnp.cos(ang), jnp.sin(ang)


def apply_rope(x, cos, sin):
    xf = x.astype(jnp.float32).reshape(*x.shape[:-1], HEAD_DIM // 2, 2)
    x0, x1 = xf[..., 0], xf[..., 1]
    c, s = cos[None, :, None, :], sin[None, :, None, :]
    out = jnp.stack([x0 * c - x1 * s, x0 * s + x1 * c], -1)
    return out.reshape(x.shape).astype(x.dtype)


def axial_gqa(q, k, v, q_scale, k_scale):
    B, S = q.shape[:2]
    cos, sin = axial_rope(S)
    q = apply_rope(rms_norm(q, q_scale), cos, sin)
    k = apply_rope(rms_norm(k, k_scale), cos, sin)
    G = ATT_HEADS // ATT_KV_HEADS
    qblk = jnp.moveaxis(q.reshape(B, S // Q_BLOCK, Q_BLOCK, ATT_KV_HEADS, G, HEAD_DIM), 1, 0)
    scale = HEAD_DIM ** -0.5

    def block(qb):
        s = jnp.einsum('bqhgd,bkhd->bhgqk', qb, k, preferred_element_type=jnp.float32) * scale
        pr = jax.nn.softmax(s, axis=-1)
        return jnp.einsum('bhgqk,bkhd->bqhgd', pr.astype(v.dtype), v)

    o = lax.map(block, qblk)
    return jnp.moveaxis(o, 0, 1).reshape(B, S, ATT_Q)


def gla_scan(q, k, v, log_a):
    B, S, H, dk = q.shape
    dv = v.shape[-1]
    C = GLA_CHUNK
    n = S // C

    def chunks(t):
        return jnp.moveaxis(t.astype(jnp.float32).reshape(B, n, C, H, t.shape[-1]), 1, 0)

    mask = jnp.tril(jnp.ones((C, C), bool))[None, :, :, None, None]

    def step(state, inp):
        qc, kc, vc, ac = inp
        b = jnp.cumsum(ac, axis=1)
        o_inter = jnp.einsum('bihd,bhde->bihe', qc * jnp.exp(b), state)
        rel = jnp.exp(jnp.where(mask, b[:, :, None] - b[:, None], -jnp.inf))
        attn = jnp.sum(qc[:, :, None] * kc[:, None] * rel, -1)
        o_intra = jnp.einsum('bijh,bjhe->bihe', attn, vc)
        b_last = b[:, -1]
        k_dec = kc * jnp.exp(b_last[:, None] - b)
        state = state * jnp.exp(b_last)[..., None] + jnp.einsum('bjhd,bjhe->bhde', k_dec, vc)
        return state, o_inter + o_intra

    state0 = jnp.zeros((B, H, dk, dv), jnp.float32)
    _, o = lax.scan(step, state0, (chunks(q), chunks(k), chunks(v), chunks(log_a)))
    return jnp.moveaxis(o, 0, 1).reshape(B, S, H, dv)


def token_mixer(h, w_in, q_norm, k_norm, w_lr_f, b_lr_f, w_lr_b, b_lr_b, gla_norm, w_br_a, w_br_b, w_o):
    B, S, _ = h.shape
    z = h @ w_in
    split_points = np.cumsum(IN_SPLITS)[:-1].tolist()
    qa, ka, va, qb, kb, vb, og, lrf, lrb, ga, gbm = jnp.split(z, split_points, axis=-1)
    ya = axial_gqa(qa.reshape(B, S, ATT_HEADS, HEAD_DIM), ka.reshape(B, S, ATT_KV_HEADS, HEAD_DIM),
                   va.reshape(B, S, ATT_KV_HEADS, HEAD_DIM), q_norm, k_norm) @ w_br_a
    qb = qb.reshape(B, S, GLA_HEADS, GLA_DK) * (GLA_DK ** -0.5)
    kb = kb.reshape(B, S, GLA_HEADS, GLA_DK)
    vb = vb.reshape(B, S, GLA_HEADS, GLA_DV)
    la_f = (jax.nn.log_sigmoid((lrf @ w_lr_f + b_lr_f).astype(jnp.float32)) / GLA_TAU).reshape(B, S, GLA_HEADS, GLA_DK)
    la_b = (jax.nn.log_sigmoid((lrb @ w_lr_b + b_lr_b).astype(jnp.float32)) / GLA_TAU).reshape(B, S, GLA_HEADS, GLA_DK)
    o_f = gla_scan(qb, kb, vb, la_f)
    o_b = gla_scan(qb[:, ::-1], kb[:, ::-1], vb[:, ::-1], la_b[:, ::-1])[:, ::-1]
    o = rms_norm(o_f + o_b, gla_norm) * jax.nn.silu(og.reshape(B, S, GLA_HEADS, GLA_DV).astype(jnp.float32))
    yb = o.reshape(B, S, GLA_V).astype(h.dtype) @ w_br_b
    m = jax.nn.sigmoid(ga) * ya + jax.nn.sigmoid(gbm) * yb
    return m @ w_o


def moe(h, w_router, b_router, w_up, b_up, w_down, b_down):
    B, S, D = h.shape
    x = h.reshape(-1, D)
    T = x.shape[0]
    logits = (x @ w_router + b_router).astype(jnp.float32)
    top_val, top_idx = lax.top_k(logits, TOP_K)
    gates = jax.nn.softmax(top_val, axis=-1)
    flat_e = top_idx.reshape(-1)
    order = jnp.argsort(flat_e)
    sorted_e = flat_e[order]
    counts = jnp.bincount(flat_e, length=N_EXPERTS)
    padded = (counts + MOE_BLOCK - 1) // MOE_BLOCK * MOE_BLOCK
    group_start = jnp.cumsum(counts) - counts
    padded_end = jnp.cumsum(padded)
    padded_start = padded_end - padded
    dest_sorted = padded_start[sorted_e] + jnp.arange(T * TOP_K) - group_start[sorted_e]
    dest = jnp.zeros_like(dest_sorted).at[order].set(dest_sorted)
    n_rows = T * TOP_K + N_EXPERTS * MOE_BLOCK
    token_of_row = jnp.full((n_rows,), T, jnp.int32).at[dest].set(
        jnp.arange(T * TOP_K, dtype=jnp.int32) // TOP_K)
    x_pad = jnp.concatenate([x, jnp.zeros((1, D), x.dtype)], 0)
    x_rows = x_pad[token_of_row].reshape(n_rows // MOE_BLOCK, MOE_BLOCK, D)
    block_start = jnp.arange(n_rows // MOE_BLOCK) * MOE_BLOCK
    block_e = jnp.clip(jnp.searchsorted(padded_end, block_start, side='right'), 0, N_EXPERTS - 1)

    def expert_block(args):
        xb, e = args
        hu = xb @ w_up[e] + b_up[e]
        g, lin = jnp.split(hu, 2, axis=-1)
        g = jnp.minimum(g, SWIGLU_LIMIT)
        lin = jnp.clip(lin, -SWIGLU_LIMIT, SWIGLU_LIMIT)
        act = g * jax.nn.sigmoid(SWIGLU_ALPHA * g) * (lin + 1.0)
        return act @ w_down[e] + b_down[e]

    y_rows = lax.map(expert_block, (x_rows, block_e)).reshape(n_rows, D)
    y = jnp.einsum('tkd,tk->td', y_rows[dest].reshape(T, TOP_K, D), gates.astype(y_rows.dtype))
    return y.reshape(B, S, D)


def setup_inputs(seed: int = 0) -> dict:
    key = jax.random.key(seed)
    ks = jax.random.split(key, 32)

    def nrm(k, shape, scale):
        return jax.random.normal(k, shape, jnp.float32) * scale

    def gain(k, shape):
        return 1.0 + nrm(k, shape, 0.02)

    L, D = DEPTH, D_MODEL
    return {
        "x": nrm(ks[0], (BATCH, SEQ, D), 1.0),
        "p": nrm(ks[1], (DEPTH, BATCH, SEQ, PLE_DIM), 1.0),
        "in_ln_g": gain(ks[2], (D,)),
        "in_ln_b": nrm(ks[3], (D,), 0.02),
        "w_in": nrm(ks[4], (L, D, IN_WIDTH), D ** -0.5),
        "q_norm": gain(ks[5], (L, HEAD_DIM)),
        "k_norm": gain(ks[6], (L, HEAD_DIM)),
        "w_lr_f": nrm(ks[7], (L, GLA_RANK, GLA_K), GLA_RANK ** -0.5),
        "b_lr_f": nrm(ks[8], (L, GLA_K), 0.1),
        "w_lr_b": nrm(ks[9], (L, GLA_RANK, GLA_K), GLA_RANK ** -0.5),
        "b_lr_b": nrm(ks[10], (L, GLA_K), 0.1),
        "gla_norm": gain(ks[11], (L, GLA_DV)),
        "w_br_a": nrm(ks[12], (L, ATT_Q, D), ATT_Q ** -0.5),
        "w_br_b": nrm(ks[13], (L, GLA_V, D), GLA_V ** -0.5),
        "w_o": nrm(ks[14], (L, D, D), D ** -0.5 * DN_BETA),
        "ln1_g": gain(ks[15], (L, D)),
        "ln1_b": nrm(ks[16], (L, D), 0.02),
        "w_router": nrm(ks[17], (L, D, N_EXPERTS), D ** -0.5),
        "b_router": nrm(ks[18], (L, N_EXPERTS), 0.01),
        "w_up": nrm(ks[19], (L, N_EXPERTS, D, 2 * D_FF), D ** -0.5),
        "b_up": nrm(ks[20], (L, N_EXPERTS, 2 * D_FF), 0.02),
        "w_down": nrm(ks[21], (L, N_EXPERTS, D_FF, D), D_FF ** -0.5 * DN_BETA),
        "b_down": nrm(ks[22], (L, N_EXPERTS, D), 0.02),
        "ln2_g": gain(ks[23], (L, D)),
        "ln2_b": nrm(ks[24], (L, D), 0.02),
        "w_ple_gate": nrm(ks[25], (L, D, D), D ** -0.5),
        "w_ple_proj": nrm(ks[26], (L, PLE_DIM, D), PLE_DIM ** -0.5 * DN_BETA),
        "ln3_g": gain(ks[27], (L, D)),
        "ln3_b": nrm(ks[28], (L, D), 0.02),
    }


def reference(x, p, in_ln_g, in_ln_b, w_in, q_norm, k_norm, w_lr_f, b_lr_f, w_lr_b, b_lr_b, gla_norm,
              w_br_a, w_br_b, w_o, ln1_g, ln1_b, w_router, b_router, w_up, b_up, w_down, b_down,
              ln2_g, ln2_b, w_ple_gate, w_ple_proj, ln3_g, ln3_b):
    h = layer_norm(x, in_ln_g, in_ln_b)
    for i in range(DEPTH):
        mix = token_mixer(h, w_in[i], q_norm[i], k_norm[i], w_lr_f[i], b_lr_f[i], w_lr_b[i], b_lr_b[i],
                          gla_norm[i], w_br_a[i], w_br_b[i], w_o[i])
        h = layer_norm(DN_ALPHA * h + mix, ln1_g[i], ln1_b[i])
        h = layer_norm(DN_ALPHA * h + moe(h, w_router[i], b_router[i], w_up[i], b_up[i], w_down[i], b_down[i]),
                       ln2_g[i], ln2_b[i])
        ple = jax.nn.sigmoid(h @ w_ple_gate[i]) * (p[i] @ w_ple_proj[i])
        h = layer_norm(DN_ALPHA * h + ple, ln3_g[i], ln3_b[i])
    return h
```

```cpp
#include <hip/hip_runtime.h>
#include <cstdio>
#include <cstdint>

typedef unsigned short bf16_t;
typedef short bf16x8 __attribute__((ext_vector_type(8)));
typedef float f32x4 __attribute__((ext_vector_type(4)));

constexpr int T = 8192, D = 2048, SEQ = 4096, NB = 2;
constexpr int INW = 8736, PLE = 256, NE = 32, TOPK = 4, CAP = 8192;
constexpr float DN_ALPHA = 1.189207115002721f;
constexpr float LN_EPS = 1e-5f, RMS_EPS = 1e-6f;

constexpr size_t MiB = 1ull << 20;
constexpr size_t WS_CTL = 0;
constexpr size_t WS_H0F = 16 * MiB;
constexpr size_t WS_H0B = WS_H0F + 64 * MiB;
constexpr size_t WS_QAR = WS_H0B + 32 * MiB;
constexpr size_t WS_KAR = WS_QAR + 16 * MiB;
constexpr size_t WS_VA  = WS_KAR + 4 * MiB;
constexpr size_t WS_QB  = WS_VA + 4 * MiB;
constexpr size_t WS_KB  = WS_QB + 8 * MiB;
constexpr size_t WS_VB  = WS_KB + 8 * MiB;
constexpr size_t WS_OG  = WS_VB + 16 * MiB;
constexpr size_t WS_SG  = WS_OG + 16 * MiB;
constexpr size_t WS_LR  = WS_SG + 64 * MiB;
constexpr size_t WS_QA  = WS_LR + 1 * MiB;
constexpr size_t WS_KA  = WS_QA + 16 * MiB;
constexpr size_t WS_BCF = WS_KA + 4 * MiB;
constexpr size_t WS_BCB = WS_BCF + 16 * MiB;
constexpr size_t WS_OF  = WS_BCB + 16 * MiB;
constexpr size_t WS_OB  = WS_OF + 32 * MiB;
constexpr size_t WS_A2  = WS_OB + 32 * MiB;
constexpr size_t WS_M1  = WS_A2 + 32 * MiB;
constexpr size_t WS_MB  = WS_M1 + 64 * MiB;
constexpr size_t WS_PRE1 = WS_MB + 32 * MiB;
constexpr size_t WS_H1F = WS_PRE1 + 64 * MiB;
constexpr size_t WS_DEST = WS_H1F + 64 * MiB;
constexpr size_t WS_GATE = WS_DEST + 1 * MiB;
constexpr size_t WS_H2F = WS_GATE + 1 * MiB;
constexpr size_t WS_H2B = WS_H2F + 64 * MiB;
constexpr size_t WS_PB  = WS_H2B + 32 * MiB;
constexpr size_t WS_PP  = WS_PB + 4 * MiB;
constexpr size_t WS_PRE3 = WS_PP + 64 * MiB;
constexpr size_t WS_XROWS = 1024 * MiB;
constexpr size_t WS_ACT = 2048 * MiB;
constexpr size_t WS_END = 3072 * MiB;
static_assert(WS_PRE3 + 64 * MiB <= WS_XROWS, "ws map");
constexpr int CW_CNT = 1024;

__device__ __forceinline__ float bf2f(bf16_t b) { return __uint_as_float(((unsigned)b) << 16); }
__device__ __forceinline__ bf16_t f2bf(float f) { unsigned u = __float_as_uint(f); u += 0x7fffu + ((u >> 16) & 1u); return (bf16_t)(u >> 16); }
__device__ __forceinline__ float wave_sum(float v) {
#pragma unroll
    for (int o = 1; o < 64; o <<= 1) v += __shfl_xor(v, o);
    return v;
}
__device__ __forceinline__ float sigm(float x) { return 1.f / (1.f + __expf(-x)); }
__device__ __forceinline__ float tof(float x) { return x; }
__device__ __forceinline__ float tof(bf16_t x) { return bf2f(x); }

__device__ __forceinline__ void ln_row(float4 (&v)[8], const float* g, const float* b, int lane) {
    float s = 0.f;
#pragma unroll
    for (int j = 0; j < 8; ++j) s += (v[j].x + v[j].y) + (v[j].z + v[j].w);
    const float mean = wave_sum(s) * (1.f / D);
    float s2 = 0.f;
#pragma unroll
    for (int j = 0; j < 8; ++j) { v[j].x -= mean; v[j].y -= mean; v[j].z -= mean; v[j].w -= mean; s2 += (v[j].x * v[j].x + v[j].y * v[j].y) + (v[j].z * v[j].z + v[j].w * v[j].w); }
    const float rstd = 1.f / sqrtf(wave_sum(s2) * (1.f / D) + LN_EPS);
#pragma unroll
    for (int j = 0; j < 8; ++j) { const float4 gg = ((const float4*)g)[lane + 64 * j], bb = ((const float4*)b)[lane + 64 * j];
        v[j].x = v[j].x * rstd * gg.x + bb.x; v[j].y = v[j].y * rstd * gg.y + bb.y; v[j].z = v[j].z * rstd * gg.z + bb.z; v[j].w = v[j].w * rstd * gg.w + bb.w; }
}
__device__ __forceinline__ void load_row(float4 (&v)[8], const float* p, int lane) {
#pragma unroll
    for (int j = 0; j < 8; ++j) v[j] = ((const float4*)p)[lane + 64 * j];
}
__device__ __forceinline__ void store_row_f32(const float4 (&v)[8], float* p, int lane) {
#pragma unroll
    for (int j = 0; j < 8; ++j) ((float4*)p)[lane + 64 * j] = v[j];
}
__device__ __forceinline__ void store_row_bf16(const float4 (&v)[8], bf16_t* p, int lane) {
#pragma unroll
    for (int j = 0; j < 8; ++j) { uint2 w; w.x = (unsigned)f2bf(v[j].x) | ((unsigned)f2bf(v[j].y) << 16); w.y = (unsigned)f2bf(v[j].z) | ((unsigned)f2bf(v[j].w) << 16);
        ((uint2*)p)[lane + 64 * j] = w; }
}

__global__ __launch_bounds__(256) void k_ln0(const float* x, const float* g, const float* b, float* h0f, bf16_t* h0b) {
    const int lane = threadIdx.x & 63, row = blockIdx.x * 4 + (threadIdx.x >> 6);
    float4 v[8]; load_row(v, x + (size_t)row * D, lane); ln_row(v, g, b, lane);
    store_row_f32(v, h0f + (size_t)row * D, lane); store_row_bf16(v, h0b + (size_t)row * D, lane);
}
__global__ __launch_bounds__(256) void k_cvt(const float* in, bf16_t* out, size_t n) {
    for (size_t i = (size_t)blockIdx.x * 256 + threadIdx.x; i < n; i += (size_t)gridDim.x * 256) out[i] = f2bf(in[i]);
}

template <class AT, class BT, bool BTRANS, bool DUAL, class Epi>
__global__ __launch_bounds__(256) void naive_gemm(const AT* A, size_t lda, size_t sA, const BT* B, size_t ldb, size_t sB, const BT* B2,
                                                  int M, const unsigned* Mdev, int N, int K, Epi epi) {
    __shared__ __attribute__((aligned(16))) bf16_t sa[64][40];
    __shared__ __attribute__((aligned(16))) bf16_t sb[64][40];
    __shared__ __attribute__((aligned(16))) bf16_t sb2[DUAL ? 64 : 1][40];
    const int batch = blockIdx.z;
    if (Mdev) M = (int)Mdev[64 * batch];
    const int m0 = blockIdx.y * 64, n0 = blockIdx.x * 64;
    if (m0 >= M) return;
    A += (size_t)batch * sA; B += (size_t)batch * sB; if (DUAL) B2 += (size_t)batch * sB;
    const int tid = threadIdx.x, w = tid >> 6, lane = tid & 63, fr = lane & 15, fq = lane >> 4;
    f32x4 acc[4], acc2[4];
#pragma unroll
    for (int c = 0; c < 4; ++c) { acc[c] = (f32x4){0.f, 0.f, 0.f, 0.f}; acc2[c] = (f32x4){0.f, 0.f, 0.f, 0.f}; }
    for (int k0 = 0; k0 < K; k0 += 32) {
        { const int r = tid >> 2, c0 = (tid & 3) * 8; const bool ok = (m0 + r) < M;
#pragma unroll
          for (int j = 0; j < 8; ++j) sa[r][c0 + j] = ok ? f2bf(tof(A[(size_t)(m0 + r) * lda + k0 + c0 + j])) : (bf16_t)0; }
        if (BTRANS) { const int r = tid >> 2, c0 = (tid & 3) * 8; const bool ok = (n0 + r) < N;
#pragma unroll
          for (int j = 0; j < 8; ++j) { sb[r][c0 + j] = ok ? f2bf(tof(B[(size_t)(n0 + r) * ldb + k0 + c0 + j])) : (bf16_t)0;
              if (DUAL) sb2[r][c0 + j] = ok ? f2bf(tof(B2[(size_t)(n0 + r) * ldb + k0 + c0 + j])) : (bf16_t)0; } }
        else { const int k = tid >> 3, nc = (tid & 7) * 8;
#pragma unroll
          for (int j = 0; j < 8; ++j) { const bool ok = (n0 + nc + j) < N; sb[nc + j][k] = ok ? f2bf(tof(B[(size_t)(k0 + k) * ldb + n0 + nc + j])) : (bf16_t)0;
              if (DUAL) sb2[nc + j][k] = ok ? f2bf(tof(B2[(size_t)(k0 + k) * ldb + n0 + nc + j])) : (bf16_t)0; } }
        __syncthreads();
        const bf16x8 a = *(const bf16x8*)&sa[16 * w + fr][8 * fq];
#pragma unroll
        for (int c = 0; c < 4; ++c) { const bf16x8 b = *(const bf16x8*)&sb[16 * c + fr][8 * fq];
            acc[c] = __builtin_amdgcn_mfma_f32_16x16x32_bf16(a, b, acc[c], 0, 0, 0);
            if (DUAL) { const bf16x8 b2 = *(const bf16x8*)&sb2[16 * c + fr][8 * fq]; acc2[c] = __builtin_amdgcn_mfma_f32_16x16x32_bf16(a, b2, acc2[c], 0, 0, 0); } }
        __syncthreads();
    }
#pragma unroll
    for (int c = 0; c < 4; ++c)
#pragma unroll
        for (int j = 0; j < 4; ++j) { const int row = m0 + 16 * w + 4 * fq + j, col = n0 + 16 * c + fr;
            if (row < M && col < N) epi(row, col, acc[c][j], acc2[c][j], batch); }
}

struct EpiInproj { bf16_t *qar, *kar, *va, *qb, *kb, *vb, *og, *sg; float* lr;
    __device__ void operator()(int row, int col, float v, float, int) const {
        const size_t r = (size_t)row;
        if (col < 1024) qar[r * 1024 + col] = f2bf(v);
        else if (col < 1280) kar[r * 256 + col - 1024] = f2bf(v);
        else if (col < 1536) va[r * 256 + col - 1280] = f2bf(v);
        else if (col < 2048) qb[r * 512 + col - 1536] = f2bf(v);
        else if (col < 2560) kb[r * 512 + col - 2048] = f2bf(v);
        else if (col < 3584) vb[r * 1024 + col - 2560] = f2bf(v);
        else if (col < 4608) og[r * 1024 + col - 3584] = f2bf(v);
        else if (col < 4640) lr[r * 32 + col - 4608] = v;
        else if (col < 6688) sg[r * 4096 + col - 4640] = f2bf(sigm(v));
        else sg[r * 4096 + 2048 + col - 6688] = f2bf(sigm(v));
    } };

__global__ __launch_bounds__(256) void k_qkprep(const bf16_t* qar, const bf16_t* kar, const float* qn, const float* kn, bf16_t* qa, bf16_t* ka) {
    const int lane = threadIdx.x & 63, gw = blockIdx.x * 4 + (threadIdx.x >> 6), t = gw / 10, hd = gw % 10;
    const bf16_t* src; bf16_t* dst; const float* gn;
    if (hd < 8) { src = qar + (size_t)t * 1024 + hd * 128; dst = qa + (size_t)t * 1024 + hd * 128; gn = qn; }
    else { src = kar + (size_t)t * 256 + (hd - 8) * 128; dst = ka + (size_t)t * 256 + (hd - 8) * 128; gn = kn; }
    const unsigned pr = ((const unsigned*)src)[lane];
    float x0 = bf2f((bf16_t)(pr & 0xffff)), x1 = bf2f((bf16_t)(pr >> 16));
    const float ss = wave_sum(x0 * x0 + x1 * x1), r = 1.f / sqrtf(ss * (1.f / 128.f) + RMS_EPS);
    x0 = x0 * r * gn[2 * lane]; x1 = x1 * r * gn[2 * lane + 1];
    const int s = t & (SEQ - 1), pos = (lane < 32) ? (s >> 6) : (s & 63);
    const float invf = exp2f(-(float)(lane & 31) * (13.287712379549449f / 32.f));
    float rev = (float)pos * invf * 0.15915494309189535f; rev -= floorf(rev);
    const float sn = __builtin_amdgcn_sinf(rev), cs = __builtin_amdgcn_cosf(rev);
    const float o0 = x0 * cs - x1 * sn, o1 = x0 * sn + x1 * cs;
    ((unsigned*)dst)[lane] = (unsigned)f2bf(o0) | ((unsigned)f2bf(o1) << 16);
}

__device__ __forceinline__ float logsig(float x) { return fminf(x, 0.f) - __logf(1.f + __expf(-fabsf(x))); }
__global__ __launch_bounds__(256) void k_glacum(const float* lr, const float* wf, const float* bfv, const float* wb, const float* bbv, float* bcf, float* bcb) {
    __shared__ float lrs[128][32];
    const int h = blockIdx.x & 3, ck = blockIdx.x >> 2, t0 = ck * 128, tid = threadIdx.x, dir = tid >> 7, d = tid & 127, ch = h * 128 + d;
    for (int i = tid; i < 128 * 32; i += 256) lrs[i >> 5][i & 31] = lr[(size_t)t0 * 32 + i];
    float w[16]; const float* W = dir ? wb : wf;
#pragma unroll
    for (int r = 0; r < 16; ++r) w[r] = W[r * 512 + ch];
    const float bias = dir ? bbv[ch] : bfv[ch];
    __syncthreads();
    float acc = 0.f; float* out = dir ? bcb : bcf;
    for (int ii = 0; ii < 128; ++ii) { const int i = dir ? 127 - ii : ii; float x = bias;
#pragma unroll
        for (int r = 0; r < 16; ++r) x += lrs[i][dir * 16 + r] * w[r];
        acc += logsig(x) * (1.f / 16.f); out[(size_t)(t0 + i) * 512 + ch] = acc; }
}
__global__ __launch_bounds__(256) void k_gla_naive(const bf16_t* qb, const bf16_t* kb, const bf16_t* vb, const float* lr, const float* wf, const float* bfv, const float* wb, const float* bbv,
                                                   float* of, float* ob) {
    __shared__ float qs[128], ks[128], dec[128];
    const int dir = blockIdx.x & 1, h = (blockIdx.x >> 1) & 3, b = blockIdx.x >> 3, e = threadIdx.x;
    float w[16]; float bias = 0.f;
    if (e < 128) { const float* W = dir ? wb : wf;
#pragma unroll
        for (int r = 0; r < 16; ++r) w[r] = W[r * 512 + h * 128 + e];
        bias = dir ? bbv[h * 128 + e] : bfv[h * 128 + e]; }
    else {
#pragma unroll
        for (int r = 0; r < 16; ++r) w[r] = 0.f; }
    float S[128];
#pragma unroll
    for (int d = 0; d < 128; ++d) S[d] = 0.f;
    float* out = dir ? ob : of;
    for (int ii = 0; ii < SEQ; ++ii) { const int t = b * SEQ + (dir ? SEQ - 1 - ii : ii);
        if (e < 128) { float x = bias;
#pragma unroll
            for (int r = 0; r < 16; ++r) x += lr[(size_t)t * 32 + dir * 16 + r] * w[r];
            dec[e] = __expf(logsig(x) * (1.f / 16.f));
            qs[e] = bf2f(qb[(size_t)t * 512 + h * 128 + e]) * 0.08838834764831845f; ks[e] = bf2f(kb[(size_t)t * 512 + h * 128 + e]); }
        __syncthreads();
        const float v = bf2f(vb[(size_t)t * 1024 + h * 256 + e]); float o = 0.f;
#pragma unroll
        for (int d = 0; d < 128; ++d) { S[d] = S[d] * dec[d] + ks[d] * v; o += qs[d] * S[d]; }
        out[(size_t)t * 1024 + h * 256 + e] = o;
        __syncthreads(); }
}
__global__ __launch_bounds__(256) void k_gla_combine(const float* of, const float* ob, const bf16_t* og, const float* gn, bf16_t* a2) {
    const int lane = threadIdx.x & 63, gw = blockIdx.x * 4 + (threadIdx.x >> 6), t = gw >> 2, h = gw & 3;
    const size_t base = (size_t)t * 1024 + h * 256 + lane * 4;
    const float4 a = *(const float4*)(of + base), c = *(const float4*)(ob + base);
    float o[4] = {a.x + c.x, a.y + c.y, a.z + c.z, a.w + c.w};
    const float ss = wave_sum(o[0] * o[0] + o[1] * o[1] + o[2] * o[2] + o[3] * o[3]), r = 1.f / sqrtf(ss * (1.f / 256.f) + RMS_EPS);
#pragma unroll
    for (int j = 0; j < 4; ++j) { const float g = bf2f(og[base + j]); a2[(size_t)t * 2048 + 1024 + h * 256 + lane * 4 + j] = f2bf(o[j] * r * gn[lane * 4 + j] * (g * sigm(g))); }
}
struct EpiScores { float* sc; __device__ void operator()(int row, int col, float v, float, int batch) const { sc[((size_t)batch * SEQ + row) * SEQ + col] = v * 0.08838834764831845f; } };
__global__ __launch_bounds__(256) void k_softmax_rows(float* sc) {
    const int lane = threadIdx.x & 63; float* p = sc + ((size_t)blockIdx.x * 4 + (threadIdx.x >> 6)) * SEQ;
    float m = -1e30f; for (int i = lane; i < SEQ; i += 64) m = fmaxf(m, p[i]);
#pragma unroll
    for (int o = 1; o < 64; o <<= 1) m = fmaxf(m, __shfl_xor(m, o));
    float s = 0.f; for (int i = lane; i < SEQ; i += 64) { const float e = __expf(p[i] - m); p[i] = e; s += e; }
    s = 1.f / wave_sum(s); for (int i = lane; i < SEQ; i += 64) p[i] *= s;
}
struct EpiAttnOut { bf16_t* a2; int b, kvh; __device__ void operator()(int row, int col, float v, float, int g) const { a2[((size_t)b * SEQ + row) * 2048 + (kvh * 4 + g) * 128 + col] = f2bf(v); } };
struct EpiYa { const bf16_t* sg; float* m1; __device__ void operator()(int row, int col, float v, float, int) const { m1[(size_t)row * 2048 + col] = bf2f(sg[(size_t)row * 4096 + col]) * v; } };
struct EpiYb { const bf16_t* sg; const float* m1; bf16_t* mb; __device__ void operator()(int row, int col, float v, float, int) const {
    mb[(size_t)row * 2048 + col] = f2bf(m1[(size_t)row * 2048 + col] + bf2f(sg[(size_t)row * 4096 + 2048 + col]) * v); } };
struct EpiRes { const float* base; float* out; __device__ void operator()(int row, int col, float v, float, int) const { const size_t i = (size_t)row * 2048 + col; out[i] = DN_ALPHA * base[i] + v; } };

__global__ __launch_bounds__(256) void k_ln1_router(const float* pre1, const float* g, const float* b, const float* wr, const float* br, float* h1f, bf16_t* xrows,
                                                    int* dest, float* gate, unsigned* ctl) {
    const int lane = threadIdx.x & 63, row = blockIdx.x * 4 + (threadIdx.x >> 6);
    float4 v[8]; load_row(v, pre1 + (size_t)row * D, lane); ln_row(v, g, b, lane); store_row_f32(v, h1f + (size_t)row * D, lane);
    float mylogit = -1e30f;
    for (int e = 0; e < NE; ++e) { float s = 0.f;
#pragma unroll
        for (int j = 0; j < 8; ++j) { const int d0 = (lane + 64 * j) * 4; s += v[j].x * wr[(d0 + 0) * NE + e] + v[j].y * wr[(d0 + 1) * NE + e] + v[j].z * wr[(d0 + 2) * NE + e] + v[j].w * wr[(d0 + 3) * NE + e]; }
        s = wave_sum(s) + br[e]; if (lane == e) mylogit = s; }
    float tv[4]; int ti[4]; float cur = mylogit;
#pragma unroll
    for (int k = 0; k < 4; ++k) { float bv = cur; int bi = lane;
#pragma unroll
        for (int o = 1; o < 64; o <<= 1) { const float ov = __shfl_xor(bv, o); const int oi = __shfl_xor(bi, o); if (ov > bv || (ov == bv && oi < bi)) { bv = ov; bi = oi; } }
        tv[k] = bv; ti[k] = bi; if (lane == bi) cur = -1e30f; }
    float ge[4], gs = 0.f;
#pragma unroll
    for (int k = 0; k < 4; ++k) { ge[k] = __expf(tv[k] - tv[0]); gs += ge[k]; }
    int dst[4];
#pragma unroll
    for (int k = 0; k < 4; ++k) { unsigned slot = 0; if (lane == 0) slot = __hip_atomic_fetch_add(ctl + CW_CNT + 64 * ti[k], 1u, __ATOMIC_RELAXED, __HIP_MEMORY_SCOPE_AGENT);
        slot = __shfl(slot, 0); dst[k] = ti[k] * CAP + (int)slot; }
    if (lane < 4) { const int k = lane; int dd = dst[0]; float gg = ge[0];
        if (k == 1) { dd = dst[1]; gg = ge[1]; } if (k == 2) { dd = dst[2]; gg = ge[2]; } if (k == 3) { dd = dst[3]; gg = ge[3]; }
        dest[row * 4 + k] = dd; gate[row * 4 + k] = gg / gs; }
#pragma unroll
    for (int k = 0; k < 4; ++k) store_row_bf16(v, xrows + (size_t)dst[k] * D, lane);
}
struct EpiUp { const float* bup; bf16_t* act; __device__ void operator()(int row, int col, float g, float lin, int e) const {
    g += bup[e * 4096 + col]; lin += bup[e * 4096 + 2048 + col]; g = fminf(g, 7.f); lin = fminf(fmaxf(lin, -7.f), 7.f);
    act[((size_t)e * CAP + row) * 2048 + col] = f2bf(g * sigm(1.702f * g) * (lin + 1.f)); } };
struct EpiDown { const float* bdn; bf16_t* y; __device__ void operator()(int row, int col, float v, float, int e) const { y[((size_t)e * CAP + row) * 2048 + col] = f2bf(v + bdn[e * 2048 + col]); } };
__global__ __launch_bounds__(256) void k_combine_ln2(const float* h1f, const bf16_t* y, const int* dest, const float* gate, const float* g, const float* b, float* h2f, bf16_t* h2b) {
    const int lane = threadIdx.x & 63, row = blockIdx.x * 4 + (threadIdx.x >> 6);
    float4 v[8]; load_row(v, h1f + (size_t)row * D, lane);
#pragma unroll
    for (int j = 0; j < 8; ++j) { v[j].x *= DN_ALPHA; v[j].y *= DN_ALPHA; v[j].z *= DN_ALPHA; v[j].w *= DN_ALPHA; }
    for (int k = 0; k < 4; ++k) { const bf16_t* yr = y + (size_t)dest[row * 4 + k] * D; const float gk = gate[row * 4 + k];
#pragma unroll
        for (int j = 0; j < 8; ++j) { const uint2 w = ((const uint2*)yr)[lane + 64 * j];
            v[j].x += gk * bf2f((bf16_t)(w.x & 0xffff)); v[j].y += gk * bf2f((bf16_t)(w.x >> 16)); v[j].z += gk * bf2f((bf16_t)(w.y & 0xffff)); v[j].w += gk * bf2f((bf16_t)(w.y >> 16)); } }
    ln_row(v, g, b, lane); store_row_f32(v, h2f + (size_t)row * D, lane); store_row_bf16(v, h2b + (size_t)row * D, lane);
}
struct EpiF32 { float* out; __device__ void operator()(int row, int col, float v, float, int) const { out[(size_t)row * 2048 + col] = v; } };
struct EpiPle { const float* h2f; const float* pp; float* out; __device__ void operator()(int row, int col, float v, float, int) const { const size_t i = (size_t)row * 2048 + col; out[i] = DN_ALPHA * h2f[i] + sigm(v) * pp[i]; } };
__global__ __launch_bounds__(256) void k_ln_out(const float* in, const float* g, const float* b, float* out) {
    const int lane = threadIdx.x & 63, row = blockIdx.x * 4 + (threadIdx.x >> 6);
    float4 v[8]; load_row(v, in + (size_t)row * D, lane); ln_row(v, g, b, lane); store_row_f32(v, out + (size_t)row * D, lane);
}

extern "C" void kernel_launch(void* const* d_in, const int* in_sizes, int n_in, void* d_out, int out_size, void* d_ws, size_t ws_size, hipStream_t stream) {
    if (n_in != 29 || ws_size < WS_END) { fprintf(stderr, "kernel_launch: unexpected n_in %d or ws %zu < %zu\n", n_in, ws_size, (size_t)WS_END); return; }
    const float* x = (const float*)d_in[0]; const float* p = (const float*)d_in[1];
    const float *in_g = (const float*)d_in[2], *in_b = (const float*)d_in[3], *w_in = (const float*)d_in[4], *qn = (const float*)d_in[5], *kn = (const float*)d_in[6];
    const float *wlf = (const float*)d_in[7], *blf = (const float*)d_in[8], *wlb = (const float*)d_in[9], *blb = (const float*)d_in[10], *gn = (const float*)d_in[11];
    const float *wba = (const float*)d_in[12], *wbb = (const float*)d_in[13], *wo = (const float*)d_in[14], *l1g = (const float*)d_in[15], *l1b = (const float*)d_in[16];
    const float *wr = (const float*)d_in[17], *br = (const float*)d_in[18], *wup = (const float*)d_in[19], *bup = (const float*)d_in[20], *wdn = (const float*)d_in[21], *bdn = (const float*)d_in[22];
    const float *l2g = (const float*)d_in[23], *l2b = (const float*)d_in[24], *wpg = (const float*)d_in[25], *wpp = (const float*)d_in[26], *l3g = (const float*)d_in[27], *l3b = (const float*)d_in[28];
    char* ws = (char*)d_ws; float* out = (float*)d_out;
    unsigned* ctl = (unsigned*)(ws + WS_CTL);
    float* H0F = (float*)(ws + WS_H0F); bf16_t* H0B = (bf16_t*)(ws + WS_H0B);
    bf16_t *QAR = (bf16_t*)(ws + WS_QAR), *KAR = (bf16_t*)(ws + WS_KAR), *VA = (bf16_t*)(ws + WS_VA), *QB = (bf16_t*)(ws + WS_QB), *KB = (bf16_t*)(ws + WS_KB), *VB = (bf16_t*)(ws + WS_VB);
    bf16_t *OG = (bf16_t*)(ws + WS_OG), *SG = (bf16_t*)(ws + WS_SG), *QA = (bf16_t*)(ws + WS_QA), *KA = (bf16_t*)(ws + WS_KA), *A2 = (bf16_t*)(ws + WS_A2), *MB = (bf16_t*)(ws + WS_MB);
    float *LR = (float*)(ws + WS_LR), *BCF = (float*)(ws + WS_BCF), *BCB = (float*)(ws + WS_BCB), *OF = (float*)(ws + WS_OF), *OB = (float*)(ws + WS_OB), *M1 = (float*)(ws + WS_M1);
    float *PRE1 = (float*)(ws + WS_PRE1), *H1F = (float*)(ws + WS_H1F), *GATE = (float*)(ws + WS_GATE), *H2F = (float*)(ws + WS_H2F), *PP = (float*)(ws + WS_PP), *PRE3 = (float*)(ws + WS_PRE3);
    int* DEST = (int*)(ws + WS_DEST); bf16_t *H2B = (bf16_t*)(ws + WS_H2B), *PB = (bf16_t*)(ws + WS_PB), *XROWS = (bf16_t*)(ws + WS_XROWS), *YROWS = (bf16_t*)(ws + WS_XROWS), *ACT = (bf16_t*)(ws + WS_ACT);
    float* SC = (float*)(ws + WS_ACT);

    hipMemsetAsync(ws + WS_CTL, 0, 1 * MiB, stream);
    hipLaunchKernelGGL(k_ln0, dim3(T / 4), dim3(256), 0, stream, x, in_g, in_b, H0F, H0B);
    hipLaunchKernelGGL(k_cvt, dim3(2048), dim3(256), 0, stream, p, PB, (size_t)T * PLE);
    { EpiInproj e{QAR, KAR, VA, QB, KB, VB, OG, SG, LR};
      hipLaunchKernelGGL((naive_gemm<bf16_t, float, false, false, EpiInproj>), dim3((INW + 63) / 64, T / 64, 1), dim3(256), 0, stream, H0B, (size_t)D, (size_t)0, w_in, (size_t)INW, (size_t)0, (const float*)nullptr, T, (const unsigned*)nullptr, INW, D, e); }
    hipLaunchKernelGGL(k_qkprep, dim3(T * 10 / 4), dim3(256), 0, stream, QAR, KAR, qn, kn, QA, KA);
    hipLaunchKernelGGL(k_glacum, dim3(NB * 32 * 4), dim3(256), 0, stream, LR, wlf, blf, wlb, blb, BCF, BCB);
    for (int b = 0; b < NB; ++b) for (int kvh = 0; kvh < 2; ++kvh) {
        EpiScores es{SC + (size_t)(b * 8 + kvh * 4) * SEQ * SEQ};
        hipLaunchKernelGGL((naive_gemm<bf16_t, bf16_t, true, false, EpiScores>), dim3(SEQ / 64, SEQ / 64, 4), dim3(256), 0, stream, QA + (size_t)b * SEQ * 1024 + kvh * 4 * 128, (size_t)1024, (size_t)128,
                           KA + (size_t)b * SEQ * 256 + kvh * 128, (size_t)256, (size_t)0, (const bf16_t*)nullptr, SEQ, (const unsigned*)nullptr, SEQ, 128, es); }
    hipLaunchKernelGGL(k_softmax_rows, dim3(16 * SEQ / 4), dim3(256), 0, stream, SC);
    for (int b = 0; b < NB; ++b) for (int kvh = 0; kvh < 2; ++kvh) {
        EpiAttnOut eo{A2, b, kvh};
        hipLaunchKernelGGL((naive_gemm<float, bf16_t, false, false, EpiAttnOut>), dim3(128 / 64, SEQ / 64, 4), dim3(256), 0, stream, SC + (size_t)(b * 8 + kvh * 4) * SEQ * SEQ, (size_t)SEQ, (size_t)SEQ * SEQ,
                           VA + (size_t)b * SEQ * 256 + kvh * 128, (size_t)256, (size_t)0, (const bf16_t*)nullptr, SEQ, (const unsigned*)nullptr, 128, SEQ, eo); }
    hipLaunchKernelGGL(k_gla_naive, dim3(16), dim3(256), 0, stream, QB, KB, VB, LR, wlf, blf, wlb, blb, OF, OB);
    hipLaunchKernelGGL(k_gla_combine, dim3(T * 4 / 4), dim3(256), 0, stream, OF, OB, OG, gn, A2);
    { EpiYa e{SG, M1}; hipLaunchKernelGGL((naive_gemm<bf16_t, float, false, false, EpiYa>), dim3(D / 64, T / 64, 1), dim3(256), 0, stream, A2, (size_t)2048, (size_t)0, wba, (size_t)D, (size_t)0, (const float*)nullptr, T, (const unsigned*)nullptr, D, 1024, e); }
    { EpiYb e{SG, M1, MB}; hipLaunchKernelGGL((naive_gemm<bf16_t, float, false, false, EpiYb>), dim3(D / 64, T / 64, 1), dim3(256), 0, stream, A2 + 1024, (size_t)2048, (size_t)0, wbb, (size_t)D, (size_t)0, (const float*)nullptr, T, (const unsigned*)nullptr, D, 1024, e); }
    { EpiRes e{H0F, PRE1}; hipLaunchKernelGGL((naive_gemm<bf16_t, float, false, false, EpiRes>), dim3(D / 64, T / 64, 1), dim3(256), 0, stream, MB, (size_t)D, (size_t)0, wo, (size_t)D, (size_t)0, (const float*)nullptr, T, (const unsigned*)nullptr, D, D, e); }
    hipLaunchKernelGGL(k_ln1_router, dim3(T / 4), dim3(256), 0, stream, PRE1, l1g, l1b, wr, br, H1F, XROWS, DEST, GATE, ctl);
    { EpiUp e{bup, ACT}; hipLaunchKernelGGL((naive_gemm<bf16_t, float, false, true, EpiUp>), dim3(2048 / 64, CAP / 64, NE), dim3(256), 0, stream, XROWS, (size_t)D, (size_t)CAP * D, wup, (size_t)4096, (size_t)D * 4096, wup + 2048, CAP, (const unsigned*)(ctl + CW_CNT), 2048, D, e); }
    { EpiDown e{bdn, YROWS}; hipLaunchKernelGGL((naive_gemm<bf16_t, float, false, false, EpiDown>), dim3(2048 / 64, CAP / 64, NE), dim3(256), 0, stream, ACT, (size_t)D, (size_t)CAP * D, wdn, (size_t)D, (size_t)D * D, (const float*)nullptr, CAP, (const unsigned*)(ctl + CW_CNT), D, D, e); }
    hipLaunchKernelGGL(k_combine_ln2, dim3(T / 4), dim3(256), 0, stream, H1F, YROWS, DEST, GATE, l2g, l2b, H2F, H2B);
    { EpiF32 e{PP}; hipLaunchKernelGGL((naive_gemm<bf16_t, float, false, false, EpiF32>), dim3(D / 64, T / 64, 1), dim3(256), 0, stream, PB, (size_t)PLE, (size_t)0, wpp, (size_t)D, (size_t)0, (const float*)nullptr, T, (const unsigned*)nullptr, D, PLE, e); }
    { EpiPle e{H2F, PP, PRE3}; hipLaunchKernelGGL((naive_gemm<bf16_t, float, false, false, EpiPle>), dim3(D / 64, T / 64, 1), dim3(256), 0, stream, H2B, (size_t)D, (size_t)0, wpg, (size_t)D, (size_t)0, (const float*)nullptr, T, (const unsigned*)nullptr, D, D, e); }
    hipLaunchKernelGGL(k_ln_out, dim3(T / 4), dim3(256), 0, stream, PRE3, l3g, l3b, out);
}
```

```cpp
#include <hip/hip_runtime.h>
#include <cstdio>
#include <cstdint>
#ifndef FAST_MASK
#define FAST_MASK 32767
#endif

typedef unsigned short bf16_t;
typedef short bf16x8 __attribute__((ext_vector_type(8)));
typedef float f32x4 __attribute__((ext_vector_type(4)));

constexpr int T = 8192, D = 2048, SEQ = 4096, NB = 2;
constexpr int INW = 8736, PLE = 256, NE = 32, TOPK = 4, CAP = 8192;
constexpr float DN_ALPHA = 1.189207115002721f;
constexpr float LN_EPS = 1e-5f, RMS_EPS = 1e-6f;

constexpr size_t MiB = 1ull << 20;
constexpr size_t WS_CTL = 0;
constexpr size_t WS_H0F = 16 * MiB;
constexpr size_t WS_H0B = WS_H0F + 64 * MiB;
constexpr size_t WS_QAR = WS_H0B + 32 * MiB;
constexpr size_t WS_KAR = WS_QAR + 16 * MiB;
constexpr size_t WS_VA  = WS_KAR + 4 * MiB;
constexpr size_t WS_QB  = WS_VA + 4 * MiB;
constexpr size_t WS_KB  = WS_QB + 8 * MiB;
constexpr size_t WS_VB  = WS_KB + 8 * MiB;
constexpr size_t WS_OG  = WS_VB + 16 * MiB;
constexpr size_t WS_SG  = WS_OG + 16 * MiB;
constexpr size_t WS_LR  = WS_SG + 64 * MiB;
constexpr size_t WS_QA  = WS_LR + 1 * MiB;
constexpr size_t WS_KA  = WS_QA + 16 * MiB;
constexpr size_t WS_BCF = WS_KA + 4 * MiB;
constexpr size_t WS_BCB = WS_BCF + 16 * MiB;
constexpr size_t WS_OF  = WS_BCB + 16 * MiB;
constexpr size_t WS_OB  = WS_OF + 32 * MiB;
constexpr size_t WS_A2  = WS_OB + 32 * MiB;
constexpr size_t WS_M1  = WS_A2 + 32 * MiB;
constexpr size_t WS_MB  = WS_M1 + 64 * MiB;
constexpr size_t WS_PRE1 = WS_MB + 32 * MiB;
constexpr size_t WS_H1F = WS_PRE1 + 64 * MiB;
constexpr size_t WS_DEST = WS_H1F + 64 * MiB;
constexpr size_t WS_GATE = WS_DEST + 1 * MiB;
constexpr size_t WS_H2F = WS_GATE + 1 * MiB;
constexpr size_t WS_H2B = WS_H2F + 64 * MiB;
constexpr size_t WS_PB  = WS_H2B + 32 * MiB;
constexpr size_t WS_PP  = WS_PB + 4 * MiB;
constexpr size_t WS_PRE3 = WS_PP + 64 * MiB;
constexpr size_t WS_XROWS = 1024 * MiB;
constexpr size_t WS_ACT = 2048 * MiB;
constexpr size_t WS_END = 3072 * MiB;
static_assert(WS_PRE3 + 64 * MiB <= WS_XROWS, "ws map");
constexpr int CW_CNT = 1024;

__device__ __forceinline__ float bf2f(bf16_t b) { return __uint_as_float(((unsigned)b) << 16); }
__device__ __forceinline__ bf16_t f2bf(float f) { unsigned u = __float_as_uint(f); u += 0x7fffu + ((u >> 16) & 1u); return (bf16_t)(u >> 16); }
__device__ __forceinline__ float wave_sum(float v) {
#pragma unroll
    for (int o = 1; o < 64; o <<= 1) v += __shfl_xor(v, o);
    return v;
}
__device__ __forceinline__ float sigm(float x) { return 1.f / (1.f + __expf(-x)); }
__device__ __forceinline__ float tof(float x) { return x; }
__device__ __forceinline__ float tof(bf16_t x) { return bf2f(x); }

__device__ __forceinline__ void ln_row(float4 (&v)[8], const float* g, const float* b, int lane) {
    float s = 0.f;
#pragma unroll
    for (int j = 0; j < 8; ++j) s += (v[j].x + v[j].y) + (v[j].z + v[j].w);
    const float mean = wave_sum(s) * (1.f / D);
    float s2 = 0.f;
#pragma unroll
    for (int j = 0; j < 8; ++j) { v[j].x -= mean; v[j].y -= mean; v[j].z -= mean; v[j].w -= mean; s2 += (v[j].x * v[j].x + v[j].y * v[j].y) + (v[j].z * v[j].z + v[j].w * v[j].w); }
    const float rstd = 1.f / sqrtf(wave_sum(s2) * (1.f / D) + LN_EPS);
#pragma unroll
    for (int j = 0; j < 8; ++j) { const float4 gg = ((const float4*)g)[lane + 64 * j], bb = ((const float4*)b)[lane + 64 * j];
        v[j].x = v[j].x * rstd * gg.x + bb.x; v[j].y = v[j].y * rstd * gg.y + bb.y; v[j].z = v[j].z * rstd * gg.z + bb.z; v[j].w = v[j].w * rstd * gg.w + bb.w; }
}
__device__ __forceinline__ void ln_row_lowreg(float4 (&v)[8], const float* g, const float* b, int lane) {
    float s = 0.f;
#pragma unroll
    for (int j = 0; j < 8; ++j) s += (v[j].x + v[j].y) + (v[j].z + v[j].w);
    const float mean = wave_sum(s) * (1.f / D);
    float s2 = 0.f;
#pragma unroll
    for (int j = 0; j < 8; ++j) { v[j].x -= mean; v[j].y -= mean; v[j].z -= mean; v[j].w -= mean; s2 += (v[j].x * v[j].x + v[j].y * v[j].y) + (v[j].z * v[j].z + v[j].w * v[j].w); }
    const float rstd = 1.f / sqrtf(wave_sum(s2) * (1.f / D) + LN_EPS);
#pragma unroll
    for (int j = 0; j < 8; ++j) { const float4 gg = ((const float4*)g)[lane + 64 * j], bb = ((const float4*)b)[lane + 64 * j];
        v[j].x = v[j].x * rstd * gg.x + bb.x; v[j].y = v[j].y * rstd * gg.y + bb.y; v[j].z = v[j].z * rstd * gg.z + bb.z; v[j].w = v[j].w * rstd * gg.w + bb.w;
        asm volatile("" ::: "memory"); }
}
__device__ __forceinline__ void load_row(float4 (&v)[8], const float* p, int lane) {
#pragma unroll
    for (int j = 0; j < 8; ++j) v[j] = ((const float4*)p)[lane + 64 * j];
}
__device__ __forceinline__ void store_row_f32(const float4 (&v)[8], float* p, int lane) {
#pragma unroll
    for (int j = 0; j < 8; ++j) ((float4*)p)[lane + 64 * j] = v[j];
}
__device__ __forceinline__ void store_row_bf16(const float4 (&v)[8], bf16_t* p, int lane) {
#pragma unroll
    for (int j = 0; j < 8; ++j) { uint2 w; w.x = (unsigned)f2bf(v[j].x) | ((unsigned)f2bf(v[j].y) << 16); w.y = (unsigned)f2bf(v[j].z) | ((unsigned)f2bf(v[j].w) << 16);
        ((uint2*)p)[lane + 64 * j] = w; }
}

__global__ __launch_bounds__(256) void k_ln0(const float* x, const float* g, const float* b, float* h0f, bf16_t* h0b) {
    const int lane = threadIdx.x & 63, row = blockIdx.x * 4 + (threadIdx.x >> 6);
    float4 v[8]; load_row(v, x + (size_t)row * D, lane); ln_row(v, g, b, lane);
    store_row_f32(v, h0f + (size_t)row * D, lane); store_row_bf16(v, h0b + (size_t)row * D, lane);
}
__global__ __launch_bounds__(256) void k_cvt(const float* in, bf16_t* out, size_t n) {
    for (size_t i = (size_t)blockIdx.x * 256 + threadIdx.x; i < n; i += (size_t)gridDim.x * 256) out[i] = f2bf(in[i]);
}

template <class AT, class BT, bool BTRANS, bool DUAL, class Epi>
__global__ __launch_bounds__(256) void naive_gemm(const AT* A, size_t lda, size_t sA, const BT* B, size_t ldb, size_t sB, const BT* B2,
                                                  int M, const unsigned* Mdev, int N, int K, Epi epi) {
    __shared__ __attribute__((aligned(16))) bf16_t sa[64][40];
    __shared__ __attribute__((aligned(16))) bf16_t sb[64][40];
    __shared__ __attribute__((aligned(16))) bf16_t sb2[DUAL ? 64 : 1][40];
    const int batch = blockIdx.z;
    if (Mdev) M = (int)Mdev[64 * batch];
    const int m0 = blockIdx.y * 64, n0 = blockIdx.x * 64;
    if (m0 >= M) return;
    A += (size_t)batch * sA; B += (size_t)batch * sB; if (DUAL) B2 += (size_t)batch * sB;
    const int tid = threadIdx.x, w = tid >> 6, lane = tid & 63, fr = lane & 15, fq = lane >> 4;
    f32x4 acc[4], acc2[4];
#pragma unroll
    for (int c = 0; c < 4; ++c) { acc[c] = (f32x4){0.f, 0.f, 0.f, 0.f}; acc2[c] = (f32x4){0.f, 0.f, 0.f, 0.f}; }
    for (int k0 = 0; k0 < K; k0 += 32) {
        { const int r = tid >> 2, c0 = (tid & 3) * 8; const bool ok = (m0 + r) < M;
#pragma unroll
          for (int j = 0; j < 8; ++j) sa[r][c0 + j] = ok ? f2bf(tof(A[(size_t)(m0 + r) * lda + k0 + c0 + j])) : (bf16_t)0; }
        if (BTRANS) { const int r = tid >> 2, c0 = (tid & 3) * 8; const bool ok = (n0 + r) < N;
#pragma unroll
          for (int j = 0; j < 8; ++j) { sb[r][c0 + j] = ok ? f2bf(tof(B[(size_t)(n0 + r) * ldb + k0 + c0 + j])) : (bf16_t)0;
              if (DUAL) sb2[r][c0 + j] = ok ? f2bf(tof(B2[(size_t)(n0 + r) * ldb + k0 + c0 + j])) : (bf16_t)0; } }
        else { const int k = tid >> 3, nc = (tid & 7) * 8;
#pragma unroll
          for (int j = 0; j < 8; ++j) { const bool ok = (n0 + nc + j) < N; sb[nc + j][k] = ok ? f2bf(tof(B[(size_t)(k0 + k) * ldb + n0 + nc + j])) : (bf16_t)0;
              if (DUAL) sb2[nc + j][k] = ok ? f2bf(tof(B2[(size_t)(k0 + k) * ldb + n0 + nc + j])) : (bf16_t)0; } }
        __syncthreads();
        const bf16x8 a = *(const bf16x8*)&sa[16 * w + fr][8 * fq];
#pragma unroll
        for (int c = 0; c < 4; ++c) { const bf16x8 b = *(const bf16x8*)&sb[16 * c + fr][8 * fq];
            acc[c] = __builtin_amdgcn_mfma_f32_16x16x32_bf16(a, b, acc[c], 0, 0, 0);
            if (DUAL) { const bf16x8 b2 = *(const bf16x8*)&sb2[16 * c + fr][8 * fq]; acc2[c] = __builtin_amdgcn_mfma_f32_16x16x32_bf16(a, b2, acc2[c], 0, 0, 0); } }
        __syncthreads();
    }
#pragma unroll
    for (int c = 0; c < 4; ++c)
#pragma unroll
        for (int j = 0; j < 4; ++j) { const int row = m0 + 16 * w + 4 * fq + j, col = n0 + 16 * c + fr;
            if (row < M && col < N) epi(row, col, acc[c][j], acc2[c][j], batch); }
}

struct EpiInproj { bf16_t *qar, *kar, *va, *qb, *kb, *vb, *og, *sg; float* lr;
    __device__ void operator()(int row, int col, float v, float, int) const {
        const size_t r = (size_t)row;
        if (col < 1024) qar[r * 1024 + col] = f2bf(v);
        else if (col < 1280) kar[r * 256 + col - 1024] = f2bf(v);
        else if (col < 1536) va[r * 256 + col - 1280] = f2bf(v);
        else if (col < 2048) qb[r * 512 + col - 1536] = f2bf(v);
        else if (col < 2560) kb[r * 512 + col - 2048] = f2bf(v);
        else if (col < 3584) vb[r * 1024 + col - 2560] = f2bf(v);
        else if (col < 4608) og[r * 1024 + col - 3584] = f2bf(v);
        else if (col < 4640) lr[r * 32 + col - 4608] = v;
        else if (col < 6688) sg[r * 4096 + col - 4640] = f2bf(sigm(v));
        else sg[r * 4096 + 2048 + col - 6688] = f2bf(sigm(v));
    } };

__global__ __launch_bounds__(256) void k_qkprep(const bf16_t* qar, const bf16_t* kar, const float* qn, const float* kn, bf16_t* qa, bf16_t* ka) {
    const int lane = threadIdx.x & 63, gw = blockIdx.x * 4 + (threadIdx.x >> 6), t = gw / 10, hd = gw % 10;
    const bf16_t* src; bf16_t* dst; const float* gn;
    if (hd < 8) { src = qar + (size_t)t * 1024 + hd * 128; dst = qa + (size_t)t * 1024 + hd * 128; gn = qn; }
    else { src = kar + (size_t)t * 256 + (hd - 8) * 128; dst = ka + (size_t)t * 256 + (hd - 8) * 128; gn = kn; }
    const unsigned pr = ((const unsigned*)src)[lane];
    float x0 = bf2f((bf16_t)(pr & 0xffff)), x1 = bf2f((bf16_t)(pr >> 16));
    const float ss = wave_sum(x0 * x0 + x1 * x1), r = 1.f / sqrtf(ss * (1.f / 128.f) + RMS_EPS);
    x0 = x0 * r * gn[2 * lane]; x1 = x1 * r * gn[2 * lane + 1];
    const int s = t & (SEQ - 1), pos = (lane < 32) ? (s >> 6) : (s & 63);
    const float invf = exp2f(-(float)(lane & 31) * (13.287712379549449f / 32.f));
    float rev = (float)pos * invf * 0.15915494309189535f; rev -= floorf(rev);
    const float sn = __builtin_amdgcn_sinf(rev), cs = __builtin_amdgcn_cosf(rev);
    const float o0 = x0 * cs - x1 * sn, o1 = x0 * sn + x1 * cs;
    ((unsigned*)dst)[lane] = (unsigned)f2bf(o0) | ((unsigned)f2bf(o1) << 16);
}

__device__ __forceinline__ float logsig(float x) { return fminf(x, 0.f) - __logf(1.f + __expf(-fabsf(x))); }
__global__ __launch_bounds__(256) void k_glacum(const float* lr, const float* wf, const float* bfv, const float* wb, const float* bbv, float* bcf, float* bcb) {
    __shared__ float lrs[128][32];
    const int h = blockIdx.x & 3, ck = blockIdx.x >> 2, t0 = ck * 128, tid = threadIdx.x, dir = tid >> 7, d = tid & 127, ch = h * 128 + d;
    for (int i = tid; i < 128 * 32; i += 256) lrs[i >> 5][i & 31] = lr[(size_t)t0 * 32 + i];
    float w[16]; const float* W = dir ? wb : wf;
#pragma unroll
    for (int r = 0; r < 16; ++r) w[r] = W[r * 512 + ch];
    const float bias = dir ? bbv[ch] : bfv[ch];
    __syncthreads();
    float acc = 0.f; float* out = dir ? bcb : bcf;
    for (int ii = 0; ii < 128; ++ii) { const int i = dir ? 127 - ii : ii; float x = bias;
#pragma unroll
        for (int r = 0; r < 16; ++r) x += lrs[i][dir * 16 + r] * w[r];
        acc += logsig(x) * (1.f / 16.f); out[(size_t)(t0 + i) * 512 + ch] = acc; }
}
__global__ __launch_bounds__(256) void k_gla_naive(const bf16_t* qb, const bf16_t* kb, const bf16_t* vb, const float* lr, const float* wf, const float* bfv, const float* wb, const float* bbv,
                                                   float* of, float* ob) {
    __shared__ float qs[128], ks[128], dec[128];
    const int dir = blockIdx.x & 1, h = (blockIdx.x >> 1) & 3, b = blockIdx.x >> 3, e = threadIdx.x;
    float w[16]; float bias = 0.f;
    if (e < 128) { const float* W = dir ? wb : wf;
#pragma unroll
        for (int r = 0; r < 16; ++r) w[r] = W[r * 512 + h * 128 + e];
        bias = dir ? bbv[h * 128 + e] : bfv[h * 128 + e]; }
    else {
#pragma unroll
        for (int r = 0; r < 16; ++r) w[r] = 0.f; }
    float S[128];
#pragma unroll
    for (int d = 0; d < 128; ++d) S[d] = 0.f;
    float* out = dir ? ob : of;
    for (int ii = 0; ii < SEQ; ++ii) { const int t = b * SEQ + (dir ? SEQ - 1 - ii : ii);
        if (e < 128) { float x = bias;
#pragma unroll
            for (int r = 0; r < 16; ++r) x += lr[(size_t)t * 32 + dir * 16 + r] * w[r];
            dec[e] = __expf(logsig(x) * (1.f / 16.f));
            qs[e] = bf2f(qb[(size_t)t * 512 + h * 128 + e]) * 0.08838834764831845f; ks[e] = bf2f(kb[(size_t)t * 512 + h * 128 + e]); }
        __syncthreads();
        const float v = bf2f(vb[(size_t)t * 1024 + h * 256 + e]); float o = 0.f;
#pragma unroll
        for (int d = 0; d < 128; ++d) { S[d] = S[d] * dec[d] + ks[d] * v; o += qs[d] * S[d]; }
        out[(size_t)t * 1024 + h * 256 + e] = o;
        __syncthreads(); }
}
__global__ __launch_bounds__(256) void k_gla_combine(const float* of, const float* ob, const bf16_t* og, const float* gn, bf16_t* a2) {
    const int lane = threadIdx.x & 63, gw = blockIdx.x * 4 + (threadIdx.x >> 6), t = gw >> 2, h = gw & 3;
    const size_t base = (size_t)t * 1024 + h * 256 + lane * 4;
    const float4 a = *(const float4*)(of + base), c = *(const float4*)(ob + base);
    float o[4] = {a.x + c.x, a.y + c.y, a.z + c.z, a.w + c.w};
    const float ss = wave_sum(o[0] * o[0] + o[1] * o[1] + o[2] * o[2] + o[3] * o[3]), r = 1.f / sqrtf(ss * (1.f / 256.f) + RMS_EPS);
#pragma unroll
    for (int j = 0; j < 4; ++j) { const float g = bf2f(og[base + j]); a2[(size_t)t * 2048 + 1024 + h * 256 + lane * 4 + j] = f2bf(o[j] * r * gn[lane * 4 + j] * (g * sigm(g))); }
}
struct EpiScores { float* sc; __device__ void operator()(int row, int col, float v, float, int batch) const { sc[((size_t)batch * SEQ + row) * SEQ + col] = v * 0.08838834764831845f; } };
__global__ __launch_bounds__(256) void k_softmax_rows(float* sc) {
    const int lane = threadIdx.x & 63; float* p = sc + ((size_t)blockIdx.x * 4 + (threadIdx.x >> 6)) * SEQ;
    float m = -1e30f; for (int i = lane; i < SEQ; i += 64) m = fmaxf(m, p[i]);
#pragma unroll
    for (int o = 1; o < 64; o <<= 1) m = fmaxf(m, __shfl_xor(m, o));
    float s = 0.f; for (int i = lane; i < SEQ; i += 64) { const float e = __expf(p[i] - m); p[i] = e; s += e; }
    s = 1.f / wave_sum(s); for (int i = lane; i < SEQ; i += 64) p[i] *= s;
}
struct EpiAttnOut { bf16_t* a2; int b, kvh; __device__ void operator()(int row, int col, float v, float, int g) const { a2[((size_t)b * SEQ + row) * 2048 + (kvh * 4 + g) * 128 + col] = f2bf(v); } };
struct EpiYa { const bf16_t* sg; float* m1; __device__ void operator()(int row, int col, float v, float, int) const { m1[(size_t)row * 2048 + col] = bf2f(sg[(size_t)row * 4096 + col]) * v; } };
struct EpiYb { const bf16_t* sg; const float* m1; bf16_t* mb; __device__ void operator()(int row, int col, float v, float, int) const {
    mb[(size_t)row * 2048 + col] = f2bf(m1[(size_t)row * 2048 + col] + bf2f(sg[(size_t)row * 4096 + 2048 + col]) * v); } };
struct EpiRes { const float* base; float* out; __device__ void operator()(int row, int col, float v, float, int) const { const size_t i = (size_t)row * 2048 + col; out[i] = DN_ALPHA * base[i] + v; } };

__global__ __launch_bounds__(256) void k_ln1_router(const float* pre1, const float* g, const float* b, const float* wr, const float* br, float* h1f, bf16_t* xrows,
                                                    int* dest, float* gate, unsigned* ctl) {
    const int lane = threadIdx.x & 63, row = blockIdx.x * 4 + (threadIdx.x >> 6);
    float4 v[8]; load_row(v, pre1 + (size_t)row * D, lane); ln_row(v, g, b, lane); store_row_f32(v, h1f + (size_t)row * D, lane);
    float mylogit = -1e30f;
    for (int e = 0; e < NE; ++e) { float s = 0.f;
#pragma unroll
        for (int j = 0; j < 8; ++j) { const int d0 = (lane + 64 * j) * 4; s += v[j].x * wr[(d0 + 0) * NE + e] + v[j].y * wr[(d0 + 1) * NE + e] + v[j].z * wr[(d0 + 2) * NE + e] + v[j].w * wr[(d0 + 3) * NE + e]; }
        s = wave_sum(s) + br[e]; if (lane == e) mylogit = s; }
    float tv[4]; int ti[4]; float cur = mylogit;
#pragma unroll
    for (int k = 0; k < 4; ++k) { float bv = cur; int bi = lane;
#pragma unroll
        for (int o = 1; o < 64; o <<= 1) { const float ov = __shfl_xor(bv, o); const int oi = __shfl_xor(bi, o); if (ov > bv || (ov == bv && oi < bi)) { bv = ov; bi = oi; } }
        tv[k] = bv; ti[k] = bi; if (lane == bi) cur = -1e30f; }
    float ge[4], gs = 0.f;
#pragma unroll
    for (int k = 0; k < 4; ++k) { ge[k] = __expf(tv[k] - tv[0]); gs += ge[k]; }
    int dst[4];
#pragma unroll
    for (int k = 0; k < 4; ++k) { unsigned slot = 0; if (lane == 0) slot = __hip_atomic_fetch_add(ctl + CW_CNT + 64 * ti[k], 1u, __ATOMIC_RELAXED, __HIP_MEMORY_SCOPE_AGENT);
        slot = __shfl(slot, 0); dst[k] = ti[k] * CAP + (int)slot; }
    if (lane < 4) { const int k = lane; int dd = dst[0]; float gg = ge[0];
        if (k == 1) { dd = dst[1]; gg = ge[1]; } if (k == 2) { dd = dst[2]; gg = ge[2]; } if (k == 3) { dd = dst[3]; gg = ge[3]; }
        dest[row * 4 + k] = dd; gate[row * 4 + k] = gg / gs; }
#pragma unroll
    for (int k = 0; k < 4; ++k) store_row_bf16(v, xrows + (size_t)dst[k] * D, lane);
}
struct EpiUp { const float* bup; bf16_t* act; __device__ void operator()(int row, int col, float g, float lin, int e) const {
    g += bup[e * 4096 + col]; lin += bup[e * 4096 + 2048 + col]; g = fminf(g, 7.f); lin = fminf(fmaxf(lin, -7.f), 7.f);
    act[((size_t)e * CAP + row) * 2048 + col] = f2bf(g * sigm(1.702f * g) * (lin + 1.f)); } };
struct EpiDown { const float* bdn; bf16_t* y; __device__ void operator()(int row, int col, float v, float, int e) const { y[((size_t)e * CAP + row) * 2048 + col] = f2bf(v + bdn[e * 2048 + col]); } };
__global__ __launch_bounds__(256) void k_combine_ln2(const float* h1f, const bf16_t* y, const int* dest, const float* gate, const float* g, const float* b, float* h2f, bf16_t* h2b) {
    const int lane = threadIdx.x & 63, row = blockIdx.x * 4 + (threadIdx.x >> 6);
    float4 v[8]; load_row(v, h1f + (size_t)row * D, lane);
#pragma unroll
    for (int j = 0; j < 8; ++j) { v[j].x *= DN_ALPHA; v[j].y *= DN_ALPHA; v[j].z *= DN_ALPHA; v[j].w *= DN_ALPHA; }
    for (int k = 0; k < 4; ++k) { const bf16_t* yr = y + (size_t)dest[row * 4 + k] * D; const float gk = gate[row * 4 + k];
#pragma unroll
        for (int j = 0; j < 8; ++j) { const uint2 w = ((const uint2*)yr)[lane + 64 * j];
            v[j].x += gk * bf2f((bf16_t)(w.x & 0xffff)); v[j].y += gk * bf2f((bf16_t)(w.x >> 16)); v[j].z += gk * bf2f((bf16_t)(w.y & 0xffff)); v[j].w += gk * bf2f((bf16_t)(w.y >> 16)); } }
    ln_row(v, g, b, lane); store_row_f32(v, h2f + (size_t)row * D, lane); store_row_bf16(v, h2b + (size_t)row * D, lane);
}
struct EpiF32 { float* out; __device__ void operator()(int row, int col, float v, float, int) const { out[(size_t)row * 2048 + col] = v; } };
struct EpiPle { const float* h2f; const float* pp; float* out; __device__ void operator()(int row, int col, float v, float, int) const { const size_t i = (size_t)row * 2048 + col; out[i] = DN_ALPHA * h2f[i] + sigm(v) * pp[i]; } };
__global__ __launch_bounds__(256) void k_ln_out(const float* in, const float* g, const float* b, float* out) {
    const int lane = threadIdx.x & 63, row = blockIdx.x * 4 + (threadIdx.x >> 6);
    float4 v[8]; load_row(v, in + (size_t)row * D, lane); ln_row(v, g, b, lane); store_row_f32(v, out + (size_t)row * D, lane);
}

namespace pg8 {
#define PG8_LAS __attribute__((address_space(3)))
typedef unsigned u32x4 __attribute__((ext_vector_type(4)));
constexpr int BM = 256, BK = 64, HALF = 128, HTB = HALF * BK * 2  , STAGE_BYTES = 8 * HTB, NXCD = 8, WGM = 8;
__host__ __device__ __forceinline__ int lds_byte(int r, int c) { const int st = (r >> 4) * 2 + (c >> 5), rr = r & 15, cc = c & 31, ob = rr * 64 + cc * 2; return st * 1024 + (ob ^ (((ob >> 9) & 1) << 5)); }
__host__ __device__ __forceinline__ void stage_rc(int b, int& R, int& C) { const int st = b / 1024, sb = b % 1024, swz = sb ^ (((sb >> 9) & 1) << 5); R = (st >> 1) * 16 + swz / 64; C = (st & 1) * 32 + (swz % 64) / 2; }
__host__ __device__ __forceinline__ int perm32(int rho) { const int n = rho >> 4, i = rho & 15; return 8 * (i >> 2) + 4 * n + (i & 3); }
struct Unit { int pm, pn; };
struct Gemm { const bf16_t* A; const bf16_t* Bt; int M, N, K; };
struct StaticOrder {
    int nM, nN, nwg, G, c;
    __host__ __device__ void init(int M, int N, int G_, int c_) { nM = M / BM; nN = N / BM; nwg = nM * nN; G = G_; c = c_; }
    __host__ __device__ bool next(int i, Unit& u) const {
        const long L = (long)i * G + c; if (L >= nwg) return false;
        int wgid = (int)L; { const int q = nwg / NXCD, r = nwg % NXCD, xcd = wgid % NXCD, off = wgid / NXCD; wgid = (xcd < r ? xcd * (q + 1) : r * (q + 1) + (xcd - r) * q) + off; }
        const int nig = WGM * nN, gid = wgid / nig, fm = gid * WGM, gsz = (nM - fm) < WGM ? (nM - fm) : WGM;
        u.pm = fm + ((wgid % nig) % gsz); u.pn = (wgid % nig) / gsz; return true;
    }
    __device__ __forceinline__ const char* abase(const Gemm& g, const Unit& u, size_t tstep) const { return (const char*)g.A + (size_t)u.pm * tstep; }
    __device__ __forceinline__ const char* bbase(const Gemm& g, const Unit& u, size_t tstep) const { return (const char*)g.Bt + (size_t)u.pn * tstep; }
    __device__ __forceinline__ void a_ready(const Unit&) const {}
    __device__ __forceinline__ void done(const Unit&) const {}
};
struct MoeOrder {
    const PG8_LAS int* tp; int NT, G, c; size_t bstride;
    __device__ bool next(int i, Unit& u) const {
        const int total = NT * tp[32]; const long L = (long)i * G + c; if (L >= total) return false;
        int wgid = (int)L; { const int q = total / NXCD, r = total % NXCD, xcd = wgid % NXCD, off = wgid / NXCD; wgid = (xcd < r ? xcd * (q + 1) : r * (q + 1) + (xcd - r) * q) + off; }
        int e = 0; while (e < 31 && wgid >= NT * tp[e + 1]) ++e;
        const int local = wgid - NT * tp[e], nte = tp[e + 1] - tp[e];
        u.pn = local / nte; u.pm = e * 32 + local % nte; return true;
    }
    __device__ __forceinline__ const char* abase(const Gemm& g, const Unit& u, size_t tstep) const { return (const char*)g.A + (size_t)u.pm * tstep; }
    __device__ __forceinline__ const char* bbase(const Gemm& g, const Unit& u, size_t tstep) const { return (const char*)g.Bt + (size_t)(u.pm >> 5) * bstride + (size_t)u.pn * tstep; }
    __device__ __forceinline__ void a_ready(const Unit&) const {}
    __device__ __forceinline__ void done(const Unit&) const {}
};
__device__ __forceinline__ unsigned cvt_pk_bf16(float lo, float hi) { unsigned r; asm volatile("v_cvt_pk_bf16_f32 %0, %1, %2" : "=v"(r) : "v"(lo), "v"(hi)); return r; }
__device__ __forceinline__ float bflo(unsigned w) { return __uint_as_float(w << 16); }
__device__ __forceinline__ float bfhi(unsigned w) { return __uint_as_float(w & 0xffff0000u); }
typedef const f32x4 (&AccRef)[2][2][4][2];

struct EpiInprojF { static constexpr bool PERM = true, AFTER_DRAIN = false;
    bf16_t *qar, *kar, *va, *qb, *kb, *vb, *og, *sg; float* lr;
    __device__ __forceinline__ void operator()(AccRef acc, const Unit& u, int wr, int wc, int fr, int fq) const {
        const int pn = u.pn, row0 = u.pm * BM + wr * 64 + fr;
        if (pn >= 34) {
            if (wc == 0) {
#pragma unroll
                for (int ai = 0; ai < 2; ++ai)
#pragma unroll
                    for (int m = 0; m < 4; ++m) { float* rp = lr + (size_t)(row0 + ai * HALF + m * 16) * 32 + 8 * fq;
                        *(f32x4*)(rp) = acc[ai][0][m][0]; *(f32x4*)(rp + 4) = acc[ai][0][m][1]; } }
            return; }
        bf16_t* base; int ld, coff; bool sgm = false;
        if (pn < 4) { base = qar; ld = 1024; coff = pn * 256; }
        else if (pn == 4) { base = kar; ld = 256; coff = 0; }
        else if (pn == 5) { base = va; ld = 256; coff = 0; }
        else if (pn < 8) { base = qb; ld = 512; coff = (pn - 6) * 256; }
        else if (pn < 10) { base = kb; ld = 512; coff = (pn - 8) * 256; }
        else if (pn < 14) { base = vb; ld = 1024; coff = (pn - 10) * 256; }
        else if (pn < 18) { base = og; ld = 1024; coff = (pn - 14) * 256; }
        else { base = sg; ld = 4096; coff = (pn - 18) * 256; sgm = true; }
        const int col0 = coff + wc * 32 + 8 * fq;
#pragma unroll
        for (int ai = 0; ai < 2; ++ai)
#pragma unroll
            for (int m = 0; m < 4; ++m) { bf16_t* rowp = base + (size_t)(row0 + ai * HALF + m * 16) * ld + col0;
#pragma unroll
                for (int bj = 0; bj < 2; ++bj) { f32x4 v0 = acc[ai][bj][m][0], v1 = acc[ai][bj][m][1];
                    if (sgm) {
#pragma unroll
                        for (int j = 0; j < 4; ++j) { v0[j] = sigm(v0[j]); v1[j] = sigm(v1[j]); } }
                    u32x4 w; w.x = cvt_pk_bf16(v0[0], v0[1]); w.y = cvt_pk_bf16(v0[2], v0[3]); w.z = cvt_pk_bf16(v1[0], v1[1]); w.w = cvt_pk_bf16(v1[2], v1[3]);
                    *(u32x4*)(rowp + bj * HALF) = w; } }
    } };
struct EpiYaF { static constexpr bool PERM = true, AFTER_DRAIN = false; const bf16_t* sg; float* m1;
    __device__ __forceinline__ void operator()(AccRef acc, const Unit& u, int wr, int wc, int fr, int fq) const {
        const int row0 = u.pm * BM + wr * 64 + fr, col0 = u.pn * BM + wc * 32 + 8 * fq;
#pragma unroll
        for (int ai = 0; ai < 2; ++ai)
#pragma unroll
            for (int m = 0; m < 4; ++m) { const size_t r = (size_t)(row0 + ai * HALF + m * 16);
#pragma unroll
                for (int bj = 0; bj < 2; ++bj) { const int c = col0 + bj * HALF; const u32x4 s = *(const u32x4*)(sg + r * 4096 + c);
                    f32x4 o0, o1; o0[0] = bflo(s.x) * acc[ai][bj][m][0][0]; o0[1] = bfhi(s.x) * acc[ai][bj][m][0][1]; o0[2] = bflo(s.y) * acc[ai][bj][m][0][2]; o0[3] = bfhi(s.y) * acc[ai][bj][m][0][3];
                    o1[0] = bflo(s.z) * acc[ai][bj][m][1][0]; o1[1] = bfhi(s.z) * acc[ai][bj][m][1][1]; o1[2] = bflo(s.w) * acc[ai][bj][m][1][2]; o1[3] = bfhi(s.w) * acc[ai][bj][m][1][3];
                    *(f32x4*)(m1 + r * 2048 + c) = o0; *(f32x4*)(m1 + r * 2048 + c + 4) = o1; } }
    } };
struct EpiYbF { static constexpr bool PERM = true, AFTER_DRAIN = false; const bf16_t* sg; const float* m1; bf16_t* mb;
    __device__ __forceinline__ void operator()(AccRef acc, const Unit& u, int wr, int wc, int fr, int fq) const {
        const int row0 = u.pm * BM + wr * 64 + fr, col0 = u.pn * BM + wc * 32 + 8 * fq;
#pragma unroll
        for (int ai = 0; ai < 2; ++ai)
#pragma unroll
            for (int m = 0; m < 4; ++m) { const size_t r = (size_t)(row0 + ai * HALF + m * 16);
#pragma unroll
                for (int bj = 0; bj < 2; ++bj) { const int c = col0 + bj * HALF; const u32x4 s = *(const u32x4*)(sg + r * 4096 + 2048 + c);
                    const f32x4 a0 = *(const f32x4*)(m1 + r * 2048 + c), a1 = *(const f32x4*)(m1 + r * 2048 + c + 4);
                    const float o0 = a0[0] + bflo(s.x) * acc[ai][bj][m][0][0], o1 = a0[1] + bfhi(s.x) * acc[ai][bj][m][0][1], o2 = a0[2] + bflo(s.y) * acc[ai][bj][m][0][2], o3 = a0[3] + bfhi(s.y) * acc[ai][bj][m][0][3];
                    const float o4 = a1[0] + bflo(s.z) * acc[ai][bj][m][1][0], o5 = a1[1] + bfhi(s.z) * acc[ai][bj][m][1][1], o6 = a1[2] + bflo(s.w) * acc[ai][bj][m][1][2], o7 = a1[3] + bfhi(s.w) * acc[ai][bj][m][1][3];
                    u32x4 w; w.x = cvt_pk_bf16(o0, o1); w.y = cvt_pk_bf16(o2, o3); w.z = cvt_pk_bf16(o4, o5); w.w = cvt_pk_bf16(o6, o7);
                    *(u32x4*)(mb + r * 2048 + c) = w; } }
    } };
template <int MODE> struct EpiF32F { static constexpr bool PERM = false, AFTER_DRAIN = false; const float* base; const float* pp; float* out;
    __device__ __forceinline__ void operator()(AccRef acc, const Unit& u, int wr, int wc, int fr, int fq) const {
        const int row0 = u.pm * BM + wr * 64 + fr, col0 = u.pn * BM + wc * 32 + 4 * fq;
#pragma unroll
        for (int ai = 0; ai < 2; ++ai)
#pragma unroll
            for (int m = 0; m < 4; ++m) { const size_t ro = (size_t)(row0 + ai * HALF + m * 16) * 2048 + col0;
#pragma unroll
                for (int bj = 0; bj < 2; ++bj)
#pragma unroll
                    for (int n = 0; n < 2; ++n) { const size_t o = ro + bj * HALF + n * 16; f32x4 v = acc[ai][bj][m][n];
                        if (MODE == 1) { const f32x4 b = *(const f32x4*)(base + o); v = b * DN_ALPHA + v; }
                        if (MODE == 2) { const f32x4 b = *(const f32x4*)(base + o), q = *(const f32x4*)(pp + o);
#pragma unroll
                            for (int j = 0; j < 4; ++j) v[j] = DN_ALPHA * b[j] + sigm(v[j]) * q[j]; }
                        *(f32x4*)(out + o) = v; } }
    } };
struct EpiUpF { static constexpr bool PERM = true, AFTER_DRAIN = false; const float* bup; bf16_t* act;
    __device__ __forceinline__ void operator()(AccRef acc, const Unit& u, int wr, int wc, int fr, int fq) const {
        const int e = u.pm >> 5, row0 = u.pm * BM + wr * 64 + fr, cj = u.pn * 128 + wc * 32 + 8 * fq;
        const f32x4 bg0 = *(const f32x4*)(bup + e * 4096 + cj), bg1 = *(const f32x4*)(bup + e * 4096 + cj + 4), bl0 = *(const f32x4*)(bup + e * 4096 + 2048 + cj), bl1 = *(const f32x4*)(bup + e * 4096 + 2048 + cj + 4);
#pragma unroll
        for (int ai = 0; ai < 2; ++ai)
#pragma unroll
            for (int m = 0; m < 4; ++m) { const size_t r = (size_t)(row0 + ai * HALF + m * 16);
                const f32x4 g0 = acc[ai][0][m][0] + bg0, g1 = acc[ai][0][m][1] + bg1, l0 = acc[ai][1][m][0] + bl0, l1 = acc[ai][1][m][1] + bl1; float o[8];
#pragma unroll
                for (int j = 0; j < 4; ++j) { const float ga = fminf(g0[j], 7.f), la = fminf(fmaxf(l0[j], -7.f), 7.f); o[j] = ga * sigm(1.702f * ga) * (la + 1.f);
                    const float gb = fminf(g1[j], 7.f), lb = fminf(fmaxf(l1[j], -7.f), 7.f); o[4 + j] = gb * sigm(1.702f * gb) * (lb + 1.f); }
                u32x4 w; w.x = cvt_pk_bf16(o[0], o[1]); w.y = cvt_pk_bf16(o[2], o[3]); w.z = cvt_pk_bf16(o[4], o[5]); w.w = cvt_pk_bf16(o[6], o[7]);
                *(u32x4*)(act + r * 2048 + cj) = w; }
    } };
struct EpiDownF { static constexpr bool PERM = true, AFTER_DRAIN = false; const float* bdn; bf16_t* y;
    __device__ __forceinline__ void operator()(AccRef acc, const Unit& u, int wr, int wc, int fr, int fq) const {
        const int e = u.pm >> 5, row0 = u.pm * BM + wr * 64 + fr, col0 = u.pn * BM + wc * 32 + 8 * fq;
        f32x4 bv[2][2];
#pragma unroll
        for (int bj = 0; bj < 2; ++bj)
#pragma unroll
            for (int n = 0; n < 2; ++n) bv[bj][n] = *(const f32x4*)(bdn + e * 2048 + col0 + bj * HALF + 4 * n);
#pragma unroll
        for (int ai = 0; ai < 2; ++ai)
#pragma unroll
            for (int m = 0; m < 4; ++m) { bf16_t* rowp = y + (size_t)(row0 + ai * HALF + m * 16) * 2048 + col0;
#pragma unroll
                for (int bj = 0; bj < 2; ++bj) { const f32x4 v0 = acc[ai][bj][m][0] + bv[bj][0], v1 = acc[ai][bj][m][1] + bv[bj][1];
                    u32x4 w; w.x = cvt_pk_bf16(v0[0], v0[1]); w.y = cvt_pk_bf16(v0[2], v0[3]); w.z = cvt_pk_bf16(v1[0], v1[1]); w.w = cvt_pk_bf16(v1[2], v1[3]);
                    *(u32x4*)(rowp + bj * HALF) = w; } }
    } };

template <class Epi, class Sched, bool STAMP = false>
__device__ __forceinline__ void gemm_phase(PG8_LAS unsigned char* lds, const Gemm g, const Sched& S, const Epi& E, unsigned long long* stamps, int lda = 0) {
    const int tid = threadIdx.x, wid = __builtin_amdgcn_readfirstlane(tid >> 6), lane = tid & 63, wr = wid >> 2, wc = wid & 3, fr = lane & 15, fq = lane >> 4;
    const int K = g.K, nt = K / BK, LDA = lda ? lda : K;
    int ts_lo = 0, ts_hi = 0, nts = 0; const unsigned long long rt_entry = STAMP ? (unsigned long long)wall_clock64() : 0ull;
#define PG8_STAMP() do { if (STAMP && wid == 0 && nts < 64) { const unsigned long long _c = (unsigned long long)clock64(); \
        ts_lo = (lane == nts) ? (int)(unsigned)_c : ts_lo; ts_hi = (lane == nts) ? (int)(unsigned)(_c >> 32) : ts_hi; ++nts; } } while (0)
    PG8_STAMP();
    unsigned voffA[2], voffB[2];
#pragma unroll
    for (int i = 0; i < 2; ++i) { int R, C; stage_rc(tid * 16 + i * 8192, R, C); const int Rb = Epi::PERM ? ((R & ~31) + perm32(R & 31)) : R;
        voffA[i] = (unsigned)(R * LDA + C) * 2u; voffB[i] = (unsigned)(Rb * K + C) * 2u; }
    const size_t kstep = (size_t)(BK * 2);
    const size_t hstep = (size_t)HALF * K * 2;
    const size_t tstep = 2 * hstep;
    const size_t hstepA = (size_t)HALF * LDA * 2, tstepA = 2 * hstepA;
    const unsigned ldsw = (unsigned)wid * 1024u;
    const int aoff = lds_byte(wr * 64 + fr, fq * 8), boff = lds_byte(wc * 32 + fr, fq * 8);
#define PG8_SA(b, h) (((b) * 2 + (h)) * HTB)
#define PG8_SB(b, h) ((4 + (b) * 2 + (h)) * HTB)
#define PG8_STAGE(bufoff, gbase, voff) do { _Pragma("unroll") for (int _i = 0; _i < 2; ++_i) \
        __builtin_amdgcn_global_load_lds((const unsigned*)((const char*)(gbase) + (voff)[_i]), (PG8_LAS unsigned*)(lds + (bufoff) + ldsw + _i * 8192), 16, 0, 0); } while (0)
#define PG8_LDA(dst, b, h) do { _Pragma("unroll") for (int m = 0; m < 4; ++m) _Pragma("unroll") for (int k = 0; k < 2; ++k) dst[m][k] = *(const PG8_LAS bf16x8*)(lds + PG8_SA(b, h) + aoff + m * 2048 + k * 1024); } while (0)
#define PG8_LDB(dst, b, h) do { _Pragma("unroll") for (int n = 0; n < 2; ++n) _Pragma("unroll") for (int k = 0; k < 2; ++k) dst[n][k] = *(const PG8_LAS bf16x8*)(lds + PG8_SB(b, h) + boff + n * 2048 + k * 1024); } while (0)
#define PG8_MMA(ai, bj, At, Bt) do { __builtin_amdgcn_s_setprio(1); _Pragma("unroll") for (int m = 0; m < 4; ++m) _Pragma("unroll") for (int n = 0; n < 2; ++n) _Pragma("unroll") for (int k = 0; k < 2; ++k) \
        acc[ai][bj][m][n] = __builtin_amdgcn_mfma_f32_16x16x32_bf16(Bt[n][k], At[m][k], acc[ai][bj][m][n], 0, 0, 0); __builtin_amdgcn_s_setprio(0); } while (0)
#define PG8_WAIT_V(n) asm volatile("s_waitcnt vmcnt(" #n ")" ::: "memory")
#define PG8_WAIT_L(n) asm volatile("s_waitcnt lgkmcnt(" #n ")" ::: "memory")
#define PG8_BAR __builtin_amdgcn_s_barrier()
#define PG8_SCHED __builtin_amdgcn_sched_barrier(0)
    Unit cur, nxt; int ui = 0;
    if (!S.next(0, cur)) return;
    f32x4 acc[2][2][4][2];
#pragma unroll
    for (int a = 0; a < 2; ++a)
#pragma unroll
        for (int b = 0; b < 2; ++b)
#pragma unroll
            for (int m = 0; m < 4; ++m)
#pragma unroll
                for (int n = 0; n < 2; ++n) acc[a][b][m][n] = (f32x4){0.f, 0.f, 0.f, 0.f};
    bf16x8 At[4][2], B0[2][2], B1[2][2];
    const char* cA = S.abase(g, cur, tstepA); const char* cB = S.bbase(g, cur, tstep);
    S.a_ready(cur);
    PG8_STAGE(PG8_SB(0, 0), cB, voffB); PG8_STAGE(PG8_SA(0, 0), cA, voffA); PG8_STAGE(PG8_SB(0, 1), cB + hstep, voffB); PG8_STAGE(PG8_SA(0, 1), cA + hstepA, voffA);
    if (wr == 1) PG8_BAR;
    PG8_WAIT_V(4); PG8_BAR;
    PG8_STAGE(PG8_SB(1, 0), cB + kstep, voffB); PG8_STAGE(PG8_SA(1, 0), cA + kstep, voffA); PG8_STAGE(PG8_SB(1, 1), cB + hstep + kstep, voffB);
    PG8_WAIT_V(6); PG8_BAR;
    PG8_STAMP();
    for (;;) {
        const bool has_next = S.next(ui + 1, nxt);
        const char* nA = has_next ? S.abase(g, nxt, tstepA) : cA; const char* nB = has_next ? S.bbase(g, nxt, tstep) : cB;
        for (int t = 0; t < nt; t += 2) {
            const bool last = (t == nt - 2);
            const char* a1 = cA + (size_t)(t + 1) * kstep;
            const char* a2 = last ? nA : cA + (size_t)(t + 2) * kstep; const char* b2 = last ? nB : cB + (size_t)(t + 2) * kstep;
            const char* a3 = a2 + kstep; const char* b3 = b2 + kstep;
            if (last && has_next) S.a_ready(nxt);
            PG8_LDB(B0, 0, 0); PG8_SCHED; PG8_LDA(At, 0, 0); PG8_STAGE(PG8_SA(1, 1), a1 + hstepA, voffA);
            PG8_WAIT_L(8); PG8_BAR; PG8_WAIT_L(0); PG8_MMA(0, 0, At, B0); PG8_BAR; PG8_SCHED;
            PG8_LDB(B1, 0, 1); PG8_STAGE(PG8_SB(0, 0), b2, voffB);
            PG8_BAR; PG8_WAIT_L(0); PG8_MMA(0, 1, At, B1); PG8_BAR;
            PG8_LDA(At, 0, 1); PG8_STAGE(PG8_SA(0, 0), a2, voffA);
            PG8_BAR; PG8_WAIT_L(0); PG8_MMA(1, 0, At, B0); PG8_BAR; PG8_SCHED;
            PG8_STAGE(PG8_SB(0, 1), b2 + hstep, voffB);
            PG8_WAIT_V(6); PG8_BAR; PG8_MMA(1, 1, At, B1); PG8_BAR;
            PG8_LDB(B0, 1, 0); PG8_SCHED; PG8_LDA(At, 1, 0); PG8_STAGE(PG8_SA(0, 1), a2 + hstepA, voffA);
            PG8_WAIT_L(8); PG8_BAR; PG8_WAIT_L(0); PG8_MMA(0, 0, At, B0); PG8_BAR; PG8_SCHED;
            PG8_LDB(B1, 1, 1); PG8_STAGE(PG8_SB(1, 0), b3, voffB);
            PG8_BAR; PG8_WAIT_L(0); PG8_MMA(0, 1, At, B1); PG8_BAR;
            PG8_LDA(At, 1, 1); PG8_STAGE(PG8_SA(1, 0), a3, voffA);
            PG8_BAR; PG8_WAIT_L(0); PG8_MMA(1, 0, At, B0); PG8_BAR; PG8_SCHED;
            PG8_STAGE(PG8_SB(1, 1), b3 + hstep, voffB);
            PG8_WAIT_V(6); PG8_BAR; PG8_MMA(1, 1, At, B1); PG8_BAR;
        }
        PG8_STAMP();
        if constexpr (!Epi::AFTER_DRAIN) { E(acc, cur, wr, wc, fr, fq); S.done(cur); }
        PG8_STAMP();
        if (!has_next) break;
#pragma unroll
        for (int a = 0; a < 2; ++a)
#pragma unroll
            for (int b = 0; b < 2; ++b)
#pragma unroll
                for (int m = 0; m < 4; ++m)
#pragma unroll
                    for (int n = 0; n < 2; ++n) acc[a][b][m][n] = (f32x4){0.f, 0.f, 0.f, 0.f};
        cur = nxt; cA = nA; cB = nB; ++ui;
    }
    PG8_WAIT_V(0);
    if (wr == 0) PG8_BAR;
    PG8_BAR;
    if constexpr (Epi::AFTER_DRAIN) { E.fused(acc, cur, wr, wc, fr, fq, lds, wid, lane); S.done(cur); }
    PG8_STAMP();
    if (STAMP && wid == 0) { stamps[lane] = lane < nts ? (((unsigned long long)(unsigned)ts_hi << 32) | (unsigned)ts_lo) : 0ull;
        if (lane == 62) stamps[62] = rt_entry; if (lane == 63) stamps[63] = (unsigned long long)wall_clock64(); }
#undef PG8_STAMP
#undef PG8_SA
#undef PG8_SB
#undef PG8_STAGE
#undef PG8_LDA
#undef PG8_LDB
#undef PG8_MMA
#undef PG8_WAIT_V
#undef PG8_WAIT_L
#undef PG8_BAR
#undef PG8_SCHED
}

}

namespace attn {
using bf16 = bf16_t;
constexpr int   D = 128, NW = 8, QBLK = 32, KVBLK = 64;
constexpr float SCALE = 0.088388347648318440f;
constexpr float THR = 8.f;
constexpr int SDEPTH = 2;
constexpr int LDQ = 1024, LDK = 256, LDO = 2048;
constexpr size_t SHM_V = KVBLK * D * 2, SHM_K = KVBLK * D * 2, SHM_ATTN = 2 * SHM_V + 2 * SHM_K + NW * 64 * 4;
using bf16x8 = __attribute__((ext_vector_type(8))) short;
using s16x4  = __attribute__((ext_vector_type(4))) short;
using f32x16 = __attribute__((ext_vector_type(16))) float;
using f32x8  = __attribute__((ext_vector_type(8))) float;
using u32x4  = __attribute__((ext_vector_type(4))) unsigned;
#define KSWZ(row, colB) ((row) * 256 + ((colB) ^ (((row) & 7) << 4)))
#define SBAR() __builtin_amdgcn_sched_barrier(0)
__device__ __forceinline__ int crow(int r, int hi) { return (r & 3) + 8 * (r >> 2) + 4 * hi; }
__device__ __forceinline__ unsigned cvtpk(float lo, float hi) {
  unsigned r; asm volatile("v_cvt_pk_bf16_f32 %0, %1, %2" : "=v"(r) : "v"(lo), "v"(hi)); return r;
}
__device__ __forceinline__ void partialSM(f32x16& p0, f32x16& p1, float& m_reg, float& mn, float& alpha) {
  constexpr float C = SCALE * 1.4426950408889634f;
  float pmax = p0[0]; for (int r = 1; r < 16; ++r) pmax = fmaxf(pmax, p0[r]); for (int r = 0; r < 16; ++r) pmax = fmaxf(pmax, p1[r]);
  { auto rr = __builtin_amdgcn_permlane32_swap(__float_as_uint(pmax), __float_as_uint(pmax), false, false);
    pmax = fmaxf(__uint_as_float(rr[0]), __uint_as_float(rr[1])); }
  if (__builtin_expect(__all(pmax - m_reg <= THR / SCALE), 1)) { mn = m_reg; alpha = 1.f; }
  else { mn = fmaxf(m_reg, pmax); alpha = __builtin_amdgcn_exp2f((m_reg - mn) * C); m_reg = mn; }
  float mnC = -mn * C;
  for (int r = 0; r < 16; ++r) p0[r] = fmaf(p0[r], C, mnC); for (int r = 0; r < 16; ++r) p1[r] = fmaf(p1[r], C, mnC);
  for (int r = 0; r < 16; ++r) p0[r] = __builtin_amdgcn_exp2f(p0[r]);
}
__device__ __forceinline__ void finishSM(f32x16& p0, f32x16& p1, float alpha, float& l_reg, bf16x8& pa0, bf16x8& pa1, bf16x8& pa2, bf16x8& pa3) {
  for (int r = 0; r < 16; ++r) p1[r] = __builtin_amdgcn_exp2f(p1[r]);
  float ps = 0; for (int r = 0; r < 16; ++r) ps += p0[r]; for (int r = 0; r < 16; ++r) ps += p1[r];
  { auto rr = __builtin_amdgcn_permlane32_swap(__float_as_uint(ps), __float_as_uint(ps), false, false);
    ps = __uint_as_float(rr[0]) + __uint_as_float(rr[1]); }
  l_reg = l_reg * alpha + ps;
#define PK4(P, BASE, OUT) do { unsigned a0 = cvtpk(P[BASE + 0], P[BASE + 1]), a1 = cvtpk(P[BASE + 2], P[BASE + 3]);   \
    unsigned b0 = cvtpk(P[BASE + 4], P[BASE + 5]), b1 = cvtpk(P[BASE + 6], P[BASE + 7]);                              \
    auto r0 = __builtin_amdgcn_permlane32_swap(a0, b0, false, false); auto r1 = __builtin_amdgcn_permlane32_swap(a1, b1, false, false); \
    u32x4 w = {r0[0], r1[0], r0[1], r1[1]}; OUT = *reinterpret_cast<bf16x8*>(&w); } while (0)
  PK4(p0, 0, pa0); PK4(p0, 8, pa1); PK4(p1, 0, pa2); PK4(p1, 8, pa3);
#undef PK4
}
__device__ __forceinline__ void qkt(f32x16& p0, f32x16& p1, const bf16* Ks, const bf16x8* qr, int r32, int hi) {
  p0 = f32x16{}; p1 = f32x16{};
  for (int d0 = 0; d0 < 8; ++d0) { int cb = (d0 * 16 + hi * 8) * 2;
    bf16x8 b0 = *reinterpret_cast<const bf16x8*>((const char*)Ks + KSWZ(r32, cb));
    bf16x8 b1 = *reinterpret_cast<const bf16x8*>((const char*)Ks + KSWZ(32 + r32, cb));
    p0 = __builtin_amdgcn_mfma_f32_32x32x16_bf16(b0, qr[d0], p0, 0, 0, 0);
    p1 = __builtin_amdgcn_mfma_f32_32x32x16_bf16(b1, qr[d0], p1, 0, 0, 0); }
}
__device__ __forceinline__ int v_st(int k, int c) { const int kk = (k & ~0xC) | ((k & 4) << 1) | ((k & 8) >> 1); return ((kk >> 3) * 4 + (c >> 5)) * 512 + ((kk & 7) * 32 + (c & 31)) * 2; }
__device__ __forceinline__ int v_rd_base(int lane) { return ((lane & 3) << 3) | (((lane >> 2) & 3) << 6) | (((lane >> 4) & 1) << 5) | (((lane >> 5) & 1) << 8); }
constexpr int v_rd_off(int d0, int ks, int half) { return d0 * 512 + ks * 4096 + half * 2048; }
template <int OFF> __device__ __forceinline__ s16x4 tr_read(int vb) {
  s16x4 r; asm volatile("ds_read_b64_tr_b16 %0, %1 offset:%2" : "=&v"(r) : "v"(vb), "i"(OFF) : "memory"); return r;
}
template <int D0> __device__ __forceinline__ void pv_one(f32x16& od, int vb, bf16x8 pa0, bf16x8 pa1, bf16x8 pa2, bf16x8 pa3) {
  const s16x4 l0 = tr_read<v_rd_off(D0, 0, 0)>(vb), h0 = tr_read<v_rd_off(D0, 0, 1)>(vb), l1 = tr_read<v_rd_off(D0, 1, 0)>(vb), h1 = tr_read<v_rd_off(D0, 1, 1)>(vb);
  const s16x4 l2 = tr_read<v_rd_off(D0, 2, 0)>(vb), h2 = tr_read<v_rd_off(D0, 2, 1)>(vb), l3 = tr_read<v_rd_off(D0, 3, 0)>(vb), h3 = tr_read<v_rd_off(D0, 3, 1)>(vb);
  asm volatile("s_waitcnt lgkmcnt(0)" ::: "memory"); SBAR();
#define PK(L, H) (bf16x8){L[0], L[1], L[2], L[3], H[0], H[1], H[2], H[3]}
  od = __builtin_amdgcn_mfma_f32_32x32x16_bf16(pa0, PK(l0, h0), od, 0, 0, 0);
  od = __builtin_amdgcn_mfma_f32_32x32x16_bf16(pa1, PK(l1, h1), od, 0, 0, 0);
  od = __builtin_amdgcn_mfma_f32_32x32x16_bf16(pa2, PK(l2, h2), od, 0, 0, 0);
  od = __builtin_amdgcn_mfma_f32_32x32x16_bf16(pa3, PK(l3, h3), od, 0, 0, 0);
#undef PK
}
__device__ __forceinline__ void pv_d0(f32x16* o, int vb, bf16x8 pa0, bf16x8 pa1, bf16x8 pa2, bf16x8 pa3) {
  pv_one<0>(o[0], vb, pa0, pa1, pa2, pa3); pv_one<1>(o[1], vb, pa0, pa1, pa2, pa3); pv_one<2>(o[2], vb, pa0, pa1, pa2, pa3); pv_one<3>(o[3], vb, pa0, pa1, pa2, pa3);
}
__device__ __forceinline__ void attn_dense_body(const bf16* __restrict__ Qb, const bf16* __restrict__ Kh, const bf16* __restrict__ Vh,
                                                bf16* __restrict__ Ob, int seq, char* lds) {
  const int tid = threadIdx.x, wid = tid >> 6, lane = tid & 63, r32 = lane & 31, hi = lane >> 5;
  bf16* V_lds = (bf16*)lds; bf16* K_lds = (bf16*)(lds + 2 * SHM_V);
  float* ws = (float*)(lds + 2 * SHM_V + 2 * SHM_K) + wid * 64; float* li_l = ws; float* al_l = ws + 32;
  float m_reg = -1e30f, l_reg = 0; f32x16 o[4] = {}; bf16x8 qr[8];
  const bf16* Qw = Qb + (long)(wid * QBLK + r32) * LDQ + hi * 8;
#pragma unroll
  for (int d0 = 0; d0 < 8; ++d0) qr[d0] = *reinterpret_cast<const bf16x8*>(Qw + d0 * 16);
  const int sr = tid >> 4, sc = (tid & 15) * 8, vst0 = v_st(sr, sc), vst1 = v_st(32 + sr, sc);
  const int vb0 = (int)(uintptr_t)V_lds + v_rd_base(lane);
  struct { bf16x8 vs0, vs1, ks0, ks1; } sr_[SDEPTH];
#define SLOAD(i, k0) do { sr_[i].vs0 = *reinterpret_cast<const bf16x8*>(&Vh[(long)((k0) + sr) * LDK + sc]); sr_[i].vs1 = *reinterpret_cast<const bf16x8*>(&Vh[(long)((k0) + 32 + sr) * LDK + sc]); \
    sr_[i].ks0 = *reinterpret_cast<const bf16x8*>(&Kh[(long)((k0) + sr) * LDK + sc]); sr_[i].ks1 = *reinterpret_cast<const bf16x8*>(&Kh[(long)((k0) + 32 + sr) * LDK + sc]); } while (0)
#define SWRITE(b, i) do { *(bf16x8*)((char*)V_lds + (b) * SHM_V + vst0) = sr_[i].vs0;          \
    *(bf16x8*)((char*)V_lds + (b) * SHM_V + vst1) = sr_[i].vs1; int kc = sc * 2;               \
    *(bf16x8*)((char*)K_lds + (b) * SHM_K + KSWZ(sr, kc)) = sr_[i].ks0;                       \
    *(bf16x8*)((char*)K_lds + (b) * SHM_K + KSWZ(32 + sr, kc)) = sr_[i].ks1; } while (0)
#define SWAIT() do { if constexpr (SDEPTH == 2) asm volatile("s_waitcnt vmcnt(4)" ::: "memory"); else asm volatile("s_waitcnt vmcnt(0)" ::: "memory"); } while (0)
#define RESC(a) do { if (__any((a) < 1.f)) { if (hi == 0) al_l[r32] = (a); asm volatile("s_waitcnt lgkmcnt(0)" ::: "memory"); \
    for (int d = 0; d < 4; ++d) for (int r = 0; r < 16; ++r) o[d][r] *= al_l[crow(r, hi)]; } } while (0)
  f32x16 pA0, pA1, pB0, pB1; float mnA, mnB, alA, alB; bf16x8 pa0, pa1, pa2, pa3; const int NT = seq / KVBLK;
  constexpr int SE = 0, SO = SDEPTH - 1;
  SLOAD(SE, 0); asm volatile("s_waitcnt vmcnt(0)" ::: "memory"); SWRITE(0, SE); __syncthreads();
  qkt(pA0, pA1, K_lds, qr, r32, hi); partialSM(pA0, pA1, m_reg, mnA, alA);
  SLOAD(SO, KVBLK); if constexpr (SDEPTH == 2) { if (2 < NT) SLOAD(SE, 2 * KVBLK); }
  SWAIT(); SWRITE(1, SO); __syncthreads();
  for (int j = 1; j + 1 < NT; j += 2) {
    SBAR(); qkt(pB0, pB1, (bf16*)((char*)K_lds + SHM_K), qr, r32, hi);
    finishSM(pA0, pA1, alA, l_reg, pa0, pa1, pa2, pa3); SBAR();
    SLOAD(SO, (j + SDEPTH) * KVBLK); SBAR();
    pv_d0(o, vb0, pa0, pa1, pa2, pa3); partialSM(pB0, pB1, m_reg, mnB, alB);
    __syncthreads(); SWAIT(); SWRITE(0, SE);
    RESC(alB); __syncthreads();
    SBAR(); qkt(pA0, pA1, K_lds, qr, r32, hi);
    finishSM(pB0, pB1, alB, l_reg, pa0, pa1, pa2, pa3); SBAR();
    if (SDEPTH == 1 || j + 3 < NT) SLOAD(SE, (j + 1 + SDEPTH) * KVBLK); SBAR();
    pv_d0(o, vb0 + (int)SHM_V, pa0, pa1, pa2, pa3); partialSM(pA0, pA1, m_reg, mnA, alA);
    __syncthreads(); SWAIT(); SWRITE(1, SO);
    RESC(alA); __syncthreads();
  }
  SBAR(); qkt(pB0, pB1, (bf16*)((char*)K_lds + SHM_K), qr, r32, hi);
  finishSM(pA0, pA1, alA, l_reg, pa0, pa1, pa2, pa3); SBAR();
  pv_d0(o, vb0, pa0, pa1, pa2, pa3); partialSM(pB0, pB1, m_reg, mnB, alB);
  __syncthreads(); RESC(alB);
  finishSM(pB0, pB1, alB, l_reg, pa0, pa1, pa2, pa3); SBAR();
  pv_d0(o, vb0 + (int)SHM_V, pa0, pa1, pa2, pa3);
  if (hi == 0) li_l[r32] = l_reg; asm volatile("s_waitcnt lgkmcnt(0)" ::: "memory");
  float rli[16];
#pragma unroll
  for (int r = 0; r < 16; ++r) rli[r] = __builtin_amdgcn_rcpf(li_l[crow(r, hi)]);
  bf16* Ow = Ob + (long)(wid * QBLK) * LDO;
#pragma unroll
  for (int r = 0; r < 16; ++r) { int orow = crow(r, hi);
    for (int d0 = 0; d0 < 4; ++d0) Ow[(long)orow * LDO + d0 * 32 + r32] = f2bf(o[d0][r] * rli[r]); }
#undef SLOAD
#undef SWRITE
#undef SWAIT
#undef RESC
}
}

#define XB_TMO      128
#define XB_XCNT(j)  (256  + 64 * (j))
#define XB_XSUB(j)  (1280 + 64 * (j))
#define XB_XGEN(j)  (2304 + 64 * (j))
#define XB_TOP      3328
#define XB_TOPGEN   3392
#define XCD_BAR_WORDS 3456
#define XB_SPIN_CAP (1u << 18)
#ifndef LAS
#define LAS __attribute__((address_space(3)))
#endif

__device__ __forceinline__ unsigned xb_ld(unsigned* p)              { return __hip_atomic_load(p, __ATOMIC_RELAXED, __HIP_MEMORY_SCOPE_AGENT); }
__device__ __forceinline__ unsigned xb_add(unsigned* p, unsigned v) { return __hip_atomic_fetch_add(p, v, __ATOMIC_RELAXED, __HIP_MEMORY_SCOPE_AGENT); }
__device__ __forceinline__ unsigned xb_xcc_id() { return (unsigned)__builtin_amdgcn_s_getreg((3 << 11) | 20) & 0xFu; }
#define XB_SPIN(cond, bar) do { unsigned _sp = 0; while (cond) { __builtin_amdgcn_s_sleep(1); \
    if ((++_sp & 255u) == 0u) { if (xb_ld(&(bar)[XB_TMO])) break; if (_sp > XB_SPIN_CAP) { atomicAdd(&(bar)[XB_TMO], 1u); break; } } } } while (0)

struct XcdBarrier {
    unsigned* bar; unsigned x;
    volatile LAS unsigned* st;
};

__device__ __forceinline__ XcdBarrier xcd_barrier_post(unsigned* bar, volatile LAS unsigned* st) {
    XcdBarrier b; b.bar = bar; b.x = xb_xcc_id(); b.st = st;
    if (threadIdx.x == 0) (void)xb_add(&bar[XB_XCNT(b.x)], 1u);
    return b;
}
__device__ __forceinline__ void xcd_barrier_complete(unsigned* bar, unsigned x, unsigned& nloc, unsigned& nx) {
    const unsigned G = gridDim.x * gridDim.y * gridDim.z;
    unsigned sum, cnt, mine, sp = 0u;
    for (;;) {
        sum = 0u; cnt = 0u; mine = 0u;
#pragma unroll
        for (unsigned j = 0; j < 16; ++j) { const unsigned c = xb_ld(&bar[XB_XCNT(j)]); sum += c; cnt += (c > 0u) ? 1u : 0u; mine = (j == x) ? c : mine; }
        if (sum == G) break;
        __builtin_amdgcn_s_sleep(1);
        if ((++sp & 255u) == 0u) { if (xb_ld(&bar[XB_TMO])) break; if (sp > XB_SPIN_CAP) { atomicAdd(&bar[XB_TMO], 1u); break; } }
    }
    nloc = mine > 0u ? mine : 1u; nx = cnt > 0u ? cnt : 1u;
}

__device__ __forceinline__ void xcd_barrier(const XcdBarrier& b) {
    asm volatile("s_waitcnt vmcnt(0)" ::: "memory");
    __syncthreads();
    if (threadIdx.x == 0) {
        unsigned* bar = b.bar;
        __builtin_amdgcn_s_waitcnt(0);
        unsigned nloc = b.st[0], nx = b.st[1];
        if (nloc == 0u) { xcd_barrier_complete(bar, b.x, nloc, nx); b.st[0] = nloc; b.st[1] = nx; }
        const unsigned old = xb_add(&bar[XB_XSUB(b.x)], 1u);
        const unsigned gen = old / nloc;
        if (old + 1u == (gen + 1u) * nloc) {
            __builtin_amdgcn_fence(__ATOMIC_RELEASE, "agent");
            asm volatile("s_waitcnt vmcnt(0)" ::: "memory");
            const unsigned og = xb_add(&bar[XB_TOP], 1u);
            const unsigned tg = og / nx;
            if (og + 1u == (tg + 1u) * nx) xb_add(&bar[XB_TOPGEN], 1u);
            else XB_SPIN(xb_ld(&bar[XB_TOPGEN]) == tg, bar);
            __builtin_amdgcn_fence(__ATOMIC_ACQUIRE, "agent");
            xb_add(&bar[XB_XGEN(b.x)], 1u);
            asm volatile("s_waitcnt vmcnt(0)" ::: "memory");
        } else {
            XB_SPIN(xb_ld(&bar[XB_XGEN(b.x)]) == gen, bar);
            __builtin_amdgcn_fence(__ATOMIC_ACQUIRE, "agent");
            asm volatile("s_waitcnt vmcnt(0)" ::: "memory");
        }
    }
    __syncthreads();
}

constexpr int NWAVES = 8, NTHR = 512;
constexpr int LDS_BYTES = 155648;
constexpr int LDS_TAB = 139264;
constexpr int LDS_BARW = LDS_BYTES - 64;
constexpr size_t WS_SST = 860 * MiB;
constexpr size_t WS_WT_IN = 896 * MiB;
constexpr size_t WS_WT_A = 932 * MiB, WS_WT_B = 936 * MiB, WS_WT_O = 940 * MiB, WS_WT_G = 948 * MiB, WS_WT_P = 956 * MiB;
constexpr size_t WS_WT_UP = 3072 * MiB;
constexpr size_t WS_WT_DN = 3584 * MiB;
constexpr size_t WS_END2 = 3840 * MiB;
constexpr int CW_BAR = 4096;
constexpr int NIN = 8960;
enum { F_TR = 1, F_LN0 = 2, F_INPROJ = 4, F_PREP = 8, F_ATTN = 16, F_GLA = 32, F_YA = 64, F_YB = 128, F_WO = 256, F_LN1 = 512, F_UP = 1024, F_DOWN = 2048, F_LN2 = 4096, F_PLE = 8192, F_LN3 = 16384 };

constexpr int KFLAGS = FAST_MASK;
struct MegaArgs { const float* in[29]; float* out; unsigned char* ws; int ph_lo, ph_hi, flags, li; };

#define LDS_WAIT() asm volatile("s_waitcnt lgkmcnt(0)" ::: "memory")
#define VM_WAIT() asm volatile("s_waitcnt vmcnt(0)" ::: "memory")

struct MapId { __device__ __forceinline__ int operator()(int n) const { return n; } };
struct MapIn { __device__ __forceinline__ int operator()(int n) const { return n < 4608 ? n : (n < 4640 ? 8704 + (n - 4608) : n - 32); } };
struct MapUp { __device__ __forceinline__ int operator()(int n) const { return n < 2048 ? ((n >> 7) << 8) + (n & 127) : (((n - 2048) >> 7) << 8) + 128 + ((n - 2048) & 127); } };
template <class Map> __device__ __forceinline__ void tr_item(const float* W, int K, int N, int k0, int n0, bf16_t* WT, Map map, LAS float* scr, int lane) {
    const int nc = (lane & 15) * 4, kr = lane >> 4; const bool okc = (n0 + nc) < N;
#pragma unroll 4
    for (int i = 0; i < 16; ++i) { const int k = kr + 4 * i; f32x4 v = (f32x4){0.f, 0.f, 0.f, 0.f};
        if (okc) v = *(const f32x4*)(W + (size_t)(k0 + k) * N + n0 + nc);
        scr[k * 65 + nc + 0] = v[0]; scr[k * 65 + nc + 1] = v[1]; scr[k * 65 + nc + 2] = v[2]; scr[k * 65 + nc + 3] = v[3]; }
    LDS_WAIT();
    const int c = lane & 7;
#pragma unroll 2
    for (int i = 0; i < 8; ++i) { const int n = (lane >> 3) + 8 * i;
        if (n0 + n < N) { const LAS float* s = scr + (8 * c) * 65 + n; pg8::u32x4 o;
            o.x = pg8::cvt_pk_bf16(s[0 * 65], s[1 * 65]); o.y = pg8::cvt_pk_bf16(s[2 * 65], s[3 * 65]); o.z = pg8::cvt_pk_bf16(s[4 * 65], s[5 * 65]); o.w = pg8::cvt_pk_bf16(s[6 * 65], s[7 * 65]);
            *(pg8::u32x4*)(WT + (size_t)map(n0 + n) * K + k0 + 8 * c) = o; } }
    LDS_WAIT();
}
__device__ __forceinline__ void ph_prologue(const MegaArgs& P, LAS unsigned char* lds, int gw, int NGW, int wave, int lane) {
    unsigned char* ws = P.ws;
    if (KFLAGS & F_TR) {
        LAS float* scr = (LAS float*)(lds + wave * 16640);
        constexpr int I_IN = 32 * 137, I_A = 16 * 32, I_O = 32 * 32, I_P = 4 * 32, I_UP = 32 * 64, I_DN = 32 * 32;
        constexpr int NDENSE = I_IN + 2 * I_A + 2 * I_O + I_P, NITEMS = NDENSE + NE * (I_UP + I_DN);
        for (int it = gw; it < NITEMS; it += NGW) {
            int r = it;
            if (r < I_IN) { tr_item(P.in[4], 2048, INW, (r / 137) * 64, (r % 137) * 64, (bf16_t*)(ws + WS_WT_IN), MapIn(), scr, lane); continue; } r -= I_IN;
            if (r < I_A) { tr_item(P.in[12], 1024, 2048, (r / 32) * 64, (r % 32) * 64, (bf16_t*)(ws + WS_WT_A), MapId(), scr, lane); continue; } r -= I_A;
            if (r < I_A) { tr_item(P.in[13], 1024, 2048, (r / 32) * 64, (r % 32) * 64, (bf16_t*)(ws + WS_WT_B), MapId(), scr, lane); continue; } r -= I_A;
            if (r < I_O) { tr_item(P.in[14], 2048, 2048, (r / 32) * 64, (r % 32) * 64, (bf16_t*)(ws + WS_WT_O), MapId(), scr, lane); continue; } r -= I_O;
            if (r < I_O) { tr_item(P.in[25], 2048, 2048, (r / 32) * 64, (r % 32) * 64, (bf16_t*)(ws + WS_WT_G), MapId(), scr, lane); continue; } r -= I_O;
            if (r < I_P) { tr_item(P.in[26], 256, 2048, (r / 32) * 64, (r % 32) * 64, (bf16_t*)(ws + WS_WT_P), MapId(), scr, lane); continue; } r -= I_P;
            if (r < NE * I_UP) { const int e = r / I_UP, q = r % I_UP;
                tr_item(P.in[19] + (size_t)e * 2048 * 4096, 2048, 4096, (q / 64) * 64, (q % 64) * 64, (bf16_t*)(ws + WS_WT_UP) + (size_t)e * 4096 * 2048, MapUp(), scr, lane); continue; } r -= NE * I_UP;
            { const int e = r / I_DN, q = r % I_DN;
              tr_item(P.in[21] + (size_t)e * 2048 * 2048, 2048, 2048, (q / 32) * 64, (q % 32) * 64, (bf16_t*)(ws + WS_WT_DN) + (size_t)e * 2048 * 2048, MapId(), scr, lane); }
        }
    }
    if (KFLAGS & F_LN0) {
        float* H0F = (float*)(ws + WS_H0F); bf16_t* H0B = (bf16_t*)(ws + WS_H0B); bf16_t* PB = (bf16_t*)(ws + WS_PB);
        for (int row = gw; row < T; row += NGW) { float4 v[8]; load_row(v, P.in[0] + (size_t)row * D, lane); ln_row(v, P.in[2], P.in[3], lane);
            store_row_f32(v, H0F + (size_t)row * D, lane); store_row_bf16(v, H0B + (size_t)row * D, lane); }
        for (int i = gw * 64 + lane; i < T * PLE / 4; i += NGW * 64) { const float4 v = ((const float4*)P.in[1])[i]; uint2 w; w.x = pg8::cvt_pk_bf16(v.x, v.y); w.y = pg8::cvt_pk_bf16(v.z, v.w); ((uint2*)PB)[i] = w; }
    }
}

__device__ __forceinline__ void ph_prep(const MegaArgs& P, LAS unsigned char* lds, int c, int gw, int NGW, int lane) {
    unsigned char* ws = P.ws;
    const bf16_t *QAR = (const bf16_t*)(ws + WS_QAR), *KAR = (const bf16_t*)(ws + WS_KAR); bf16_t *QA = (bf16_t*)(ws + WS_QA), *KA = (bf16_t*)(ws + WS_KA);
    const float *qn = P.in[5], *kn = P.in[6];
    for (int it = gw; it < T * 10; it += NGW) { const int t = it / 10, hd = it % 10;
        const bf16_t* src; bf16_t* dst; const float* gn;
        if (hd < 8) { src = QAR + (size_t)t * 1024 + hd * 128; dst = QA + (size_t)t * 1024 + hd * 128; gn = qn; }
        else { src = KAR + (size_t)t * 256 + (hd - 8) * 128; dst = KA + (size_t)t * 256 + (hd - 8) * 128; gn = kn; }
        const unsigned pr = ((const unsigned*)src)[lane];
        float x0 = pg8::bflo(pr), x1 = pg8::bfhi(pr);
        const float ss = wave_sum(x0 * x0 + x1 * x1), r = 1.f / sqrtf(ss * (1.f / 128.f) + RMS_EPS);
        x0 = x0 * r * gn[2 * lane]; x1 = x1 * r * gn[2 * lane + 1];
        const int s = t & (SEQ - 1), pos = (lane < 32) ? (s >> 6) : (s & 63);
        const float invf = exp2f(-(float)(lane & 31) * (13.287712379549449f / 32.f));
        float rev = (float)pos * invf * 0.15915494309189535f; rev -= floorf(rev);
        const float sn = __builtin_amdgcn_sinf(rev), cs = __builtin_amdgcn_cosf(rev);
        ((unsigned*)dst)[lane] = pg8::cvt_pk_bf16(x0 * cs - x1 * sn, x0 * sn + x1 * cs); }
    { const float* LR = (const float*)(ws + WS_LR); float* BCF = (float*)(ws + WS_BCF); float* BCB = (float*)(ws + WS_BCB);
      LAS float* lrs = (LAS float*)lds;
      const int tid = threadIdx.x;
      for (int u = c; u < NB * 32 * 4; u += gridDim.x) {
        const int h = u & 3, ck = u >> 2, t0 = ck * 128;
        __syncthreads();
        for (int i = tid; i < 128 * 32; i += NTHR) lrs[i] = LR[(size_t)t0 * 32 + i];
        __syncthreads();
        if (tid < 256) { const int dir = tid >> 7, d = tid & 127, ch = h * 128 + d;
            const float* W = dir ? P.in[9] : P.in[7]; const float bias = dir ? P.in[10][ch] : P.in[8][ch];
            float w[16];
#pragma unroll
            for (int r = 0; r < 16; ++r) w[r] = W[r * 512 + ch];
            float acc = 0.f; float* out = dir ? BCB : BCF;
            for (int ii = 0; ii < 128; ++ii) { const int i = dir ? 127 - ii : ii; float x = bias;
#pragma unroll
                for (int r = 0; r < 16; ++r) x += lrs[i * 32 + dir * 16 + r] * w[r];
                acc += logsig(x) * (1.f / 16.f); out[(size_t)(t0 + i) * 512 + ch] = acc; } }
      }
      __syncthreads(); }
}

__device__ __forceinline__ void gla_state_scan(const MegaArgs& P, LAS unsigned char* lds, int c) {
    unsigned char* ws = P.ws;
    const bf16_t *KBp = (const bf16_t*)(ws + WS_KB), *VBp = (const bf16_t*)(ws + WS_VB); bf16_t* SST = (bf16_t*)(ws + WS_SST);
    const int tid = threadIdx.x, w = __builtin_amdgcn_readfirstlane(tid >> 6), lane = tid & 63, fr = lane & 15, fq = lane >> 4;
    const int chain = c >> 4, sub = c & 15, b = chain >> 3, h = (chain >> 1) & 3, dir = chain & 1, d0 = (sub >> 2) * 32, e0 = (sub & 3) * 64, et = w >> 1, dt = w & 1;
    const float* BC = (const float*)(ws + (dir ? WS_BCB : WS_BCF));
    LAS bf16_t* Vt = (LAS bf16_t*)lds;
    LAS bf16_t* Kt = (LAS bf16_t*)(lds + 64 * 272);
    const int sj = tid >> 2, sec = (tid & 3) * 16, sdc = (tid & 3) * 8;
    f32x4 acc = (f32x4){0.f, 0.f, 0.f, 0.f};
    bf16x8 v0, v1, kk; f32x4 b0, b1, bl0, bl1; float gdec;
#define GLA_LOAD(ck_) do { const int t0_ = b * SEQ + 128 * (ck_), tr_ = t0_ + sj, tl_ = t0_ + (dir ? 0 : 127); \
        v0 = *(const bf16x8*)(VBp + (size_t)tr_ * 1024 + h * 256 + e0 + sec); v1 = *(const bf16x8*)(VBp + (size_t)tr_ * 1024 + h * 256 + e0 + sec + 8); \
        kk = *(const bf16x8*)(KBp + (size_t)tr_ * 512 + h * 128 + d0 + sdc); \
        b0 = *(const f32x4*)(BC + (size_t)tr_ * 512 + h * 128 + d0 + sdc); b1 = *(const f32x4*)(BC + (size_t)tr_ * 512 + h * 128 + d0 + sdc + 4); \
        bl0 = *(const f32x4*)(BC + (size_t)tl_ * 512 + h * 128 + d0 + sdc); bl1 = *(const f32x4*)(BC + (size_t)tl_ * 512 + h * 128 + d0 + sdc + 4); \
        gdec = BC[(size_t)tl_ * 512 + h * 128 + d0 + 16 * dt + fr]; } while (0)
    GLA_LOAD(dir ? 31 : 0);
    for (int cc = 0; cc < 32; ++cc) { const int ck = dir ? 31 - cc : cc;
        { bf16_t* sp = SST + ((size_t)(chain * 32 + ck) * 256 + e0 + 16 * et + 4 * fq) * 128 + d0 + 16 * dt + fr;
#pragma unroll
          for (int r = 0; r < 4; ++r) sp[r * 128] = f2bf(acc[r]); }
#pragma unroll
        for (int i = 0; i < 8; ++i) { Vt[(sec + i) * 136 + sj] = (bf16_t)v0[i]; Vt[(sec + 8 + i) * 136 + sj] = (bf16_t)v1[i]; }
#pragma unroll
        for (int i = 0; i < 8; ++i) { const float bl = i < 4 ? bl0[i & 3] : bl1[i & 3], bb = i < 4 ? b0[i & 3] : b1[i & 3];
            Kt[(sdc + i) * 136 + sj] = f2bf(bf2f((bf16_t)kk[i]) * __expf(bl - bb)); }
        const float g = __expf(gdec);
        if (cc + 1 < 32) GLA_LOAD(dir ? 30 - cc : cc + 1);
        __syncthreads();
        acc = acc * g;
#pragma unroll
        for (int ks = 0; ks < 4; ++ks) { const bf16x8 a = *(const LAS bf16x8*)(Vt + (16 * et + fr) * 136 + 32 * ks + 8 * fq), bb = *(const LAS bf16x8*)(Kt + (16 * dt + fr) * 136 + 32 * ks + 8 * fq);
            acc = __builtin_amdgcn_mfma_f32_16x16x32_bf16(a, bb, acc, 0, 0, 0); }
        __syncthreads(); }
#undef GLA_LOAD
}

__device__ __forceinline__ bf16x8 swz_frag(const LAS unsigned char* base, int row, int ks, int fq) { return *(const LAS bf16x8*)(base + row * 256 + ((64 * ks + 16 * fq) ^ ((row & 7) << 4))); }
__device__ __forceinline__ void gla_output(const MegaArgs& P, LAS unsigned char* lds, int c) {
    unsigned char* ws = P.ws;
    const bf16_t *QBp = (const bf16_t*)(ws + WS_QB), *KBp = (const bf16_t*)(ws + WS_KB), *VBp = (const bf16_t*)(ws + WS_VB), *OGp = (const bf16_t*)(ws + WS_OG), *SST = (const bf16_t*)(ws + WS_SST);
    bf16_t* A2 = (bf16_t*)(ws + WS_A2); const float* gnorm = P.in[11];
    const int tid = threadIdx.x, w = __builtin_amdgcn_readfirstlane(tid >> 6), lane = tid & 63, fr = lane & 15, fq = lane >> 4;
    const int b = c >> 7, h = (c >> 5) & 3, ck = c & 31, t0 = b * SEQ + 128 * ck;
    LAS unsigned char* X0 = lds; LAS unsigned char* X1 = lds + 32768; LAS unsigned char* VT = lds + 65536;
#pragma unroll 2
    for (int u = 0; u < 8; ++u) { const int id = tid + NTHR * u, j = id >> 5, ec = (id & 31) * 8;
        const bf16x8 vv = *(const bf16x8*)(VBp + (size_t)(t0 + j) * 1024 + h * 256 + ec);
#pragma unroll
        for (int i = 0; i < 8; ++i) { const int e = ec + i; *(LAS bf16_t*)(VT + e * 256 + ((j * 2) ^ ((e & 7) << 4))) = (bf16_t)vv[i]; } }
#define GLA_STAGE_QK(BCp) do { _Pragma("unroll") for (int u = 0; u < 4; ++u) { const int id = tid + NTHR * u, row = id >> 4, dc = (id & 15) * 8; \
        const bf16x8 q8 = *(const bf16x8*)(QBp + (size_t)(t0 + row) * 512 + h * 128 + dc), k8 = *(const bf16x8*)(KBp + (size_t)(t0 + row) * 512 + h * 128 + dc); \
        const f32x4 ba = *(const f32x4*)((BCp) + (size_t)(t0 + row) * 512 + h * 128 + dc), bb = *(const f32x4*)((BCp) + (size_t)(t0 + row) * 512 + h * 128 + dc + 4); \
        float qt[8], kt[8]; \
        _Pragma("unroll") for (int i = 0; i < 8; ++i) { const float bv = i < 4 ? ba[i & 3] : bb[i & 3]; qt[i] = bf2f((bf16_t)q8[i]) * __expf(bv) * 0.08838834764831845f; kt[i] = bf2f((bf16_t)k8[i]) * __expf(-bv); } \
        pg8::u32x4 wq, wk; wq.x = pg8::cvt_pk_bf16(qt[0], qt[1]); wq.y = pg8::cvt_pk_bf16(qt[2], qt[3]); wq.z = pg8::cvt_pk_bf16(qt[4], qt[5]); wq.w = pg8::cvt_pk_bf16(qt[6], qt[7]); \
        wk.x = pg8::cvt_pk_bf16(kt[0], kt[1]); wk.y = pg8::cvt_pk_bf16(kt[2], kt[3]); wk.z = pg8::cvt_pk_bf16(kt[4], kt[5]); wk.w = pg8::cvt_pk_bf16(kt[6], kt[7]); \
        const int off_ = row * 256 + ((dc * 2) ^ ((row & 7) << 4)); *(LAS pg8::u32x4*)(X0 + off_) = wq; *(LAS pg8::u32x4*)(X1 + off_) = wk; } } while (0)
    const float* BCF = (const float*)(ws + WS_BCF); const float* BCB = (const float*)(ws + WS_BCB);
    GLA_STAGE_QK(BCF);
    __syncthreads();
    f32x4 accP[8], accO[16];
#pragma unroll
    for (int i = 0; i < 8; ++i) accP[i] = (f32x4){0.f, 0.f, 0.f, 0.f};
#pragma unroll
    for (int i = 0; i < 16; ++i) accO[i] = (f32x4){0.f, 0.f, 0.f, 0.f};
    bf16x8 af[4];
#pragma unroll
    for (int ks = 0; ks < 4; ++ks) af[ks] = swz_frag(X0, 16 * w + fr, ks, fq);
#pragma unroll
    for (int jt = 0; jt < 8; ++jt) { if (jt <= w) {
#pragma unroll
        for (int ks = 0; ks < 4; ++ks) accP[jt] = __builtin_amdgcn_mfma_f32_16x16x32_bf16(af[ks], swz_frag(X1, 16 * jt + fr, ks, fq), accP[jt], 0, 0, 0);
        if (jt == w) {
#pragma unroll
            for (int r = 0; r < 4; ++r) if (fr > 4 * fq + r) accP[jt][r] = 0.f; } } }
    { const bf16_t* Sf = SST + (size_t)(((b * 4 + h) * 2 + 0) * 32 + ck) * 256 * 128;
#pragma unroll
      for (int et = 0; et < 16; ++et)
#pragma unroll
          for (int ks = 0; ks < 4; ++ks) { const bf16x8 bb = *(const bf16x8*)(Sf + (size_t)(16 * et + fr) * 128 + 32 * ks + 8 * fq);
              accO[et] = __builtin_amdgcn_mfma_f32_16x16x32_bf16(af[ks], bb, accO[et], 0, 0, 0); } }
    __syncthreads();
    GLA_STAGE_QK(BCB);
    __syncthreads();
#pragma unroll
    for (int ks = 0; ks < 4; ++ks) af[ks] = swz_frag(X0, 16 * w + fr, ks, fq);
#pragma unroll
    for (int jt = 0; jt < 8; ++jt) { if (jt >= w) { f32x4 tt = (f32x4){0.f, 0.f, 0.f, 0.f};
#pragma unroll
        for (int ks = 0; ks < 4; ++ks) tt = __builtin_amdgcn_mfma_f32_16x16x32_bf16(af[ks], swz_frag(X1, 16 * jt + fr, ks, fq), tt, 0, 0, 0);
        if (jt == w) {
#pragma unroll
            for (int r = 0; r < 4; ++r) if (fr < 4 * fq + r) tt[r] = 0.f; }
        accP[jt] = accP[jt] + tt; } }
    { const bf16_t* Sb = SST + (size_t)(((b * 4 + h) * 2 + 1) * 32 + ck) * 256 * 128;
#pragma unroll
      for (int et = 0; et < 16; ++et)
#pragma unroll
          for (int ks = 0; ks < 4; ++ks) { const bf16x8 bb = *(const bf16x8*)(Sb + (size_t)(16 * et + fr) * 128 + 32 * ks + 8 * fq);
              accO[et] = __builtin_amdgcn_mfma_f32_16x16x32_bf16(af[ks], bb, accO[et], 0, 0, 0); } }
    LDS_WAIT();
#pragma unroll
    for (int jt = 0; jt < 8; ++jt)
#pragma unroll
        for (int r = 0; r < 4; ++r) { const int row = 16 * w + 4 * fq + r, j = 16 * jt + fr; *(LAS bf16_t*)(X0 + row * 256 + ((j * 2) ^ ((row & 7) << 4))) = f2bf(accP[jt][r]); }
    LDS_WAIT();
#pragma unroll
    for (int ks = 0; ks < 4; ++ks) af[ks] = swz_frag(X0, 16 * w + fr, ks, fq);
#pragma unroll
    for (int et = 0; et < 16; ++et)
#pragma unroll
        for (int ks = 0; ks < 4; ++ks) accO[et] = __builtin_amdgcn_mfma_f32_16x16x32_bf16(af[ks], swz_frag(VT, 16 * et + fr, ks, fq), accO[et], 0, 0, 0);
    float rr[4];
#pragma unroll
    for (int r = 0; r < 4; ++r) { float ss = 0.f;
#pragma unroll
        for (int et = 0; et < 16; ++et) ss += accO[et][r] * accO[et][r];
        ss += __shfl_xor(ss, 1); ss += __shfl_xor(ss, 2); ss += __shfl_xor(ss, 4); ss += __shfl_xor(ss, 8);
        rr[r] = 1.f / sqrtf(ss * (1.f / 256.f) + RMS_EPS); }
#pragma unroll
    for (int et = 0; et < 16; ++et) { const int e = 16 * et + fr; const float gn = gnorm[e];
#pragma unroll
        for (int r = 0; r < 4; ++r) { const size_t t = (size_t)(t0 + 16 * w + 4 * fq + r); const float g = bf2f(OGp[t * 1024 + h * 256 + e]);
            A2[t * 2048 + 1024 + h * 256 + e] = f2bf(accO[et][r] * rr[r] * gn * (g * sigm(g))); } }
#undef GLA_STAGE_QK
    __syncthreads();
}

__device__ __forceinline__ void ph_ln1_router(const MegaArgs& P, LAS unsigned char* lds, int c) {
    unsigned char* ws = P.ws; unsigned* ctl = (unsigned*)(ws + WS_CTL);
    const float* PRE1 = (const float*)(ws + WS_PRE1); float* H1F = (float*)(ws + WS_H1F); bf16_t* XROWS = (bf16_t*)(ws + WS_XROWS); int* DEST = (int*)(ws + WS_DEST); float* GATE = (float*)(ws + WS_GATE);
    const float *g1 = P.in[15], *b1 = P.in[16], *wr = P.in[17], *br = P.in[18];
    const int tid = threadIdx.x, w = __builtin_amdgcn_readfirstlane(tid >> 6), lane = tid & 63, e = lane & 31, half = lane >> 5;
    LAS float* hrow = (LAS float*)lds;
    LAS float* part = (LAS float*)(lds + 65536);
    LAS int* etab = (LAS int*)(lds + 81920);
    LAS float* gtab = (LAS float*)(lds + 81920 + 512);
    LAS int* slot = (LAS int*)(lds + 81920 + 1024);
    LAS int* lbase = (LAS int*)(lds + 81920 + 1536);
    float wreg[128];
#pragma unroll
    for (int i = 0; i < 128; ++i) wreg[i] = wr[(size_t)(256 * w + 128 * half + i) * NE + e];
    for (int rb = c * 32; rb < T; rb += gridDim.x * 32) {
        for (int gI = 0; gI < 4; ++gI) {
            const int row = rb + 8 * gI + w;
            { float4 v[8]; load_row(v, PRE1 + (size_t)row * D, lane); ln_row_lowreg(v, g1, b1, lane); store_row_f32(v, H1F + (size_t)row * D, lane);
#pragma unroll
              for (int j = 0; j < 8; ++j) *(LAS f32x4*)(hrow + w * 2048 + (lane + 64 * j) * 4) = (f32x4){v[j].x, v[j].y, v[j].z, v[j].w}; }
            __syncthreads();
            float acc[8];
#pragma unroll
            for (int r = 0; r < 8; ++r) acc[r] = 0.f;
#pragma unroll
            for (int i = 0; i < 128; i += 4) {
#pragma unroll
                for (int r = 0; r < 8; ++r) { const f32x4 h4 = *(const LAS f32x4*)(hrow + r * 2048 + 256 * w + 128 * half + i);
                    acc[r] += h4[0] * wreg[i] + h4[1] * wreg[i + 1] + h4[2] * wreg[i + 2] + h4[3] * wreg[i + 3]; }
                asm volatile("" ::: "memory"); }
#pragma unroll
            for (int r = 0; r < 8; ++r) part[(w * 8 + r) * 64 + lane] = acc[r];
            __syncthreads();
            float lg = -1e30f;
            if (lane < 32) { float s = br[lane];
#pragma unroll
                for (int ww = 0; ww < 8; ++ww) s += part[(ww * 8 + w) * 64 + lane] + part[(ww * 8 + w) * 64 + lane + 32];
                lg = s; }
            float cur = lg, tv0, tv1, tv2, tv3; int ti0, ti1, ti2, ti3;
#define TOP1(TV, TI) do { float bv = cur; int bi = lane; \
                _Pragma("unroll") for (int o = 1; o < 64; o <<= 1) { const float ov = __shfl_xor(bv, o); const int oi = __shfl_xor(bi, o); if (ov > bv || (ov == bv && oi < bi)) { bv = ov; bi = oi; } } \
                TV = bv; TI = bi; if (lane == bi) cur = -1e30f; } while (0)
            TOP1(tv0, ti0); TOP1(tv1, ti1); TOP1(tv2, ti2); TOP1(tv3, ti3);
#undef TOP1
            const float ge0 = 1.f, ge1 = __expf(tv1 - tv0), ge2 = __expf(tv2 - tv0), ge3 = __expf(tv3 - tv0), gs = (ge0 + ge1) + (ge2 + ge3);
            if (lane < 4) { int ee = ti0; float gg = ge0;
                if (lane == 1) { ee = ti1; gg = ge1; } if (lane == 2) { ee = ti2; gg = ge2; } if (lane == 3) { ee = ti3; gg = ge3; }
                etab[(8 * gI + w) * 4 + lane] = ee; gtab[(8 * gI + w) * 4 + lane] = gg / gs; }
        }
        VM_WAIT();
        __syncthreads();
        if (w == 0) { int cnt = 0;
            for (int a = 0; a < 128; ++a) { const int ea = etab[a]; if (ea == lane) { slot[a] = cnt; ++cnt; } }
            if (lane < 32) { unsigned base = 0; if (cnt) base = __hip_atomic_fetch_add(ctl + CW_CNT + 64 * lane, (unsigned)cnt, __ATOMIC_RELAXED, __HIP_MEMORY_SCOPE_AGENT); lbase[lane] = (int)base; } }
        __syncthreads();
        for (int rr = 0; rr < 4; ++rr) { const int rl = 4 * w + rr, row = rb + rl;
            float4 v[8]; load_row(v, H1F + (size_t)row * D, lane);
#pragma unroll
            for (int k = 0; k < 4; ++k) { const int ee = etab[rl * 4 + k]; const int dst = ee * CAP + lbase[ee] + slot[rl * 4 + k];
                store_row_bf16(v, XROWS + (size_t)dst * D, lane);
                if (lane == k) { DEST[row * 4 + k] = dst; GATE[row * 4 + k] = gtab[rl * 4 + k]; } } }
        __syncthreads();
    }
}
__device__ __forceinline__ void build_moe_table(const MegaArgs& P, LAS unsigned char* lds) {
    unsigned* ctl = (unsigned*)(P.ws + WS_CTL); LAS int* tp = (LAS int*)(lds + LDS_TAB);
    __syncthreads();
    if (threadIdx.x == 0) { int run = 0; tp[0] = 0;
        for (int e = 0; e < NE; ++e) { const unsigned cnt = __hip_atomic_load(ctl + CW_CNT + 64 * e, __ATOMIC_RELAXED, __HIP_MEMORY_SCOPE_AGENT); run += (int)((cnt + 255u) >> 8); tp[e + 1] = run; } }
    __syncthreads();
}
__device__ __forceinline__ void ph_combine_ln2(const MegaArgs& P, int gw, int NGW, int lane) {
    unsigned char* ws = P.ws; const float* H1F = (const float*)(ws + WS_H1F); const bf16_t* Y = (const bf16_t*)(ws + WS_XROWS); const int* DEST = (const int*)(ws + WS_DEST); const float* GATE = (const float*)(ws + WS_GATE);
    float* H2F = (float*)(ws + WS_H2F); bf16_t* H2B = (bf16_t*)(ws + WS_H2B);
    for (int row = gw; row < T; row += NGW) {
        float4 v[8]; load_row(v, H1F + (size_t)row * D, lane);
#pragma unroll
        for (int j = 0; j < 8; ++j) { v[j].x *= DN_ALPHA; v[j].y *= DN_ALPHA; v[j].z *= DN_ALPHA; v[j].w *= DN_ALPHA; }
#pragma unroll
        for (int k = 0; k < 4; ++k) { const bf16_t* yr = Y + (size_t)DEST[row * 4 + k] * D; const float gk = GATE[row * 4 + k];
#pragma unroll
            for (int j = 0; j < 8; ++j) { const uint2 q = ((const uint2*)yr)[lane + 64 * j];
                v[j].x += gk * pg8::bflo(q.x); v[j].y += gk * pg8::bfhi(q.x); v[j].z += gk * pg8::bflo(q.y); v[j].w += gk * pg8::bfhi(q.y); } }
        ln_row(v, P.in[23], P.in[24], lane); store_row_f32(v, H2F + (size_t)row * D, lane); store_row_bf16(v, H2B + (size_t)row * D, lane); }
}

__global__ void __launch_bounds__(NTHR, 2) mega(MegaArgs P) {
    extern __shared__ __attribute__((aligned(16))) unsigned char lds_raw[];
    LAS unsigned char* lds = (LAS unsigned char*)lds_raw;
    const int tid = threadIdx.x, lane = tid & 63, wave = __builtin_amdgcn_readfirstlane(tid >> 6), c = blockIdx.x, G = gridDim.x;
    const int gw = c * NWAVES + wave, NGW = G * NWAVES;
    unsigned char* ws = P.ws; unsigned* ctl = (unsigned*)(ws + WS_CTL);
    if (tid == 0) *(LAS pg8::u32x4*)(lds + LDS_BARW) = (pg8::u32x4){0u, 0u, 0u, 0u};
    __syncthreads();
    XcdBarrier bar = xcd_barrier_post(ctl + CW_BAR + P.li * XCD_BAR_WORDS, (volatile LAS unsigned*)(lds + LDS_BARW));
    const int lo = P.ph_lo, hi = P.ph_hi;
#define IN(k) (lo <= (k) && (k) < hi)
#define SEAM(k) do { if (IN(k) && IN((k) + 1)) xcd_barrier(bar); } while (0)
    bf16_t *H0B = (bf16_t*)(ws + WS_H0B), *A2 = (bf16_t*)(ws + WS_A2), *MB = (bf16_t*)(ws + WS_MB), *SG = (bf16_t*)(ws + WS_SG), *H2B = (bf16_t*)(ws + WS_H2B), *PB = (bf16_t*)(ws + WS_PB);
    float *M1 = (float*)(ws + WS_M1), *PRE1 = (float*)(ws + WS_PRE1), *H0F = (float*)(ws + WS_H0F), *H2F = (float*)(ws + WS_H2F), *PP = (float*)(ws + WS_PP), *PRE3 = (float*)(ws + WS_PRE3);

    if (IN(0)) { ph_prologue(P, lds, gw, NGW, wave, lane); } SEAM(0);
    if (IN(1)) { if (KFLAGS & F_INPROJ) {
        pg8::Gemm g{H0B, (const bf16_t*)(ws + WS_WT_IN), T, NIN, D}; pg8::StaticOrder S; S.init(T, NIN, G, c);
        pg8::EpiInprojF E{(bf16_t*)(ws + WS_QAR), (bf16_t*)(ws + WS_KAR), (bf16_t*)(ws + WS_VA), (bf16_t*)(ws + WS_QB), (bf16_t*)(ws + WS_KB), (bf16_t*)(ws + WS_VB), (bf16_t*)(ws + WS_OG), SG, (float*)(ws + WS_LR)};
        pg8::gemm_phase<pg8::EpiInprojF, pg8::StaticOrder>(lds, g, S, E, nullptr); } } SEAM(1);
    if (IN(2)) { if (KFLAGS & F_PREP) ph_prep(P, lds, c, gw, NGW, lane); } SEAM(2);
    if (IN(3)) {
        if (KFLAGS & F_ATTN) { for (int u = c; u < 256; u += G) {
            const int xcd = u & 7, off = u >> 3, grp = xcd >> 1, b = grp >> 1, kvh = grp & 1, idx = (xcd & 1) * 32 + off, gq = idx >> 4, qb = idx & 15, hq = kvh * 4 + gq;
            const bf16_t* QA = (const bf16_t*)(ws + WS_QA); const bf16_t* KA = (const bf16_t*)(ws + WS_KA); const bf16_t* VA = (const bf16_t*)(ws + WS_VA);
            attn::attn_dense_body(QA + ((size_t)(b * SEQ + qb * 256) * 1024 + hq * 128), KA + ((size_t)b * SEQ * 256 + kvh * 128), VA + ((size_t)b * SEQ * 256 + kvh * 128),
                                  A2 + ((size_t)(b * SEQ + qb * 256) * 2048 + hq * 128), SEQ, (char*)lds_raw);
            __syncthreads(); } }
        if (KFLAGS & F_GLA) { for (int u = c; u < 256; u += G) gla_state_scan(P, lds, u); }
    } SEAM(3);
    if (IN(4)) {
        if (KFLAGS & F_GLA) { for (int u = c; u < 256; u += G) gla_output(P, lds, u); }
    }
    if (IN(4) && (KFLAGS & F_YA)) { pg8::Gemm g{A2, (const bf16_t*)(ws + WS_WT_A), T, D, 1024}; pg8::StaticOrder S; S.init(T, D, G, c); pg8::EpiYaF E{SG, M1};
        pg8::gemm_phase<pg8::EpiYaF, pg8::StaticOrder>(lds, g, S, E, nullptr, 2048); } SEAM(4);
    if (IN(5)) { if (KFLAGS & F_YB) { pg8::Gemm g{A2 + 1024, (const bf16_t*)(ws + WS_WT_B), T, D, 1024}; pg8::StaticOrder S; S.init(T, D, G, c); pg8::EpiYbF E{SG, M1, MB};
        pg8::gemm_phase<pg8::EpiYbF, pg8::StaticOrder>(lds, g, S, E, nullptr, 2048); } } SEAM(5);
    if (IN(6)) { if (KFLAGS & F_WO) { pg8::Gemm g{MB, (const bf16_t*)(ws + WS_WT_O), T, D, D}; pg8::StaticOrder S; S.init(T, D, G, c); pg8::EpiF32F<1> E{H0F, nullptr, PRE1};
        pg8::gemm_phase<pg8::EpiF32F<1>, pg8::StaticOrder>(lds, g, S, E, nullptr); } } SEAM(6);
    if (IN(7)) { if (KFLAGS & F_LN1) ph_ln1_router(P, lds, c); } SEAM(7);
    if (IN(8)) { if (KFLAGS & F_UP) { build_moe_table(P, lds);
        pg8::Gemm g{(const bf16_t*)(ws + WS_XROWS), (const bf16_t*)(ws + WS_WT_UP), NE * CAP, 4096, D}; pg8::MoeOrder S{(const PG8_LAS int*)(lds + LDS_TAB), 16, G, c, (size_t)4096 * 2048 * 2};
        pg8::EpiUpF E{P.in[20], (bf16_t*)(ws + WS_ACT)};
        pg8::gemm_phase<pg8::EpiUpF, pg8::MoeOrder>(lds, g, S, E, nullptr); } } SEAM(8);
    if (IN(9)) { if (KFLAGS & F_DOWN) { build_moe_table(P, lds);
        pg8::Gemm g{(const bf16_t*)(ws + WS_ACT), (const bf16_t*)(ws + WS_WT_DN), NE * CAP, D, D}; pg8::MoeOrder S{(const PG8_LAS int*)(lds + LDS_TAB), 8, G, c, (size_t)2048 * 2048 * 2};
        pg8::EpiDownF E{P.in[22], (bf16_t*)(ws + WS_XROWS)};
        pg8::gemm_phase<pg8::EpiDownF, pg8::MoeOrder>(lds, g, S, E, nullptr); } } SEAM(9);
    if (IN(10)) { if (KFLAGS & F_LN2) ph_combine_ln2(P, gw, NGW, lane); } SEAM(10);
    if (IN(11)) { if (KFLAGS & F_PLE) {
        { pg8::Gemm g{PB, (const bf16_t*)(ws + WS_WT_P), T, D, PLE}; pg8::StaticOrder S; S.init(T, D, G, c); pg8::EpiF32F<0> E{nullptr, nullptr, PP};
          pg8::gemm_phase<pg8::EpiF32F<0>, pg8::StaticOrder>(lds, g, S, E, nullptr); }
        { pg8::Gemm g{H2B, (const bf16_t*)(ws + WS_WT_G), T, D, D}; pg8::StaticOrder S; S.init(T, D, G, c); pg8::EpiF32F<2> E{H2F, PP, PRE3};
          pg8::gemm_phase<pg8::EpiF32F<2>, pg8::StaticOrder>(lds, g, S, E, nullptr); } } } SEAM(11);
    if (IN(12)) { if (KFLAGS & F_LN3) { for (int row = gw; row < T; row += NGW) { float4 v[8]; load_row(v, PRE3 + (size_t)row * D, lane); ln_row(v, P.in[27], P.in[28], lane); store_row_f32(v, P.out + (size_t)row * D, lane); } } }
#undef IN
#undef SEAM
}

extern "C" void kernel_launch(void* const* d_in, const int* in_sizes, int n_in, void* d_out, int out_size, void* d_ws, size_t ws_size, hipStream_t stream) {
    static int grid = 0;
    if (grid == 0) {
        if (n_in != 29 || ws_size < WS_END2) { fprintf(stderr, "kernel_launch: unexpected n_in %d or ws %zu < %zu\n", n_in, ws_size, (size_t)WS_END2); grid = -1; return; }
        int dev = 0, cus = 0, per_cu = 0;
        if (hipGetDevice(&dev) != hipSuccess || hipDeviceGetAttribute(&cus, hipDeviceAttributeMultiprocessorCount, dev) != hipSuccess) { grid = -1; return; }
        if (hipFuncSetAttribute((const void*)mega, hipFuncAttributeMaxDynamicSharedMemorySize, LDS_BYTES) != hipSuccess) { fprintf(stderr, "kernel_launch: hipFuncSetAttribute failed\n"); grid = -1; return; }
        if (hipOccupancyMaxActiveBlocksPerMultiprocessor(&per_cu, (const void*)mega, NTHR, LDS_BYTES) != hipSuccess || per_cu < 1) fprintf(stderr, "kernel_launch: occupancy query says %d\n", per_cu);
        (void)hipGetLastError();
        grid = cus;
    }
    if (grid < 0) return;
    const float* x = (const float*)d_in[0]; const float* p = (const float*)d_in[1];
    const float *in_g = (const float*)d_in[2], *in_b = (const float*)d_in[3], *w_in = (const float*)d_in[4], *qn = (const float*)d_in[5], *kn = (const float*)d_in[6];
    const float *wlf = (const float*)d_in[7], *blf = (const float*)d_in[8], *wlb = (const float*)d_in[9], *blb = (const float*)d_in[10], *gn = (const float*)d_in[11];
    const float *wba = (const float*)d_in[12], *wbb = (const float*)d_in[13], *wo = (const float*)d_in[14], *l1g = (const float*)d_in[15], *l1b = (const float*)d_in[16];
    const float *wr = (const float*)d_in[17], *br = (const float*)d_in[18], *wup = (const float*)d_in[19], *bup = (const float*)d_in[20], *wdn = (const float*)d_in[21], *bdn = (const float*)d_in[22];
    const float *l2g = (const float*)d_in[23], *l2b = (const float*)d_in[24], *wpg = (const float*)d_in[25], *wpp = (const float*)d_in[26], *l3g = (const float*)d_in[27], *l3b = (const float*)d_in[28];
    char* ws = (char*)d_ws; float* out = (float*)d_out;
    unsigned* ctl = (unsigned*)(ws + WS_CTL);
    float* H0F = (float*)(ws + WS_H0F); bf16_t* H0B = (bf16_t*)(ws + WS_H0B);
    bf16_t *QAR = (bf16_t*)(ws + WS_QAR), *KAR = (bf16_t*)(ws + WS_KAR), *VA = (bf16_t*)(ws + WS_VA), *QB = (bf16_t*)(ws + WS_QB), *KB = (bf16_t*)(ws + WS_KB), *VB = (bf16_t*)(ws + WS_VB);
    bf16_t *OG = (bf16_t*)(ws + WS_OG), *SG = (bf16_t*)(ws + WS_SG), *QA = (bf16_t*)(ws + WS_QA), *KA = (bf16_t*)(ws + WS_KA), *A2 = (bf16_t*)(ws + WS_A2), *MB = (bf16_t*)(ws + WS_MB);
    float *LR = (float*)(ws + WS_LR), *BCF = (float*)(ws + WS_BCF), *BCB = (float*)(ws + WS_BCB), *OF = (float*)(ws + WS_OF), *OB = (float*)(ws + WS_OB), *M1 = (float*)(ws + WS_M1);
    float *PRE1 = (float*)(ws + WS_PRE1), *H1F = (float*)(ws + WS_H1F), *GATE = (float*)(ws + WS_GATE), *H2F = (float*)(ws + WS_H2F), *PP = (float*)(ws + WS_PP), *PRE3 = (float*)(ws + WS_PRE3);
    int* DEST = (int*)(ws + WS_DEST); bf16_t *H2B = (bf16_t*)(ws + WS_H2B), *PB = (bf16_t*)(ws + WS_PB), *XROWS = (bf16_t*)(ws + WS_XROWS), *YROWS = (bf16_t*)(ws + WS_XROWS), *ACT = (bf16_t*)(ws + WS_ACT);
    float* SC = (float*)(ws + WS_ACT);
    (void)hipMemsetAsync(ws + WS_CTL, 0, 1 * MiB, stream);

    constexpr int FAST = FAST_MASK;
    static const int stage_flags[13] = {F_TR | F_LN0, F_INPROJ, F_PREP, F_ATTN | F_GLA, F_GLA | F_YA, F_YB, F_WO, F_LN1, F_UP, F_DOWN, F_LN2, F_PLE, F_LN3};
    int pend_lo = -1, li = 0;
    MegaArgs a{};
    for (int i = 0; i < 29; ++i) a.in[i] = (const float*)d_in[i];
    a.out = out; a.ws = (unsigned char*)d_ws; a.flags = FAST;
#define FLUSH(hi_) do { if (pend_lo >= 0) { a.ph_lo = pend_lo; a.ph_hi = (hi_); a.li = li++; hipLaunchKernelGGL(mega, dim3(grid), dim3(NTHR), LDS_BYTES, stream, a); pend_lo = -1; } } while (0)
    for (int s = 0; s < 13; ++s) {
        switch (s) {
        case 0: if (!(FAST & F_LN0)) { FLUSH(s); hipLaunchKernelGGL(k_ln0, dim3(T / 4), dim3(256), 0, stream, x, in_g, in_b, H0F, H0B);
                    hipLaunchKernelGGL(k_cvt, dim3(2048), dim3(256), 0, stream, p, PB, (size_t)T * PLE); } break;
        case 1: if (!(FAST & F_INPROJ)) { FLUSH(s); EpiInproj e{QAR, KAR, VA, QB, KB, VB, OG, SG, LR};
                    hipLaunchKernelGGL((naive_gemm<bf16_t, float, false, false, EpiInproj>), dim3((INW + 63) / 64, T / 64, 1), dim3(256), 0, stream, H0B, (size_t)D, (size_t)0, w_in, (size_t)INW, (size_t)0, (const float*)nullptr, T, (const unsigned*)nullptr, INW, D, e); } break;
        case 2: if (!(FAST & F_PREP)) { FLUSH(s); hipLaunchKernelGGL(k_qkprep, dim3(T * 10 / 4), dim3(256), 0, stream, QAR, KAR, qn, kn, QA, KA);
                    hipLaunchKernelGGL(k_glacum, dim3(NB * 32 * 4), dim3(256), 0, stream, LR, wlf, blf, wlb, blb, BCF, BCB); } break;
        case 3: if (!(FAST & F_ATTN)) { FLUSH(s);
                    for (int b = 0; b < NB; ++b) for (int kvh = 0; kvh < 2; ++kvh) { EpiScores es{SC + (size_t)(b * 8 + kvh * 4) * SEQ * SEQ};
                        hipLaunchKernelGGL((naive_gemm<bf16_t, bf16_t, true, false, EpiScores>), dim3(SEQ / 64, SEQ / 64, 4), dim3(256), 0, stream, QA + (size_t)b * SEQ * 1024 + kvh * 4 * 128, (size_t)1024, (size_t)128,
                                           KA + (size_t)b * SEQ * 256 + kvh * 128, (size_t)256, (size_t)0, (const bf16_t*)nullptr, SEQ, (const unsigned*)nullptr, SEQ, 128, es); }
                    hipLaunchKernelGGL(k_softmax_rows, dim3(16 * SEQ / 4), dim3(256), 0, stream, SC);
                    for (int b = 0; b < NB; ++b) for (int kvh = 0; kvh < 2; ++kvh) { EpiAttnOut eo{A2, b, kvh};
                        hipLaunchKernelGGL((naive_gemm<float, bf16_t, false, false, EpiAttnOut>), dim3(128 / 64, SEQ / 64, 4), dim3(256), 0, stream, SC + (size_t)(b * 8 + kvh * 4) * SEQ * SEQ, (size_t)SEQ, (size_t)SEQ * SEQ,
                                           VA + (size_t)b * SEQ * 256 + kvh * 128, (size_t)256, (size_t)0, (const bf16_t*)nullptr, SEQ, (const unsigned*)nullptr, 128, SEQ, eo); } }
                if (!(FAST & F_GLA)) { FLUSH(s); hipLaunchKernelGGL(k_gla_naive, dim3(16), dim3(256), 0, stream, QB, KB, VB, LR, wlf, blf, wlb, blb, OF, OB); } break;
        case 4: if (!(FAST & F_GLA)) { FLUSH(s); hipLaunchKernelGGL(k_gla_combine, dim3(T * 4 / 4), dim3(256), 0, stream, OF, OB, OG, gn, A2); }
                if (!(FAST & F_YA)) { FLUSH(s); EpiYa e{SG, M1}; hipLaunchKernelGGL((naive_gemm<bf16_t, float, false, false, EpiYa>), dim3(D / 64, T / 64, 1), dim3(256), 0, stream, A2, (size_t)2048, (size_t)0, wba, (size_t)D, (size_t)0, (const float*)nullptr, T, (const unsigned*)nullptr, D, 1024, e); } break;
        case 5: if (!(FAST & F_YB)) { FLUSH(s); EpiYb e{SG, M1, MB}; hipLaunchKernelGGL((naive_gemm<bf16_t, float, false, false, EpiYb>), dim3(D / 64, T / 64, 1), dim3(256), 0, stream, A2 + 1024, (size_t)2048, (size_t)0, wbb, (size_t)D, (size_t)0, (const float*)nullptr, T, (const unsigned*)nullptr, D, 1024, e); } break;
        case 6: if (!(FAST & F_WO)) { FLUSH(s); EpiRes e{H0F, PRE1}; hipLaunchKernelGGL((naive_gemm<bf16_t, float, false, false, EpiRes>), dim3(D / 64, T / 64, 1), dim3(256), 0, stream, MB, (size_t)D, (size_t)0, wo, (size_t)D, (size_t)0, (const float*)nullptr, T, (const unsigned*)nullptr, D, D, e); } break;
        case 7: if (!(FAST & F_LN1)) { FLUSH(s); hipLaunchKernelGGL(k_ln1_router, dim3(T / 4), dim3(256), 0, stream, PRE1, l1g, l1b, wr, br, H1F, XROWS, DEST, GATE, ctl); } break;
        case 8: if (!(FAST & F_UP)) { FLUSH(s); EpiUp e{bup, ACT}; hipLaunchKernelGGL((naive_gemm<bf16_t, float, false, true, EpiUp>), dim3(2048 / 64, CAP / 64, NE), dim3(256), 0, stream, XROWS, (size_t)D, (size_t)CAP * D, wup, (size_t)4096, (size_t)D * 4096, wup + 2048, CAP, (const unsigned*)(ctl + CW_CNT), 2048, D, e); } break;
        case 9: if (!(FAST & F_DOWN)) { FLUSH(s); EpiDown e{bdn, YROWS}; hipLaunchKernelGGL((naive_gemm<bf16_t, float, false, false, EpiDown>), dim3(2048 / 64, CAP / 64, NE), dim3(256), 0, stream, ACT, (size_t)D, (size_t)CAP * D, wdn, (size_t)D, (size_t)D * D, (const float*)nullptr, CAP, (const unsigned*)(ctl + CW_CNT), D, D, e); } break;
        case 10: if (!(FAST & F_LN2)) { FLUSH(s); hipLaunchKernelGGL(k_combine_ln2, dim3(T / 4), dim3(256), 0, stream, H1F, YROWS, DEST, GATE, l2g, l2b, H2F, H2B); } break;
        case 11: if (!(FAST & F_PLE)) { FLUSH(s); { EpiF32 e{PP}; hipLaunchKernelGGL((naive_gemm<bf16_t, float, false, false, EpiF32>), dim3(D / 64, T / 64, 1), dim3(256), 0, stream, PB, (size_t)PLE, (size_t)0, wpp, (size_t)D, (size_t)0, (const float*)nullptr, T, (const unsigned*)nullptr, D, PLE, e); }
                     { EpiPle e{H2F, PP, PRE3}; hipLaunchKernelGGL((naive_gemm<bf16_t, float, false, false, EpiPle>), dim3(D / 64, T / 64, 1), dim3(256), 0, stream, H2B, (size_t)D, (size_t)0, wpg, (size_t)D, (size_t)0, (const float*)nullptr, T, (const unsigned*)nullptr, D, D, e); } } break;
        case 12: if (!(FAST & F_LN3)) { FLUSH(s); hipLaunchKernelGGL(k_ln_out, dim3(T / 4), dim3(256), 0, stream, PRE3, l3g, l3b, out); } break;
        }
        if (FAST & stage_flags[s]) { if (pend_lo < 0) pend_lo = s; } else { FLUSH(s); }
    }
    FLUSH(13);
#undef FLUSH
}
```

```cpp
#include <hip/hip_runtime.h>
#include <cstdio>
#include <cstdint>
#ifndef FAST_MASK
#define FAST_MASK 32767
#endif

typedef unsigned short bf16_t;
typedef short bf16x8 __attribute__((ext_vector_type(8)));
typedef float f32x4 __attribute__((ext_vector_type(4)));

constexpr int T = 8192, D = 2048, SEQ = 4096, NB = 2;
constexpr int INW = 8736, PLE = 256, NE = 32, TOPK = 4, CAP = 8192;
constexpr float DN_ALPHA = 1.189207115002721f;
constexpr float LN_EPS = 1e-5f, RMS_EPS = 1e-6f;

constexpr size_t MiB = 1ull << 20;
constexpr size_t WS_CTL = 0;
constexpr size_t WS_H0F = 16 * MiB;
constexpr size_t WS_H0B = WS_H0F + 64 * MiB;
constexpr size_t WS_QAR = WS_H0B + 32 * MiB;
constexpr size_t WS_KAR = WS_QAR + 16 * MiB;
constexpr size_t WS_VA  = WS_KAR + 4 * MiB;
constexpr size_t WS_QB  = WS_VA + 4 * MiB;
constexpr size_t WS_KB  = WS_QB + 8 * MiB;
constexpr size_t WS_VB  = WS_KB + 8 * MiB;
constexpr size_t WS_OG  = WS_VB + 16 * MiB;
constexpr size_t WS_SG  = WS_OG + 16 * MiB;
constexpr size_t WS_LR  = WS_SG + 64 * MiB;
constexpr size_t WS_QA  = WS_LR + 1 * MiB;
constexpr size_t WS_KA  = WS_QA + 16 * MiB;
constexpr size_t WS_BCF = WS_KA + 4 * MiB;
constexpr size_t WS_BCB = WS_BCF + 16 * MiB;
constexpr size_t WS_OF  = WS_BCB + 16 * MiB;
constexpr size_t WS_OB  = WS_OF + 32 * MiB;
constexpr size_t WS_A2  = WS_OB + 32 * MiB;
constexpr size_t WS_M1  = WS_A2 + 32 * MiB;
constexpr size_t WS_MB  = WS_M1 + 64 * MiB;
constexpr size_t WS_PRE1 = WS_MB + 32 * MiB;
constexpr size_t WS_H1F = WS_PRE1 + 64 * MiB;
constexpr size_t WS_DEST = WS_H1F + 64 * MiB;
constexpr size_t WS_GATE = WS_DEST + 1 * MiB;
constexpr size_t WS_H2F = WS_GATE + 1 * MiB;
constexpr size_t WS_H2B = WS_H2F + 64 * MiB;
constexpr size_t WS_PB  = WS_H2B + 32 * MiB;
constexpr size_t WS_PP  = WS_PB + 4 * MiB;
constexpr size_t WS_PRE3 = WS_PP + 64 * MiB;
constexpr size_t WS_XROWS = 1024 * MiB;
constexpr size_t WS_ACT = 2048 * MiB;
constexpr size_t WS_END = 3072 * MiB;
static_assert(WS_PRE3 + 64 * MiB <= WS_XROWS, "ws map");
constexpr int CW_CNT = 1024;

__device__ __forceinline__ float bf2f(bf16_t b) { return __uint_as_float(((unsigned)b) << 16); }
__device__ __forceinline__ bf16_t f2bf(float f) { unsigned u = __float_as_uint(f); u += 0x7fffu + ((u >> 16) & 1u); return (bf16_t)(u >> 16); }
__device__ __forceinline__ float wave_sum(float v) {
#pragma unroll
    for (int o = 1; o < 64; o <<= 1) v += __shfl_xor(v, o);
    return v;
}
__device__ __forceinline__ float sigm(float x) { return 1.f / (1.f + __expf(-x)); }
__device__ __forceinline__ float tof(float x) { return x; }
__device__ __forceinline__ float tof(bf16_t x) { return bf2f(x); }

__device__ __forceinline__ void ln_row(float4 (&v)[8], const float* g, const float* b, int lane) {
    float s = 0.f;
#pragma unroll
    for (int j = 0; j < 8; ++j) s += (v[j].x + v[j].y) + (v[j].z + v[j].w);
    const float mean = wave_sum(s) * (1.f / D);
    float s2 = 0.f;
#pragma unroll
    for (int j = 0; j < 8; ++j) { v[j].x -= mean; v[j].y -= mean; v[j].z -= mean; v[j].w -= mean; s2 += (v[j].x * v[j].x + v[j].y * v[j].y) + (v[j].z * v[j].z + v[j].w * v[j].w); }
    const float rstd = 1.f / sqrtf(wave_sum(s2) * (1.f / D) + LN_EPS);
#pragma unroll
    for (int j = 0; j < 8; ++j) { const float4 gg = ((const float4*)g)[lane + 64 * j], bb = ((const float4*)b)[lane + 64 * j];
        v[j].x = v[j].x * rstd * gg.x + bb.x; v[j].y = v[j].y * rstd * gg.y + bb.y; v[j].z = v[j].z * rstd * gg.z + bb.z; v[j].w = v[j].w * rstd * gg.w + bb.w; }
}
__device__ __forceinline__ void store_row_fp8(const float4 (&v)[8], unsigned char* p, int lane) {
#pragma unroll
    for (int j = 0; j < 8; ++j) { int w = 0; w = __builtin_amdgcn_cvt_pk_fp8_f32(v[j].x, v[j].y, w, false); w = __builtin_amdgcn_cvt_pk_fp8_f32(v[j].z, v[j].w, w, true); ((unsigned*)p)[lane + 64 * j] = (unsigned)w; }
}
__device__ __forceinline__ void ln_row_lowreg(float4 (&v)[8], const float* g, const float* b, int lane) {
    float s = 0.f;
#pragma unroll
    for (int j = 0; j < 8; ++j) s += (v[j].x + v[j].y) + (v[j].z + v[j].w);
    const float mean = wave_sum(s) * (1.f / D);
    float s2 = 0.f;
#pragma unroll
    for (int j = 0; j < 8; ++j) { v[j].x -= mean; v[j].y -= mean; v[j].z -= mean; v[j].w -= mean; s2 += (v[j].x * v[j].x + v[j].y * v[j].y) + (v[j].z * v[j].z + v[j].w * v[j].w); }
    const float rstd = 1.f / sqrtf(wave_sum(s2) * (1.f / D) + LN_EPS);
#pragma unroll
    for (int j = 0; j < 8; ++j) { const float4 gg = ((const float4*)g)[lane + 64 * j], bb = ((const float4*)b)[lane + 64 * j];
        v[j].x = v[j].x * rstd * gg.x + bb.x; v[j].y = v[j].y * rstd * gg.y + bb.y; v[j].z = v[j].z * rstd * gg.z + bb.z; v[j].w = v[j].w * rstd * gg.w + bb.w;
        asm volatile("" ::: "memory"); }
}
__device__ __forceinline__ void load_row(float4 (&v)[8], const float* p, int lane) {
#pragma unroll
    for (int j = 0; j < 8; ++j) v[j] = ((const float4*)p)[lane + 64 * j];
}
__device__ __forceinline__ void store_row_f32(const float4 (&v)[8], float* p, int lane) {
#pragma unroll
    for (int j = 0; j < 8; ++j) ((float4*)p)[lane + 64 * j] = v[j];
}
__device__ __forceinline__ void store_row_bf16(const float4 (&v)[8], bf16_t* p, int lane) {
#pragma unroll
    for (int j = 0; j < 8; ++j) { uint2 w; w.x = (unsigned)f2bf(v[j].x) | ((unsigned)f2bf(v[j].y) << 16); w.y = (unsigned)f2bf(v[j].z) | ((unsigned)f2bf(v[j].w) << 16);
        ((uint2*)p)[lane + 64 * j] = w; }
}

__global__ __launch_bounds__(256) void k_ln0(const float* x, const float* g, const float* b, float* h0f, bf16_t* h0b) {
    const int lane = threadIdx.x & 63, row = blockIdx.x * 4 + (threadIdx.x >> 6);
    float4 v[8]; load_row(v, x + (size_t)row * D, lane); ln_row(v, g, b, lane);
    store_row_f32(v, h0f + (size_t)row * D, lane); store_row_bf16(v, h0b + (size_t)row * D, lane);
}
__global__ __launch_bounds__(256) void k_cvt(const float* in, bf16_t* out, size_t n) {
    for (size_t i = (size_t)blockIdx.x * 256 + threadIdx.x; i < n; i += (size_t)gridDim.x * 256) out[i] = f2bf(in[i]);
}

template <class AT, class BT, bool BTRANS, bool DUAL, class Epi>
__global__ __launch_bounds__(256) void naive_gemm(const AT* A, size_t lda, size_t sA, const BT* B, size_t ldb, size_t sB, const BT* B2,
                                                  int M, const unsigned* Mdev, int N, int K, Epi epi) {
    __shared__ __attribute__((aligned(16))) bf16_t sa[64][40];
    __shared__ __attribute__((aligned(16))) bf16_t sb[64][40];
    __shared__ __attribute__((aligned(16))) bf16_t sb2[DUAL ? 64 : 1][40];
    const int batch = blockIdx.z;
    if (Mdev) M = (int)Mdev[64 * batch];
    const int m0 = blockIdx.y * 64, n0 = blockIdx.x * 64;
    if (m0 >= M) return;
    A += (size_t)batch * sA; B += (size_t)batch * sB; if (DUAL) B2 += (size_t)batch * sB;
    const int tid = threadIdx.x, w = tid >> 6, lane = tid & 63, fr = lane & 15, fq = lane >> 4;
    f32x4 acc[4], acc2[4];
#pragma unroll
    for (int c = 0; c < 4; ++c) { acc[c] = (f32x4){0.f, 0.f, 0.f, 0.f}; acc2[c] = (f32x4){0.f, 0.f, 0.f, 0.f}; }
    for (int k0 = 0; k0 < K; k0 += 32) {
        { const int r = tid >> 2, c0 = (tid & 3) * 8; const bool ok = (m0 + r) < M;
#pragma unroll
          for (int j = 0; j < 8; ++j) sa[r][c0 + j] = ok ? f2bf(tof(A[(size_t)(m0 + r) * lda + k0 + c0 + j])) : (bf16_t)0; }
        if (BTRANS) { const int r = tid >> 2, c0 = (tid & 3) * 8; const bool ok = (n0 + r) < N;
#pragma unroll
          for (int j = 0; j < 8; ++j) { sb[r][c0 + j] = ok ? f2bf(tof(B[(size_t)(n0 + r) * ldb + k0 + c0 + j])) : (bf16_t)0;
              if (DUAL) sb2[r][c0 + j] = ok ? f2bf(tof(B2[(size_t)(n0 + r) * ldb + k0 + c0 + j])) : (bf16_t)0; } }
        else { const int k = tid >> 3, nc = (tid & 7) * 8;
#pragma unroll
          for (int j = 0; j < 8; ++j) { const bool ok = (n0 + nc + j) < N; sb[nc + j][k] = ok ? f2bf(tof(B[(size_t)(k0 + k) * ldb + n0 + nc + j])) : (bf16_t)0;
              if (DUAL) sb2[nc + j][k] = ok ? f2bf(tof(B2[(size_t)(k0 + k) * ldb + n0 + nc + j])) : (bf16_t)0; } }
        __syncthreads();
        const bf16x8 a = *(const bf16x8*)&sa[16 * w + fr][8 * fq];
#pragma unroll
        for (int c = 0; c < 4; ++c) { const bf16x8 b = *(const bf16x8*)&sb[16 * c + fr][8 * fq];
            acc[c] = __builtin_amdgcn_mfma_f32_16x16x32_bf16(a, b, acc[c], 0, 0, 0);
            if (DUAL) { const bf16x8 b2 = *(const bf16x8*)&sb2[16 * c + fr][8 * fq]; acc2[c] = __builtin_amdgcn_mfma_f32_16x16x32_bf16(a, b2, acc2[c], 0, 0, 0); } }
        __syncthreads();
    }
#pragma unroll
    for (int c = 0; c < 4; ++c)
#pragma unroll
        for (int j = 0; j < 4; ++j) { const int row = m0 + 16 * w + 4 * fq + j, col = n0 + 16 * c + fr;
            if (row < M && col < N) epi(row, col, acc[c][j], acc2[c][j], batch); }
}

struct EpiInproj { bf16_t *qar, *kar, *va, *qb, *kb, *vb, *og, *sg; float* lr;
    __device__ void operator()(int row, int col, float v, float, int) const {
        const size_t r = (size_t)row;
        if (col < 1024) qar[r * 1024 + col] = f2bf(v);
        else if (col < 1280) kar[r * 256 + col - 1024] = f2bf(v);
        else if (col < 1536) va[r * 256 + col - 1280] = f2bf(v);
        else if (col < 2048) qb[r * 512 + col - 1536] = f2bf(v);
        else if (col < 2560) kb[r * 512 + col - 2048] = f2bf(v);
        else if (col < 3584) vb[r * 1024 + col - 2560] = f2bf(v);
        else if (col < 4608) og[r * 1024 + col - 3584] = f2bf(v);
        else if (col < 4640) lr[r * 32 + col - 4608] = v;
        else if (col < 6688) sg[r * 4096 + col - 4640] = f2bf(sigm(v));
        else sg[r * 4096 + 2048 + col - 6688] = f2bf(sigm(v));
    } };

__global__ __launch_bounds__(256) void k_qkprep(const bf16_t* qar, const bf16_t* kar, const float* qn, const float* kn, bf16_t* qa, bf16_t* ka) {
    const int lane = threadIdx.x & 63, gw = blockIdx.x * 4 + (threadIdx.x >> 6), t = gw / 10, hd = gw % 10;
    const bf16_t* src; bf16_t* dst; const float* gn;
    if (hd < 8) { src = qar + (size_t)t * 1024 + hd * 128; dst = qa + (size_t)t * 1024 + hd * 128; gn = qn; }
    else { src = kar + (size_t)t * 256 + (hd - 8) * 128; dst = ka + (size_t)t * 256 + (hd - 8) * 128; gn = kn; }
    const unsigned pr = ((const unsigned*)src)[lane];
    float x0 = bf2f((bf16_t)(pr & 0xffff)), x1 = bf2f((bf16_t)(pr >> 16));
    const float ss = wave_sum(x0 * x0 + x1 * x1), r = 1.f / sqrtf(ss * (1.f / 128.f) + RMS_EPS);
    x0 = x0 * r * gn[2 * lane]; x1 = x1 * r * gn[2 * lane + 1];
    const int s = t & (SEQ - 1), pos = (lane < 32) ? (s >> 6) : (s & 63);
    const float invf = exp2f(-(float)(lane & 31) * (13.287712379549449f / 32.f));
    float rev = (float)pos * invf * 0.15915494309189535f; rev -= floorf(rev);
    const float sn = __builtin_amdgcn_sinf(rev), cs = __builtin_amdgcn_cosf(rev);
    const float o0 = x0 * cs - x1 * sn, o1 = x0 * sn + x1 * cs;
    ((unsigned*)dst)[lane] = (unsigned)f2bf(o0) | ((unsigned)f2bf(o1) << 16);
}

__device__ __forceinline__ float logsig(float x) { return fminf(x, 0.f) - __logf(1.f + __expf(-fabsf(x))); }
__global__ __launch_bounds__(256) void k_glacum(const float* lr, const float* wf, const float* bfv, const float* wb, const float* bbv, float* bcf, float* bcb) {
    __shared__ float lrs[128][32];
    const int h = blockIdx.x & 3, ck = blockIdx.x >> 2, t0 = ck * 128, tid = threadIdx.x, dir = tid >> 7, d = tid & 127, ch = h * 128 + d;
    for (int i = tid; i < 128 * 32; i += 256) lrs[i >> 5][i & 31] = lr[(size_t)t0 * 32 + i];
    float w[16]; const float* W = dir ? wb : wf;
#pragma unroll
    for (int r = 0; r < 16; ++r) w[r] = W[r * 512 + ch];
    const float bias = dir ? bbv[ch] : bfv[ch];
    __syncthreads();
    float acc = 0.f; float* out = dir ? bcb : bcf;
    for (int ii = 0; ii < 128; ++ii) { const int i = dir ? 127 - ii : ii; float x = bias;
#pragma unroll
        for (int r = 0; r < 16; ++r) x += lrs[i][dir * 16 + r] * w[r];
        acc += logsig(x) * (1.f / 16.f); out[(size_t)(t0 + i) * 512 + ch] = acc; }
}
__global__ __launch_bounds__(256) void k_gla_naive(const bf16_t* qb, const bf16_t* kb, const bf16_t* vb, const float* lr, const float* wf, const float* bfv, const float* wb, const float* bbv,
                                                   float* of, float* ob) {
    __shared__ float qs[128], ks[128], dec[128];
    const int dir = blockIdx.x & 1, h = (blockIdx.x >> 1) & 3, b = blockIdx.x >> 3, e = threadIdx.x;
    float w[16]; float bias = 0.f;
    if (e < 128) { const float* W = dir ? wb : wf;
#pragma unroll
        for (int r = 0; r < 16; ++r) w[r] = W[r * 512 + h * 128 + e];
        bias = dir ? bbv[h * 128 + e] : bfv[h * 128 + e]; }
    else {
#pragma unroll
        for (int r = 0; r < 16; ++r) w[r] = 0.f; }
    float S[128];
#pragma unroll
    for (int d = 0; d < 128; ++d) S[d] = 0.f;
    float* out = dir ? ob : of;
    for (int ii = 0; ii < SEQ; ++ii) { const int t = b * SEQ + (dir ? SEQ - 1 - ii : ii);
        if (e < 128) { float x = bias;
#pragma unroll
            for (int r = 0; r < 16; ++r) x += lr[(size_t)t * 32 + dir * 16 + r] * w[r];
            dec[e] = __expf(logsig(x) * (1.f / 16.f));
            qs[e] = bf2f(qb[(size_t)t * 512 + h * 128 + e]) * 0.08838834764831845f; ks[e] = bf2f(kb[(size_t)t * 512 + h * 128 + e]); }
        __syncthreads();
        const float v = bf2f(vb[(size_t)t * 1024 + h * 256 + e]); float o = 0.f;
#pragma unroll
        for (int d = 0; d < 128; ++d) { S[d] = S[d] * dec[d] + ks[d] * v; o += qs[d] * S[d]; }
        out[(size_t)t * 1024 + h * 256 + e] = o;
        __syncthreads(); }
}
__global__ __launch_bounds__(256) void k_gla_combine(const float* of, const float* ob, const bf16_t* og, const float* gn, bf16_t* a2) {
    const int lane = threadIdx.x & 63, gw = blockIdx.x * 4 + (threadIdx.x >> 6), t = gw >> 2, h = gw & 3;
    const size_t base = (size_t)t * 1024 + h * 256 + lane * 4;
    const float4 a = *(const float4*)(of + base), c = *(const float4*)(ob + base);
    float o[4] = {a.x + c.x, a.y + c.y, a.z + c.z, a.w + c.w};
    const float ss = wave_sum(o[0] * o[0] + o[1] * o[1] + o[2] * o[2] + o[3] * o[3]), r = 1.f / sqrtf(ss * (1.f / 256.f) + RMS_EPS);
#pragma unroll
    for (int j = 0; j < 4; ++j) { const float g = bf2f(og[base + j]); a2[(size_t)t * 2048 + 1024 + h * 256 + lane * 4 + j] = f2bf(o[j] * r * gn[lane * 4 + j] * (g * sigm(g))); }
}
struct EpiScores { float* sc; __device__ void operator()(int row, int col, float v, float, int batch) const { sc[((size_t)batch * SEQ + row) * SEQ + col] = v * 0.08838834764831845f; } };
__global__ __launch_bounds__(256) void k_softmax_rows(float* sc) {
    const int lane = threadIdx.x & 63; float* p = sc + ((size_t)blockIdx.x * 4 + (threadIdx.x >> 6)) * SEQ;
    float m = -1e30f; for (int i = lane; i < SEQ; i += 64) m = fmaxf(m, p[i]);
#pragma unroll
    for (int o = 1; o < 64; o <<= 1) m = fmaxf(m, __shfl_xor(m, o));
    float s = 0.f; for (int i = lane; i < SEQ; i += 64) { const float e = __expf(p[i] - m); p[i] = e; s += e; }
    s = 1.f / wave_sum(s); for (int i = lane; i < SEQ; i += 64) p[i] *= s;
}
struct EpiAttnOut { bf16_t* a2; int b, kvh; __device__ void operator()(int row, int col, float v, float, int g) const { a2[((size_t)b * SEQ + row) * 2048 + (kvh * 4 + g) * 128 + col] = f2bf(v); } };
struct EpiYa { const bf16_t* sg; float* m1; __device__ void operator()(int row, int col, float v, float, int) const { m1[(size_t)row * 2048 + col] = bf2f(sg[(size_t)row * 4096 + col]) * v; } };
struct EpiYb { const bf16_t* sg; const float* m1; bf16_t* mb; __device__ void operator()(int row, int col, float v, float, int) const {
    mb[(size_t)row * 2048 + col] = f2bf(m1[(size_t)row * 2048 + col] + bf2f(sg[(size_t)row * 4096 + 2048 + col]) * v); } };
struct EpiRes { const float* base; float* out; __device__ void operator()(int row, int col, float v, float, int) const { const size_t i = (size_t)row * 2048 + col; out[i] = DN_ALPHA * base[i] + v; } };

__global__ __launch_bounds__(256) void k_ln1_router(const float* pre1, const float* g, const float* b, const float* wr, const float* br, float* h1f, bf16_t* xrows,
                                                    int* dest, float* gate, unsigned* ctl) {
    const int lane = threadIdx.x & 63, row = blockIdx.x * 4 + (threadIdx.x >> 6);
    float4 v[8]; load_row(v, pre1 + (size_t)row * D, lane); ln_row(v, g, b, lane); store_row_f32(v, h1f + (size_t)row * D, lane);
    float mylogit = -1e30f;
    for (int e = 0; e < NE; ++e) { float s = 0.f;
#pragma unroll
        for (int j = 0; j < 8; ++j) { const int d0 = (lane + 64 * j) * 4; s += v[j].x * wr[(d0 + 0) * NE + e] + v[j].y * wr[(d0 + 1) * NE + e] + v[j].z * wr[(d0 + 2) * NE + e] + v[j].w * wr[(d0 + 3) * NE + e]; }
        s = wave_sum(s) + br[e]; if (lane == e) mylogit = s; }
    float tv[4]; int ti[4]; float cur = mylogit;
#pragma unroll
    for (int k = 0; k < 4; ++k) { float bv = cur; int bi = lane;
#pragma unroll
        for (int o = 1; o < 64; o <<= 1) { const float ov = __shfl_xor(bv, o); const int oi = __shfl_xor(bi, o); if (ov > bv || (ov == bv && oi < bi)) { bv = ov; bi = oi; } }
        tv[k] = bv; ti[k] = bi; if (lane == bi) cur = -1e30f; }
    float ge[4], gs = 0.f;
#pragma unroll
    for (int k = 0; k < 4; ++k) { ge[k] = __expf(tv[k] - tv[0]); gs += ge[k]; }
    int dst[4];
#pragma unroll
    for (int k = 0; k < 4; ++k) { unsigned slot = 0; if (lane == 0) slot = __hip_atomic_fetch_add(ctl + CW_CNT + 64 * ti[k], 1u, __ATOMIC_RELAXED, __HIP_MEMORY_SCOPE_AGENT);
        slot = __shfl(slot, 0); dst[k] = ti[k] * CAP + (int)slot; }
    if (lane < 4) { const int k = lane; int dd = dst[0]; float gg = ge[0];
        if (k == 1) { dd = dst[1]; gg = ge[1]; } if (k == 2) { dd = dst[2]; gg = ge[2]; } if (k == 3) { dd = dst[3]; gg = ge[3]; }
        dest[row * 4 + k] = dd; gate[row * 4 + k] = gg / gs; }
#pragma unroll
    for (int k = 0; k < 4; ++k) store_row_bf16(v, xrows + (size_t)dst[k] * D, lane);
}
struct EpiUp { const float* bup; bf16_t* act; __device__ void operator()(int row, int col, float g, float lin, int e) const {
    g += bup[e * 4096 + col]; lin += bup[e * 4096 + 2048 + col]; g = fminf(g, 7.f); lin = fminf(fmaxf(lin, -7.f), 7.f);
    act[((size_t)e * CAP + row) * 2048 + col] = f2bf(g * sigm(1.702f * g) * (lin + 1.f)); } };
struct EpiDown { const float* bdn; bf16_t* y; __device__ void operator()(int row, int col, float v, float, int e) const { y[((size_t)e * CAP + row) * 2048 + col] = f2bf(v + bdn[e * 2048 + col]); } };
__global__ __launch_bounds__(256) void k_combine_ln2(const float* h1f, const bf16_t* y, const int* dest, const float* gate, const float* g, const float* b, float* h2f, bf16_t* h2b) {
    const int lane = threadIdx.x & 63, row = blockIdx.x * 4 + (threadIdx.x >> 6);
    float4 v[8]; load_row(v, h1f + (size_t)row * D, lane);
#pragma unroll
    for (int j = 0; j < 8; ++j) { v[j].x *= DN_ALPHA; v[j].y *= DN_ALPHA; v[j].z *= DN_ALPHA; v[j].w *= DN_ALPHA; }
    for (int k = 0; k < 4; ++k) { const bf16_t* yr = y + (size_t)dest[row * 4 + k] * D; const float gk = gate[row * 4 + k];
#pragma unroll
        for (int j = 0; j < 8; ++j) { const uint2 w = ((const uint2*)yr)[lane + 64 * j];
            v[j].x += gk * bf2f((bf16_t)(w.x & 0xffff)); v[j].y += gk * bf2f((bf16_t)(w.x >> 16)); v[j].z += gk * bf2f((bf16_t)(w.y & 0xffff)); v[j].w += gk * bf2f((bf16_t)(w.y >> 16)); } }
    ln_row(v, g, b, lane); store_row_f32(v, h2f + (size_t)row * D, lane); store_row_bf16(v, h2b + (size_t)row * D, lane);
}
struct EpiF32 { float* out; __device__ void operator()(int row, int col, float v, float, int) const { out[(size_t)row * 2048 + col] = v; } };
struct EpiPle { const float* h2f; const float* pp; float* out; __device__ void operator()(int row, int col, float v, float, int) const { const size_t i = (size_t)row * 2048 + col; out[i] = DN_ALPHA * h2f[i] + sigm(v) * pp[i]; } };
__global__ __launch_bounds__(256) void k_ln_out(const float* in, const float* g, const float* b, float* out) {
    const int lane = threadIdx.x & 63, row = blockIdx.x * 4 + (threadIdx.x >> 6);
    float4 v[8]; load_row(v, in + (size_t)row * D, lane); ln_row(v, g, b, lane); store_row_f32(v, out + (size_t)row * D, lane);
}

namespace pg8 {
#define PG8_LAS __attribute__((address_space(3)))
typedef unsigned u32x4 __attribute__((ext_vector_type(4)));
constexpr int BM = 256, BK = 64, HALF = 128, HTB = HALF * BK * 2  , STAGE_BYTES = 8 * HTB, NXCD = 8, WGM = 8;
__host__ __device__ __forceinline__ int lds_byte(int r, int c) { const int st = (r >> 4) * 2 + (c >> 5), rr = r & 15, cc = c & 31, ob = rr * 64 + cc * 2; return st * 1024 + (ob ^ (((ob >> 9) & 1) << 5)); }
__host__ __device__ __forceinline__ void stage_rc(int b, int& R, int& C) { const int st = b / 1024, sb = b % 1024, swz = sb ^ (((sb >> 9) & 1) << 5); R = (st >> 1) * 16 + swz / 64; C = (st & 1) * 32 + (swz % 64) / 2; }
__host__ __device__ __forceinline__ int perm32(int rho) { const int n = rho >> 4, i = rho & 15; return 8 * (i >> 2) + 4 * n + (i & 3); }
struct Unit { int pm, pn; };
struct Gemm { const bf16_t* A; const bf16_t* Bt; int M, N, K; };
struct StaticOrder {
    int nM, nN, nwg, G, c;
    __host__ __device__ void init(int M, int N, int G_, int c_) { nM = M / BM; nN = N / BM; nwg = nM * nN; G = G_; c = c_; }
    __host__ __device__ bool next(int i, Unit& u) const {
        const long L = (long)i * G + c; if (L >= nwg) return false;
        int wgid = (int)L; { const int q = nwg / NXCD, r = nwg % NXCD, xcd = wgid % NXCD, off = wgid / NXCD; wgid = (xcd < r ? xcd * (q + 1) : r * (q + 1) + (xcd - r) * q) + off; }
        const int nig = WGM * nN, gid = wgid / nig, fm = gid * WGM, gsz = (nM - fm) < WGM ? (nM - fm) : WGM;
        u.pm = fm + ((wgid % nig) % gsz); u.pn = (wgid % nig) / gsz; return true;
    }
    __device__ __forceinline__ const char* abase(const Gemm& g, const Unit& u, size_t tstep) const { return (const char*)g.A + (size_t)u.pm * tstep; }
    __device__ __forceinline__ const char* bbase(const Gemm& g, const Unit& u, size_t tstep) const { return (const char*)g.Bt + (size_t)u.pn * tstep; }
    __device__ __forceinline__ void a_ready(const Unit&) const {}
    __device__ __forceinline__ void done(const Unit&) const {}
};
struct MoeOrder {
    const PG8_LAS int* tp; int NT, G, c; size_t bstride;
    __device__ __forceinline__ int tpr(int i) const { return __builtin_amdgcn_readfirstlane(tp[i]); }
    __device__ bool next(int i, Unit& u) const {
        const int total = NT * tpr(32); const long L = (long)i * G + c; if (L >= total) return false;
        int wgid = (int)L; { const int q = total / NXCD, r = total % NXCD, xcd = wgid % NXCD, off = wgid / NXCD; wgid = (xcd < r ? xcd * (q + 1) : r * (q + 1) + (xcd - r) * q) + off; }
        int e = 0; while (e < 31 && wgid >= NT * tpr(e + 1)) ++e;
        const int t0 = tpr(e), local = wgid - NT * t0, nte = tpr(e + 1) - t0;
        u.pn = local / nte; u.pm = e * 32 + local % nte; return true;
    }
    __device__ __forceinline__ const char* abase(const Gemm& g, const Unit& u, size_t tstep) const { return (const char*)g.A + (size_t)u.pm * tstep; }
    __device__ __forceinline__ const char* bbase(const Gemm& g, const Unit& u, size_t tstep) const { return (const char*)g.Bt + (size_t)(u.pm >> 5) * bstride + (size_t)u.pn * tstep; }
    __device__ __forceinline__ void a_ready(const Unit&) const {}
    __device__ __forceinline__ void done(const Unit&) const {}
};
__device__ __forceinline__ unsigned cvt_pk_bf16(float lo, float hi) { unsigned r; asm volatile("v_cvt_pk_bf16_f32 %0, %1, %2" : "=v"(r) : "v"(lo), "v"(hi)); return r; }
typedef int v8i __attribute__((ext_vector_type(8)));
typedef int v4i __attribute__((ext_vector_type(4)));
__device__ __forceinline__ v8i cat8(bf16x8 a, bf16x8 b) { const v4i x = __builtin_bit_cast(v4i, a), y = __builtin_bit_cast(v4i, b); return __builtin_shufflevector(x, y, 0, 1, 2, 3, 4, 5, 6, 7); }
__device__ __forceinline__ unsigned pk_fp8x4(float a, float b, float c, float d) { int w = 0; w = __builtin_amdgcn_cvt_pk_fp8_f32(a, b, w, false); w = __builtin_amdgcn_cvt_pk_fp8_f32(c, d, w, true); return (unsigned)w; }
constexpr float W8_SCALE = 256.f, W8_INV = 1.f / 256.f;
__device__ __forceinline__ float bflo(unsigned w) { return __uint_as_float(w << 16); }
__device__ __forceinline__ float bfhi(unsigned w) { return __uint_as_float(w & 0xffff0000u); }
typedef const f32x4 (&AccRef)[2][2][4][2];

struct EpiInprojF { static constexpr bool PERM = true, AFTER_DRAIN = false;
    bf16_t *qar, *kar, *va, *qb, *kb, *vb, *og, *sg; float* lr;
    __device__ __forceinline__ void operator()(AccRef acc, const Unit& u, int wr, int wc, int fr, int fq) const {
        const int pn = u.pn, row0 = u.pm * BM + wr * 64 + fr;
        if (pn >= 34) {
            if (wc == 0) {
#pragma unroll
                for (int ai = 0; ai < 2; ++ai)
#pragma unroll
                    for (int m = 0; m < 4; ++m) { float* rp = lr + (size_t)(row0 + ai * HALF + m * 16) * 32 + 8 * fq;
                        *(f32x4*)(rp) = acc[ai][0][m][0]; *(f32x4*)(rp + 4) = acc[ai][0][m][1]; } }
            return; }
        bf16_t* base; int ld, coff; bool sgm = false;
        if (pn < 4) { base = qar; ld = 1024; coff = pn * 256; }
        else if (pn == 4) { base = kar; ld = 256; coff = 0; }
        else if (pn == 5) { base = va; ld = 256; coff = 0; }
        else if (pn < 8) { base = qb; ld = 512; coff = (pn - 6) * 256; }
        else if (pn < 10) { base = kb; ld = 512; coff = (pn - 8) * 256; }
        else if (pn < 14) { base = vb; ld = 1024; coff = (pn - 10) * 256; }
        else if (pn < 18) { base = og; ld = 1024; coff = (pn - 14) * 256; }
        else { base = sg; ld = 4096; coff = (pn - 18) * 256; sgm = true; }
        const int col0 = coff + wc * 32 + 8 * fq;
#pragma unroll
        for (int ai = 0; ai < 2; ++ai)
#pragma unroll
            for (int m = 0; m < 4; ++m) { bf16_t* rowp = base + (size_t)(row0 + ai * HALF + m * 16) * ld + col0;
#pragma unroll
                for (int bj = 0; bj < 2; ++bj) { f32x4 v0 = acc[ai][bj][m][0], v1 = acc[ai][bj][m][1];
                    if (sgm) {
#pragma unroll
                        for (int j = 0; j < 4; ++j) { v0[j] = sigm(v0[j]); v1[j] = sigm(v1[j]); } }
                    u32x4 w; w.x = cvt_pk_bf16(v0[0], v0[1]); w.y = cvt_pk_bf16(v0[2], v0[3]); w.z = cvt_pk_bf16(v1[0], v1[1]); w.w = cvt_pk_bf16(v1[2], v1[3]);
                    *(u32x4*)(rowp + bj * HALF) = w; } }
    } };
struct EpiYaF { static constexpr bool PERM = true, AFTER_DRAIN = false; const bf16_t* sg; float* m1;
    __device__ __forceinline__ void operator()(AccRef acc, const Unit& u, int wr, int wc, int fr, int fq) const {
        const int row0 = u.pm * BM + wr * 64 + fr, col0 = u.pn * BM + wc * 32 + 8 * fq;
#pragma unroll
        for (int ai = 0; ai < 2; ++ai)
#pragma unroll
            for (int m = 0; m < 4; ++m) { const size_t r = (size_t)(row0 + ai * HALF + m * 16);
#pragma unroll
                for (int bj = 0; bj < 2; ++bj) { const int c = col0 + bj * HALF; const u32x4 s = *(const u32x4*)(sg + r * 4096 + c);
                    f32x4 o0, o1; o0[0] = bflo(s.x) * acc[ai][bj][m][0][0]; o0[1] = bfhi(s.x) * acc[ai][bj][m][0][1]; o0[2] = bflo(s.y) * acc[ai][bj][m][0][2]; o0[3] = bfhi(s.y) * acc[ai][bj][m][0][3];
                    o1[0] = bflo(s.z) * acc[ai][bj][m][1][0]; o1[1] = bfhi(s.z) * acc[ai][bj][m][1][1]; o1[2] = bflo(s.w) * acc[ai][bj][m][1][2]; o1[3] = bfhi(s.w) * acc[ai][bj][m][1][3];
                    *(f32x4*)(m1 + r * 2048 + c) = o0; *(f32x4*)(m1 + r * 2048 + c + 4) = o1; } }
    } };
struct EpiYbF { static constexpr bool PERM = true, AFTER_DRAIN = false; const bf16_t* sg; const float* m1; bf16_t* mb;
    __device__ __forceinline__ void operator()(AccRef acc, const Unit& u, int wr, int wc, int fr, int fq) const {
        const int row0 = u.pm * BM + wr * 64 + fr, col0 = u.pn * BM + wc * 32 + 8 * fq;
#pragma unroll
        for (int ai = 0; ai < 2; ++ai)
#pragma unroll
            for (int m = 0; m < 4; ++m) { const size_t r = (size_t)(row0 + ai * HALF + m * 16);
#pragma unroll
                for (int bj = 0; bj < 2; ++bj) { const int c = col0 + bj * HALF; const u32x4 s = *(const u32x4*)(sg + r * 4096 + 2048 + c);
                    const f32x4 a0 = *(const f32x4*)(m1 + r * 2048 + c), a1 = *(const f32x4*)(m1 + r * 2048 + c + 4);
                    const float o0 = a0[0] + bflo(s.x) * acc[ai][bj][m][0][0], o1 = a0[1] + bfhi(s.x) * acc[ai][bj][m][0][1], o2 = a0[2] + bflo(s.y) * acc[ai][bj][m][0][2], o3 = a0[3] + bfhi(s.y) * acc[ai][bj][m][0][3];
                    const float o4 = a1[0] + bflo(s.z) * acc[ai][bj][m][1][0], o5 = a1[1] + bfhi(s.z) * acc[ai][bj][m][1][1], o6 = a1[2] + bflo(s.w) * acc[ai][bj][m][1][2], o7 = a1[3] + bfhi(s.w) * acc[ai][bj][m][1][3];
                    u32x4 w; w.x = cvt_pk_bf16(o0, o1); w.y = cvt_pk_bf16(o2, o3); w.z = cvt_pk_bf16(o4, o5); w.w = cvt_pk_bf16(o6, o7);
                    *(u32x4*)(mb + r * 2048 + c) = w; } }
    } };
template <int MODE> struct EpiF32F { static constexpr bool PERM = false, AFTER_DRAIN = false; const float* base; const float* pp; float* out;
    __device__ __forceinline__ void operator()(AccRef acc, const Unit& u, int wr, int wc, int fr, int fq) const {
        const int row0 = u.pm * BM + wr * 64 + fr, col0 = u.pn * BM + wc * 32 + 4 * fq;
#pragma unroll
        for (int ai = 0; ai < 2; ++ai)
#pragma unroll
            for (int m = 0; m < 4; ++m) { const size_t ro = (size_t)(row0 + ai * HALF + m * 16) * 2048 + col0;
#pragma unroll
                for (int bj = 0; bj < 2; ++bj)
#pragma unroll
                    for (int n = 0; n < 2; ++n) { const size_t o = ro + bj * HALF + n * 16; f32x4 v = acc[ai][bj][m][n];
                        if (MODE == 1) { const f32x4 b = *(const f32x4*)(base + o); v = b * DN_ALPHA + v; }
                        if (MODE == 2) { const f32x4 b = *(const f32x4*)(base + o), q = *(const f32x4*)(pp + o);
#pragma unroll
                            for (int j = 0; j < 4; ++j) v[j] = DN_ALPHA * b[j] + sigm(v[j]) * q[j]; }
                        *(f32x4*)(out + o) = v; } }
    } };
struct EpiUpF { static constexpr bool PERM = true, AFTER_DRAIN = false; const float* bup; bf16_t* act;
    __device__ __forceinline__ void operator()(AccRef acc, const Unit& u, int wr, int wc, int fr, int fq) const {
        const int e = u.pm >> 5, row0 = u.pm * BM + wr * 64 + fr, cj = u.pn * 128 + wc * 32 + 8 * fq;
        const f32x4 bg0 = *(const f32x4*)(bup + e * 4096 + cj), bg1 = *(const f32x4*)(bup + e * 4096 + cj + 4), bl0 = *(const f32x4*)(bup + e * 4096 + 2048 + cj), bl1 = *(const f32x4*)(bup + e * 4096 + 2048 + cj + 4);
#pragma unroll
        for (int ai = 0; ai < 2; ++ai)
#pragma unroll
            for (int m = 0; m < 4; ++m) { const size_t r = (size_t)(row0 + ai * HALF + m * 16);
                const f32x4 g0 = acc[ai][0][m][0] + bg0, g1 = acc[ai][0][m][1] + bg1, l0 = acc[ai][1][m][0] + bl0, l1 = acc[ai][1][m][1] + bl1; float o[8];
#pragma unroll
                for (int j = 0; j < 4; ++j) { const float ga = fminf(g0[j], 7.f), la = fminf(fmaxf(l0[j], -7.f), 7.f); o[j] = ga * sigm(1.702f * ga) * (la + 1.f);
                    const float gb = fminf(g1[j], 7.f), lb = fminf(fmaxf(l1[j], -7.f), 7.f); o[4 + j] = gb * sigm(1.702f * gb) * (lb + 1.f); }
                u32x4 w; w.x = cvt_pk_bf16(o[0], o[1]); w.y = cvt_pk_bf16(o[2], o[3]); w.z = cvt_pk_bf16(o[4], o[5]); w.w = cvt_pk_bf16(o[6], o[7]);
                *(u32x4*)(act + r * 2048 + cj) = w; }
    } };
struct EpiUpF8 { static constexpr bool PERM = true, AFTER_DRAIN = false; const float* bup; unsigned char* act;
    __device__ __forceinline__ void operator()(AccRef acc, const Unit& u, int wr, int wc, int fr, int fq) const {
        const int e = u.pm >> 5, row0 = u.pm * BM + wr * 64 + fr, cj = u.pn * 128 + wc * 32 + 8 * fq;
        const f32x4 bg0 = *(const f32x4*)(bup + e * 4096 + cj), bg1 = *(const f32x4*)(bup + e * 4096 + cj + 4), bl0 = *(const f32x4*)(bup + e * 4096 + 2048 + cj), bl1 = *(const f32x4*)(bup + e * 4096 + 2048 + cj + 4);
#pragma unroll
        for (int ai = 0; ai < 2; ++ai)
#pragma unroll
            for (int m = 0; m < 4; ++m) { const size_t r = (size_t)(row0 + ai * HALF + m * 16);
                const f32x4 g0 = acc[ai][0][m][0] * W8_INV + bg0, g1 = acc[ai][0][m][1] * W8_INV + bg1, l0 = acc[ai][1][m][0] * W8_INV + bl0, l1 = acc[ai][1][m][1] * W8_INV + bl1; float o[8];
#pragma unroll
                for (int j = 0; j < 4; ++j) { const float ga = fminf(g0[j], 7.f), la = fminf(fmaxf(l0[j], -7.f), 7.f); o[j] = ga * sigm(1.702f * ga) * (la + 1.f);
                    const float gb = fminf(g1[j], 7.f), lb = fminf(fmaxf(l1[j], -7.f), 7.f); o[4 + j] = gb * sigm(1.702f * gb) * (lb + 1.f); }
                uint2 w; w.x = pk_fp8x4(o[0], o[1], o[2], o[3]); w.y = pk_fp8x4(o[4], o[5], o[6], o[7]);
                *(uint2*)(act + r * 2048 + cj) = w; }
    } };
struct EpiDownF8 { static constexpr bool PERM = true, AFTER_DRAIN = false; const float* bdn; bf16_t* y;
    __device__ __forceinline__ void operator()(AccRef acc, const Unit& u, int wr, int wc, int fr, int fq) const {
        const int e = u.pm >> 5, row0 = u.pm * BM + wr * 64 + fr, col0 = u.pn * BM + wc * 32 + 8 * fq;
        f32x4 bv[2][2];
#pragma unroll
        for (int bj = 0; bj < 2; ++bj)
#pragma unroll
            for (int n = 0; n < 2; ++n) bv[bj][n] = *(const f32x4*)(bdn + e * 2048 + col0 + bj * HALF + 4 * n);
#pragma unroll
        for (int ai = 0; ai < 2; ++ai)
#pragma unroll
            for (int m = 0; m < 4; ++m) { bf16_t* rowp = y + (size_t)(row0 + ai * HALF + m * 16) * 2048 + col0;
#pragma unroll
                for (int bj = 0; bj < 2; ++bj) { const f32x4 v0 = acc[ai][bj][m][0] * W8_INV + bv[bj][0], v1 = acc[ai][bj][m][1] * W8_INV + bv[bj][1];
                    u32x4 w; w.x = cvt_pk_bf16(v0[0], v0[1]); w.y = cvt_pk_bf16(v0[2], v0[3]); w.z = cvt_pk_bf16(v1[0], v1[1]); w.w = cvt_pk_bf16(v1[2], v1[3]);
                    *(u32x4*)(rowp + bj * HALF) = w; } }
    } };
struct EpiDownF { static constexpr bool PERM = true, AFTER_DRAIN = false; const float* bdn; bf16_t* y;
    __device__ __forceinline__ void operator()(AccRef acc, const Unit& u, int wr, int wc, int fr, int fq) const {
        const int e = u.pm >> 5, row0 = u.pm * BM + wr * 64 + fr, col0 = u.pn * BM + wc * 32 + 8 * fq;
        f32x4 bv[2][2];
#pragma unroll
        for (int bj = 0; bj < 2; ++bj)
#pragma unroll
            for (int n = 0; n < 2; ++n) bv[bj][n] = *(const f32x4*)(bdn + e * 2048 + col0 + bj * HALF + 4 * n);
#pragma unroll
        for (int ai = 0; ai < 2; ++ai)
#pragma unroll
            for (int m = 0; m < 4; ++m) { bf16_t* rowp = y + (size_t)(row0 + ai * HALF + m * 16) * 2048 + col0;
#pragma unroll
                for (int bj = 0; bj < 2; ++bj) { const f32x4 v0 = acc[ai][bj][m][0] + bv[bj][0], v1 = acc[ai][bj][m][1] + bv[bj][1];
                    u32x4 w; w.x = cvt_pk_bf16(v0[0], v0[1]); w.y = cvt_pk_bf16(v0[2], v0[3]); w.z = cvt_pk_bf16(v1[0], v1[1]); w.w = cvt_pk_bf16(v1[2], v1[3]);
                    *(u32x4*)(rowp + bj * HALF) = w; } }
    } };

template <class Epi, class Sched, bool STAMP = false, bool FP8 = false>
__device__ __forceinline__ void gemm_phase(PG8_LAS unsigned char* lds, const Gemm g, const Sched& S, const Epi& E, unsigned long long* stamps, int lda = 0) {
    const int tid = threadIdx.x, wid = __builtin_amdgcn_readfirstlane(tid >> 6), lane = tid & 63, wr = wid >> 2, wc = wid & 3, fr = lane & 15, fq = lane >> 4;
    const int K = g.K, nt = K / BK, LDA = lda ? lda : K;
    int ts_lo = 0, ts_hi = 0, nts = 0; const unsigned long long rt_entry = STAMP ? (unsigned long long)wall_clock64() : 0ull;
#define PG8_STAMP() do { if (STAMP && wid == 0 && nts < 64) { const unsigned long long _c = (unsigned long long)clock64(); \
        ts_lo = (lane == nts) ? (int)(unsigned)_c : ts_lo; ts_hi = (lane == nts) ? (int)(unsigned)(_c >> 32) : ts_hi; ++nts; } } while (0)
    PG8_STAMP();
    unsigned voffA[2], voffB[2];
#pragma unroll
    for (int i = 0; i < 2; ++i) { int R, C; stage_rc(tid * 16 + i * 8192, R, C); const int Rb = Epi::PERM ? ((R & ~31) + perm32(R & 31)) : R;
        voffA[i] = (unsigned)(R * LDA + C) * 2u; voffB[i] = (unsigned)(Rb * K + C) * 2u; }
    const size_t kstep = (size_t)(BK * 2);
    const size_t hstep = (size_t)HALF * K * 2;
    const size_t tstep = 2 * hstep;
    const size_t hstepA = (size_t)HALF * LDA * 2, tstepA = 2 * hstepA;
    const unsigned ldsw = (unsigned)wid * 1024u;
    const int aoff = lds_byte(wr * 64 + fr, fq * 8), boff = lds_byte(wc * 32 + fr, fq * 8);
#define PG8_SA(b, h) (((b) * 2 + (h)) * HTB)
#define PG8_SB(b, h) ((4 + (b) * 2 + (h)) * HTB)
#define PG8_STAGE(bufoff, gbase, voff) do { _Pragma("unroll") for (int _i = 0; _i < 2; ++_i) \
        __builtin_amdgcn_global_load_lds((const unsigned*)((const char*)(gbase) + (voff)[_i]), (PG8_LAS unsigned*)(lds + (bufoff) + ldsw + _i * 8192), 16, 0, 0); } while (0)
#define PG8_LDA(dst, b, h) do { _Pragma("unroll") for (int m = 0; m < 4; ++m) { const bf16x8 x0_ = *(const PG8_LAS bf16x8*)(lds + PG8_SA(b, h) + aoff + m * 2048), x1_ = *(const PG8_LAS bf16x8*)(lds + PG8_SA(b, h) + aoff + m * 2048 + 1024); \
        if constexpr (FP8) dst##8[m] = cat8(x0_, x1_); else { dst[m][0] = x0_; dst[m][1] = x1_; } } } while (0)
#define PG8_LDB(dst, b, h) do { _Pragma("unroll") for (int n = 0; n < 2; ++n) { const bf16x8 x0_ = *(const PG8_LAS bf16x8*)(lds + PG8_SB(b, h) + boff + n * 2048), x1_ = *(const PG8_LAS bf16x8*)(lds + PG8_SB(b, h) + boff + n * 2048 + 1024); \
        if constexpr (FP8) dst##8[n] = cat8(x0_, x1_); else { dst[n][0] = x0_; dst[n][1] = x1_; } } } while (0)
#define PG8_MMA(ai, bj, At, Bt) do { __builtin_amdgcn_s_setprio(1); _Pragma("unroll") for (int m = 0; m < 4; ++m) _Pragma("unroll") for (int n = 0; n < 2; ++n) { \
        if constexpr (FP8) asm volatile("v_mfma_f32_16x16x128_f8f6f4 %0, %1, %2, %0" : "+v"(acc[ai][bj][m][n]) : "v"(Bt##8[n]), "v"(At##8[m]));   \
        else { _Pragma("unroll") for (int k = 0; k < 2; ++k) acc[ai][bj][m][n] = __builtin_amdgcn_mfma_f32_16x16x32_bf16(Bt[n][k], At[m][k], acc[ai][bj][m][n], 0, 0, 0); } } __builtin_amdgcn_s_setprio(0); } while (0)
#define PG8_WAIT_V(n) asm volatile("s_waitcnt vmcnt(" #n ")" ::: "memory")
#define PG8_WAIT_L(n) asm volatile("s_waitcnt lgkmcnt(" #n ")" ::: "memory")
#define PG8_BAR __builtin_amdgcn_s_barrier()
#define PG8_SCHED __builtin_amdgcn_sched_barrier(0)
    Unit cur, nxt; int ui = 0;
    if (!S.next(0, cur)) return;
    f32x4 acc[2][2][4][2];
#pragma unroll
    for (int a = 0; a < 2; ++a)
#pragma unroll
        for (int b = 0; b < 2; ++b)
#pragma unroll
            for (int m = 0; m < 4; ++m)
#pragma unroll
                for (int n = 0; n < 2; ++n) acc[a][b][m][n] = (f32x4){0.f, 0.f, 0.f, 0.f};
    bf16x8 At[4][2], B0[2][2], B1[2][2]; v8i At8[4], B08[2], B18[2];
    const char* cA = S.abase(g, cur, tstepA); const char* cB = S.bbase(g, cur, tstep);
    S.a_ready(cur);
    PG8_STAGE(PG8_SB(0, 0), cB, voffB); PG8_STAGE(PG8_SA(0, 0), cA, voffA); PG8_STAGE(PG8_SB(0, 1), cB + hstep, voffB); PG8_STAGE(PG8_SA(0, 1), cA + hstepA, voffA);
    if (wr == 1) PG8_BAR;
    PG8_WAIT_V(4); PG8_BAR;
    PG8_STAGE(PG8_SB(1, 0), cB + kstep, voffB); PG8_STAGE(PG8_SA(1, 0), cA + kstep, voffA); PG8_STAGE(PG8_SB(1, 1), cB + hstep + kstep, voffB);
    PG8_WAIT_V(6); PG8_BAR;
    PG8_STAMP();
    for (;;) {
        const bool has_next = S.next(ui + 1, nxt);
        const char* nA = has_next ? S.abase(g, nxt, tstepA) : cA; const char* nB = has_next ? S.bbase(g, nxt, tstep) : cB;
        for (int t = 0; t < nt; t += 2) {
            const bool last = (t == nt - 2);
            const char* a1 = cA + (size_t)(t + 1) * kstep;
            const char* a2 = last ? nA : cA + (size_t)(t + 2) * kstep; const char* b2 = last ? nB : cB + (size_t)(t + 2) * kstep;
            const char* a3 = a2 + kstep; const char* b3 = b2 + kstep;
            if (last && has_next) S.a_ready(nxt);
            PG8_LDB(B0, 0, 0); PG8_SCHED; PG8_LDA(At, 0, 0); PG8_STAGE(PG8_SA(1, 1), a1 + hstepA, voffA);
            PG8_WAIT_L(8); PG8_BAR; PG8_WAIT_L(0); PG8_MMA(0, 0, At, B0); PG8_BAR; PG8_SCHED;
            PG8_LDB(B1, 0, 1); PG8_STAGE(PG8_SB(0, 0), b2, voffB);
            PG8_BAR; PG8_WAIT_L(0); PG8_MMA(0, 1, At, B1); PG8_BAR;
            PG8_LDA(At, 0, 1); PG8_STAGE(PG8_SA(0, 0), a2, voffA);
            PG8_BAR; PG8_WAIT_L(0); PG8_MMA(1, 0, At, B0); PG8_BAR; PG8_SCHED;
            PG8_STAGE(PG8_SB(0, 1), b2 + hstep, voffB);
            PG8_WAIT_V(6); PG8_BAR; PG8_MMA(1, 1, At, B1); PG8_BAR;
            PG8_LDB(B0, 1, 0); PG8_SCHED; PG8_LDA(At, 1, 0); PG8_STAGE(PG8_SA(0, 1), a2 + hstepA, voffA);
            PG8_WAIT_L(8); PG8_BAR; PG8_WAIT_L(0); PG8_MMA(0, 0, At, B0); PG8_BAR; PG8_SCHED;
            PG8_LDB(B1, 1, 1); PG8_STAGE(PG8_SB(1, 0), b3, voffB);
            PG8_BAR; PG8_WAIT_L(0); PG8_MMA(0, 1, At, B1); PG8_BAR;
            PG8_LDA(At, 1, 1); PG8_STAGE(PG8_SA(1, 0), a3, voffA);
            PG8_BAR; PG8_WAIT_L(0); PG8_MMA(1, 0, At, B0); PG8_BAR; PG8_SCHED;
            PG8_STAGE(PG8_SB(1, 1), b3 + hstep, voffB);
            PG8_WAIT_V(6); PG8_BAR; PG8_MMA(1, 1, At, B1); PG8_BAR;
        }
        PG8_STAMP();
        if constexpr (!Epi::AFTER_DRAIN) { E(acc, cur, wr, wc, fr, fq); S.done(cur); }
        PG8_STAMP();
        if (!has_next) break;
#pragma unroll
        for (int a = 0; a < 2; ++a)
#pragma unroll
            for (int b = 0; b < 2; ++b)
#pragma unroll
                for (int m = 0; m < 4; ++m)
#pragma unroll
                    for (int n = 0; n < 2; ++n) acc[a][b][m][n] = (f32x4){0.f, 0.f, 0.f, 0.f};
        cur = nxt; cA = nA; cB = nB; ++ui;
    }
    PG8_WAIT_V(0);
    if (wr == 0) PG8_BAR;
    PG8_BAR;
    if constexpr (Epi::AFTER_DRAIN) { E.fused(acc, cur, wr, wc, fr, fq, lds, wid, lane); S.done(cur); }
    PG8_STAMP();
    if (STAMP && wid == 0) { stamps[lane] = lane < nts ? (((unsigned long long)(unsigned)ts_hi << 32) | (unsigned)ts_lo) : 0ull;
        if (lane == 62) stamps[62] = rt_entry; if (lane == 63) stamps[63] = (unsigned long long)wall_clock64(); }
#undef PG8_STAMP
#undef PG8_SA
#undef PG8_SB
#undef PG8_STAGE
#undef PG8_LDA
#undef PG8_LDB
#undef PG8_MMA
#undef PG8_WAIT_V
#undef PG8_WAIT_L
#undef PG8_BAR
#undef PG8_SCHED
}

}

namespace attn {
using bf16 = bf16_t;
constexpr int   D = 128, NW = 8, QBLK = 32, KVBLK = 64;
constexpr float SCALE = 0.088388347648318440f;
constexpr float THR = 8.f;
constexpr int SDEPTH = 2;
constexpr int LDQ = 1024, LDK = 256, LDO = 2048;
constexpr size_t SHM_V = KVBLK * D * 2, SHM_K = KVBLK * D * 2, SHM_ATTN = 2 * SHM_V + 2 * SHM_K + NW * 64 * 4;
using bf16x8 = __attribute__((ext_vector_type(8))) short;
using s16x4  = __attribute__((ext_vector_type(4))) short;
using f32x16 = __attribute__((ext_vector_type(16))) float;
using f32x8  = __attribute__((ext_vector_type(8))) float;
using u32x4  = __attribute__((ext_vector_type(4))) unsigned;
#define KSWZ(row, colB) ((row) * 256 + ((colB) ^ (((row) & 7) << 4)))
#define SBAR() __builtin_amdgcn_sched_barrier(0)
__device__ __forceinline__ int crow(int r, int hi) { return (r & 3) + 8 * (r >> 2) + 4 * hi; }
__device__ __forceinline__ unsigned cvtpk(float lo, float hi) {
  unsigned r; asm volatile("v_cvt_pk_bf16_f32 %0, %1, %2" : "=v"(r) : "v"(lo), "v"(hi)); return r;
}
__device__ __forceinline__ void partialSM(f32x16& p0, f32x16& p1, float& m_reg, float& mn, float& alpha) {
  constexpr float C = SCALE * 1.4426950408889634f;
  float pmax = p0[0]; for (int r = 1; r < 16; ++r) pmax = fmaxf(pmax, p0[r]); for (int r = 0; r < 16; ++r) pmax = fmaxf(pmax, p1[r]);
  { auto rr = __builtin_amdgcn_permlane32_swap(__float_as_uint(pmax), __float_as_uint(pmax), false, false);
    pmax = fmaxf(__uint_as_float(rr[0]), __uint_as_float(rr[1])); }
  if (__builtin_expect(__all(pmax - m_reg <= THR / SCALE), 1)) { mn = m_reg; alpha = 1.f; }
  else { mn = fmaxf(m_reg, pmax); alpha = __builtin_amdgcn_exp2f((m_reg - mn) * C); m_reg = mn; }
  float mnC = -mn * C;
  for (int r = 0; r < 16; ++r) p0[r] = fmaf(p0[r], C, mnC); for (int r = 0; r < 16; ++r) p1[r] = fmaf(p1[r], C, mnC);
  for (int r = 0; r < 16; ++r) p0[r] = __builtin_amdgcn_exp2f(p0[r]);
}
__device__ __forceinline__ void finishSM(f32x16& p0, f32x16& p1, float alpha, float& l_reg, bf16x8& pa0, bf16x8& pa1, bf16x8& pa2, bf16x8& pa3) {
  for (int r = 0; r < 16; ++r) p1[r] = __builtin_amdgcn_exp2f(p1[r]);
  float ps = 0; for (int r = 0; r < 16; ++r) ps += p0[r]; for (int r = 0; r < 16; ++r) ps += p1[r];
  { auto rr = __builtin_amdgcn_permlane32_swap(__float_as_uint(ps), __float_as_uint(ps), false, false);
    ps = __uint_as_float(rr[0]) + __uint_as_float(rr[1]); }
  l_reg = l_reg * alpha + ps;
#define PK4(P, BASE, OUT) do { unsigned a0 = cvtpk(P[BASE + 0], P[BASE + 1]), a1 = cvtpk(P[BASE + 2], P[BASE + 3]);   \
    unsigned b0 = cvtpk(P[BASE + 4], P[BASE + 5]), b1 = cvtpk(P[BASE + 6], P[BASE + 7]);                              \
    auto r0 = __builtin_amdgcn_permlane32_swap(a0, b0, false, false); auto r1 = __builtin_amdgcn_permlane32_swap(a1, b1, false, false); \
    u32x4 w = {r0[0], r1[0], r0[1], r1[1]}; OUT = *reinterpret_cast<bf16x8*>(&w); } while (0)
  PK4(p0, 0, pa0); PK4(p0, 8, pa1); PK4(p1, 0, pa2); PK4(p1, 8, pa3);
#undef PK4
}
__device__ __forceinline__ void qkt(f32x16& p0, f32x16& p1, const bf16* Ks, const bf16x8* qr, int r32, int hi) {
  p0 = f32x16{}; p1 = f32x16{};
  for (int d0 = 0; d0 < 8; ++d0) { int cb = (d0 * 16 + hi * 8) * 2;
    bf16x8 b0 = *reinterpret_cast<const bf16x8*>((const char*)Ks + KSWZ(r32, cb));
    bf16x8 b1 = *reinterpret_cast<const bf16x8*>((const char*)Ks + KSWZ(32 + r32, cb));
    p0 = __builtin_amdgcn_mfma_f32_32x32x16_bf16(b0, qr[d0], p0, 0, 0, 0);
    p1 = __builtin_amdgcn_mfma_f32_32x32x16_bf16(b1, qr[d0], p1, 0, 0, 0); }
}
__device__ __forceinline__ int v_st(int k, int c) { const int kk = (k & ~0xC) | ((k & 4) << 1) | ((k & 8) >> 1); return ((kk >> 3) * 4 + (c >> 5)) * 512 + ((kk & 7) * 32 + (c & 31)) * 2; }
__device__ __forceinline__ int v_rd_base(int lane) { return ((lane & 3) << 3) | (((lane >> 2) & 3) << 6) | (((lane >> 4) & 1) << 5) | (((lane >> 5) & 1) << 8); }
constexpr int v_rd_off(int d0, int ks, int half) { return d0 * 512 + ks * 4096 + half * 2048; }
template <int OFF> __device__ __forceinline__ s16x4 tr_read(int vb) {
  s16x4 r; asm volatile("ds_read_b64_tr_b16 %0, %1 offset:%2" : "=&v"(r) : "v"(vb), "i"(OFF) : "memory"); return r;
}
template <int D0> __device__ __forceinline__ void pv_one(f32x16& od, int vb, bf16x8 pa0, bf16x8 pa1, bf16x8 pa2, bf16x8 pa3) {
  const s16x4 l0 = tr_read<v_rd_off(D0, 0, 0)>(vb), h0 = tr_read<v_rd_off(D0, 0, 1)>(vb), l1 = tr_read<v_rd_off(D0, 1, 0)>(vb), h1 = tr_read<v_rd_off(D0, 1, 1)>(vb);
  const s16x4 l2 = tr_read<v_rd_off(D0, 2, 0)>(vb), h2 = tr_read<v_rd_off(D0, 2, 1)>(vb), l3 = tr_read<v_rd_off(D0, 3, 0)>(vb), h3 = tr_read<v_rd_off(D0, 3, 1)>(vb);
  asm volatile("s_waitcnt lgkmcnt(0)" ::: "memory"); SBAR();
#define PK(L, H) (bf16x8){L[0], L[1], L[2], L[3], H[0], H[1], H[2], H[3]}
  od = __builtin_amdgcn_mfma_f32_32x32x16_bf16(pa0, PK(l0, h0), od, 0, 0, 0);
  od = __builtin_amdgcn_mfma_f32_32x32x16_bf16(pa1, PK(l1, h1), od, 0, 0, 0);
  od = __builtin_amdgcn_mfma_f32_32x32x16_bf16(pa2, PK(l2, h2), od, 0, 0, 0);
  od = __builtin_amdgcn_mfma_f32_32x32x16_bf16(pa3, PK(l3, h3), od, 0, 0, 0);
#undef PK
}
__device__ __forceinline__ void pv_d0(f32x16* o, int vb, bf16x8 pa0, bf16x8 pa1, bf16x8 pa2, bf16x8 pa3) {
  pv_one<0>(o[0], vb, pa0, pa1, pa2, pa3); pv_one<1>(o[1], vb, pa0, pa1, pa2, pa3); pv_one<2>(o[2], vb, pa0, pa1, pa2, pa3); pv_one<3>(o[3], vb, pa0, pa1, pa2, pa3);
}
__device__ __forceinline__ void attn_dense_body(const bf16* __restrict__ Qb, const bf16* __restrict__ Kh, const bf16* __restrict__ Vh,
                                                bf16* __restrict__ Ob, int seq, char* lds) {
  const int tid = threadIdx.x, wid = tid >> 6, lane = tid & 63, r32 = lane & 31, hi = lane >> 5;
  bf16* V_lds = (bf16*)lds; bf16* K_lds = (bf16*)(lds + 2 * SHM_V);
  float* ws = (float*)(lds + 2 * SHM_V + 2 * SHM_K) + wid * 64; float* li_l = ws; float* al_l = ws + 32;
  float m_reg = -1e30f, l_reg = 0; f32x16 o[4] = {}; bf16x8 qr[8];
  const bf16* Qw = Qb + (long)(wid * QBLK + r32) * LDQ + hi * 8;
#pragma unroll
  for (int d0 = 0; d0 < 8; ++d0) qr[d0] = *reinterpret_cast<const bf16x8*>(Qw + d0 * 16);
  const int sr = tid >> 4, sc = (tid & 15) * 8, vst0 = v_st(sr, sc), vst1 = v_st(32 + sr, sc);
  const int vb0 = (int)(uintptr_t)V_lds + v_rd_base(lane);
  struct { bf16x8 vs0, vs1, ks0, ks1; } sr_[SDEPTH];
#define SLOAD(i, k0) do { sr_[i].vs0 = *reinterpret_cast<const bf16x8*>(&Vh[(long)((k0) + sr) * LDK + sc]); sr_[i].vs1 = *reinterpret_cast<const bf16x8*>(&Vh[(long)((k0) + 32 + sr) * LDK + sc]); \
    sr_[i].ks0 = *reinterpret_cast<const bf16x8*>(&Kh[(long)((k0) + sr) * LDK + sc]); sr_[i].ks1 = *reinterpret_cast<const bf16x8*>(&Kh[(long)((k0) + 32 + sr) * LDK + sc]); } while (0)
#define SWRITE(b, i) do { *(bf16x8*)((char*)V_lds + (b) * SHM_V + vst0) = sr_[i].vs0;          \
    *(bf16x8*)((char*)V_lds + (b) * SHM_V + vst1) = sr_[i].vs1; int kc = sc * 2;               \
    *(bf16x8*)((char*)K_lds + (b) * SHM_K + KSWZ(sr, kc)) = sr_[i].ks0;                       \
    *(bf16x8*)((char*)K_lds + (b) * SHM_K + KSWZ(32 + sr, kc)) = sr_[i].ks1; } while (0)
#define SWAIT() do { if constexpr (SDEPTH == 2) asm volatile("s_waitcnt vmcnt(4)" ::: "memory"); else asm volatile("s_waitcnt vmcnt(0)" ::: "memory"); } while (0)
#define RESC(a) do { if (__any((a) < 1.f)) { if (hi == 0) al_l[r32] = (a); asm volatile("s_waitcnt lgkmcnt(0)" ::: "memory"); \
    for (int d = 0; d < 4; ++d) for (int r = 0; r < 16; ++r) o[d][r] *= al_l[crow(r, hi)]; } } while (0)
  f32x16 pA0, pA1, pB0, pB1; float mnA, mnB, alA, alB; bf16x8 pa0, pa1, pa2, pa3; const int NT = seq / KVBLK;
  constexpr int SE = 0, SO = SDEPTH - 1;
  SLOAD(SE, 0); asm volatile("s_waitcnt vmcnt(0)" ::: "memory"); SWRITE(0, SE); __syncthreads();
  qkt(pA0, pA1, K_lds, qr, r32, hi); partialSM(pA0, pA1, m_reg, mnA, alA);
  SLOAD(SO, KVBLK); if constexpr (SDEPTH == 2) { if (2 < NT) SLOAD(SE, 2 * KVBLK); }
  SWAIT(); SWRITE(1, SO); __syncthreads();
  for (int j = 1; j + 1 < NT; j += 2) {
    SBAR(); qkt(pB0, pB1, (bf16*)((char*)K_lds + SHM_K), qr, r32, hi);
    finishSM(pA0, pA1, alA, l_reg, pa0, pa1, pa2, pa3); SBAR();
    SLOAD(SO, (j + SDEPTH) * KVBLK); SBAR();
    pv_d0(o, vb0, pa0, pa1, pa2, pa3); partialSM(pB0, pB1, m_reg, mnB, alB);
    __syncthreads(); SWAIT(); SWRITE(0, SE);
    RESC(alB); __syncthreads();
    SBAR(); qkt(pA0, pA1, K_lds, qr, r32, hi);
    finishSM(pB0, pB1, alB, l_reg, pa0, pa1, pa2, pa3); SBAR();
    if (SDEPTH == 1 || j + 3 < NT) SLOAD(SE, (j + 1 + SDEPTH) * KVBLK); SBAR();
    pv_d0(o, vb0 + (int)SHM_V, pa0, pa1, pa2, pa3); partialSM(pA0, pA1, m_reg, mnA, alA);
    __syncthreads(); SWAIT(); SWRITE(1, SO);
    RESC(alA); __syncthreads();
  }
  SBAR(); qkt(pB0, pB1, (bf16*)((char*)K_lds + SHM_K), qr, r32, hi);
  finishSM(pA0, pA1, alA, l_reg, pa0, pa1, pa2, pa3); SBAR();
  pv_d0(o, vb0, pa0, pa1, pa2, pa3); partialSM(pB0, pB1, m_reg, mnB, alB);
  __syncthreads(); RESC(alB);
  finishSM(pB0, pB1, alB, l_reg, pa0, pa1, pa2, pa3); SBAR();
  pv_d0(o, vb0 + (int)SHM_V, pa0, pa1, pa2, pa3);
  if (hi == 0) li_l[r32] = l_reg; asm volatile("s_waitcnt lgkmcnt(0)" ::: "memory");
  float rli[16];
#pragma unroll
  for (int r = 0; r < 16; ++r) rli[r] = __builtin_amdgcn_rcpf(li_l[crow(r, hi)]);
  bf16* Ow = Ob + (long)(wid * QBLK) * LDO;
#pragma unroll
  for (int r = 0; r < 16; ++r) { int orow = crow(r, hi);
    for (int d0 = 0; d0 < 4; ++d0) Ow[(long)orow * LDO + d0 * 32 + r32] = f2bf(o[d0][r] * rli[r]); }
#undef SLOAD
#undef SWRITE
#undef SWAIT
#undef RESC
}
}

#define XB_TMO      128
#define XB_XCNT(j)  (256  + 64 * (j))
#define XB_XSUB(j)  (1280 + 64 * (j))
#define XB_XGEN(j)  (2304 + 64 * (j))
#define XB_TOP      3328
#define XB_TOPGEN   3392
#define XCD_BAR_WORDS 3456
#define XB_SPIN_CAP (1u << 18)
#ifndef LAS
#define LAS __attribute__((address_space(3)))
#endif

__device__ __forceinline__ unsigned xb_ld(unsigned* p)              { return __hip_atomic_load(p, __ATOMIC_RELAXED, __HIP_MEMORY_SCOPE_AGENT); }
__device__ __forceinline__ unsigned xb_add(unsigned* p, unsigned v) { return __hip_atomic_fetch_add(p, v, __ATOMIC_RELAXED, __HIP_MEMORY_SCOPE_AGENT); }
__device__ __forceinline__ unsigned xb_xcc_id() { return (unsigned)__builtin_amdgcn_s_getreg((3 << 11) | 20) & 0xFu; }
#define XB_SPIN(cond, bar) do { unsigned _sp = 0; while (cond) { __builtin_amdgcn_s_sleep(1); \
    if ((++_sp & 255u) == 0u) { if (xb_ld(&(bar)[XB_TMO])) break; if (_sp > XB_SPIN_CAP) { atomicAdd(&(bar)[XB_TMO], 1u); break; } } } } while (0)

struct XcdBarrier {
    unsigned* bar; unsigned x;
    volatile LAS unsigned* st;
};

__device__ __forceinline__ XcdBarrier xcd_barrier_post(unsigned* bar, volatile LAS unsigned* st) {
    XcdBarrier b; b.bar = bar; b.x = xb_xcc_id(); b.st = st;
    if (threadIdx.x == 0) (void)xb_add(&bar[XB_XCNT(b.x)], 1u);
    return b;
}
__device__ __forceinline__ void xcd_barrier_complete(unsigned* bar, unsigned x, unsigned& nloc, unsigned& nx) {
    const unsigned G = gridDim.x * gridDim.y * gridDim.z;
    unsigned sum, cnt, mine, sp = 0u;
    for (;;) {
        sum = 0u; cnt = 0u; mine = 0u;
#pragma unroll
        for (unsigned j = 0; j < 16; ++j) { const unsigned c = xb_ld(&bar[XB_XCNT(j)]); sum += c; cnt += (c > 0u) ? 1u : 0u; mine = (j == x) ? c : mine; }
        if (sum == G) break;
        __builtin_amdgcn_s_sleep(1);
        if ((++sp & 255u) == 0u) { if (xb_ld(&bar[XB_TMO])) break; if (sp > XB_SPIN_CAP) { atomicAdd(&bar[XB_TMO], 1u); break; } }
    }
    nloc = mine > 0u ? mine : 1u; nx = cnt > 0u ? cnt : 1u;
}

__device__ __forceinline__ void xcd_barrier(const XcdBarrier& b) {
    asm volatile("s_waitcnt vmcnt(0)" ::: "memory");
    __syncthreads();
    if (threadIdx.x == 0) {
        unsigned* bar = b.bar;
        __builtin_amdgcn_s_waitcnt(0);
        unsigned nloc = b.st[0], nx = b.st[1];
        if (nloc == 0u) { xcd_barrier_complete(bar, b.x, nloc, nx); b.st[0] = nloc; b.st[1] = nx; }
        const unsigned old = xb_add(&bar[XB_XSUB(b.x)], 1u);
        const unsigned gen = old / nloc;
        if (old + 1u == (gen + 1u) * nloc) {
            __builtin_amdgcn_fence(__ATOMIC_RELEASE, "agent");
            asm volatile("s_waitcnt vmcnt(0)" ::: "memory");
            const unsigned og = xb_add(&bar[XB_TOP], 1u);
            const unsigned tg = og / nx;
            if (og + 1u == (tg + 1u) * nx) xb_add(&bar[XB_TOPGEN], 1u);
            else XB_SPIN(xb_ld(&bar[XB_TOPGEN]) == tg, bar);
            __builtin_amdgcn_fence(__ATOMIC_ACQUIRE, "agent");
            xb_add(&bar[XB_XGEN(b.x)], 1u);
            asm volatile("s_waitcnt vmcnt(0)" ::: "memory");
        } else {
            XB_SPIN(xb_ld(&bar[XB_XGEN(b.x)]) == gen, bar);
            __builtin_amdgcn_fence(__ATOMIC_ACQUIRE, "agent");
            asm volatile("s_waitcnt vmcnt(0)" ::: "memory");
        }
    }
    __syncthreads();
}

constexpr int NWAVES = 8, NTHR = 512;
constexpr int LDS_BYTES = 155648;
constexpr int LDS_TAB = 139264;
constexpr int LDS_BARW = LDS_BYTES - 64;
constexpr size_t WS_SST = 860 * MiB;
constexpr size_t WS_WT_IN = 896 * MiB;
constexpr size_t WS_WT_A = 932 * MiB, WS_WT_B = 936 * MiB, WS_WT_O = 940 * MiB, WS_WT_G = 948 * MiB, WS_WT_P = 956 * MiB;
constexpr size_t WS_WT_UP = 3072 * MiB;
constexpr size_t WS_WT_DN = 3584 * MiB;
constexpr size_t WS_END2 = 3840 * MiB;
constexpr int CW_BAR = 4096;
constexpr int NIN = 8960;
enum { F_TR = 1, F_LN0 = 2, F_INPROJ = 4, F_PREP = 8, F_ATTN = 16, F_GLA = 32, F_YA = 64, F_YB = 128, F_WO = 256, F_LN1 = 512, F_UP = 1024, F_DOWN = 2048, F_LN2 = 4096, F_PLE = 8192, F_LN3 = 16384 };

constexpr int KFLAGS = FAST_MASK;
struct MegaArgs { const float* in[29]; float* out; unsigned char* ws; int ph_lo, ph_hi, flags, li; };

#define LDS_WAIT() asm volatile("s_waitcnt lgkmcnt(0)" ::: "memory")
#define VM_WAIT() asm volatile("s_waitcnt vmcnt(0)" ::: "memory")

struct MapId { __device__ __forceinline__ int operator()(int n) const { return n; } };
struct MapIn { __device__ __forceinline__ int operator()(int n) const { return n < 4608 ? n : (n < 4640 ? 8704 + (n - 4608) : n - 32); } };
struct MapUp { __device__ __forceinline__ int operator()(int n) const { return n < 2048 ? ((n >> 7) << 8) + (n & 127) : (((n - 2048) >> 7) << 8) + 128 + ((n - 2048) & 127); } };
template <class Map> __device__ __forceinline__ void tr_item(const float* W, int K, int N, int k0, int n0, bf16_t* WT, Map map, LAS float* scr, int lane) {
    const int nc = (lane & 15) * 4, kr = lane >> 4; const bool okc = (n0 + nc) < N;
#pragma unroll 4
    for (int i = 0; i < 16; ++i) { const int k = kr + 4 * i; f32x4 v = (f32x4){0.f, 0.f, 0.f, 0.f};
        if (okc) v = *(const f32x4*)(W + (size_t)(k0 + k) * N + n0 + nc);
        scr[k * 65 + nc + 0] = v[0]; scr[k * 65 + nc + 1] = v[1]; scr[k * 65 + nc + 2] = v[2]; scr[k * 65 + nc + 3] = v[3]; }
    LDS_WAIT();
    const int c = lane & 7;
#pragma unroll 2
    for (int i = 0; i < 8; ++i) { const int n = (lane >> 3) + 8 * i;
        if (n0 + n < N) { const LAS float* s = scr + (8 * c) * 65 + n; pg8::u32x4 o;
            o.x = pg8::cvt_pk_bf16(s[0 * 65], s[1 * 65]); o.y = pg8::cvt_pk_bf16(s[2 * 65], s[3 * 65]); o.z = pg8::cvt_pk_bf16(s[4 * 65], s[5 * 65]); o.w = pg8::cvt_pk_bf16(s[6 * 65], s[7 * 65]);
            *(pg8::u32x4*)(WT + (size_t)map(n0 + n) * K + k0 + 8 * c) = o; } }
    LDS_WAIT();
}
template <class Map> __device__ __forceinline__ void tr_item8(const float* W, int K, int N, int k0, int n0, unsigned char* WT, Map map, LAS float* scr, int lane) {
    const int nc = (lane & 15) * 4, kr = lane >> 4;
#pragma unroll 4
    for (int i = 0; i < 16; ++i) { const int k = kr + 4 * i; const f32x4 v = *(const f32x4*)(W + (size_t)(k0 + k) * N + n0 + nc);
        scr[k * 65 + nc + 0] = v[0]; scr[k * 65 + nc + 1] = v[1]; scr[k * 65 + nc + 2] = v[2]; scr[k * 65 + nc + 3] = v[3]; }
    LDS_WAIT();
    const int c = lane & 7;
#pragma unroll 2
    for (int i = 0; i < 8; ++i) { const int n = (lane >> 3) + 8 * i; const LAS float* s = scr + (8 * c) * 65 + n; uint2 o;
        o.x = pg8::pk_fp8x4(s[0 * 65] * pg8::W8_SCALE, s[1 * 65] * pg8::W8_SCALE, s[2 * 65] * pg8::W8_SCALE, s[3 * 65] * pg8::W8_SCALE);
        o.y = pg8::pk_fp8x4(s[4 * 65] * pg8::W8_SCALE, s[5 * 65] * pg8::W8_SCALE, s[6 * 65] * pg8::W8_SCALE, s[7 * 65] * pg8::W8_SCALE);
        *(uint2*)(WT + (size_t)map(n0 + n) * K + k0 + 8 * c) = o; }
    LDS_WAIT();
}
__device__ __forceinline__ void ph_prologue(const MegaArgs& P, LAS unsigned char* lds, int gw, int NGW, int wave, int lane) {
    unsigned char* ws = P.ws;
    if (KFLAGS & F_TR) {
        LAS float* scr = (LAS float*)(lds + wave * 16640);
        constexpr int I_IN = 32 * 137, I_A = 16 * 32, I_O = 32 * 32, I_P = 4 * 32, I_UP = 32 * 64, I_DN = 32 * 32;
        constexpr int NDENSE = I_IN + 2 * I_A + 2 * I_O + I_P, NITEMS = NDENSE + NE * (I_UP + I_DN);
        for (int it = gw; it < NITEMS; it += NGW) {
            int r = it;
            if (r < I_IN) { tr_item(P.in[4], 2048, INW, (r / 137) * 64, (r % 137) * 64, (bf16_t*)(ws + WS_WT_IN), MapIn(), scr, lane); continue; } r -= I_IN;
            if (r < I_A) { tr_item(P.in[12], 1024, 2048, (r / 32) * 64, (r % 32) * 64, (bf16_t*)(ws + WS_WT_A), MapId(), scr, lane); continue; } r -= I_A;
            if (r < I_A) { tr_item(P.in[13], 1024, 2048, (r / 32) * 64, (r % 32) * 64, (bf16_t*)(ws + WS_WT_B), MapId(), scr, lane); continue; } r -= I_A;
            if (r < I_O) { tr_item(P.in[14], 2048, 2048, (r / 32) * 64, (r % 32) * 64, (bf16_t*)(ws + WS_WT_O), MapId(), scr, lane); continue; } r -= I_O;
            if (r < I_O) { tr_item(P.in[25], 2048, 2048, (r / 32) * 64, (r % 32) * 64, (bf16_t*)(ws + WS_WT_G), MapId(), scr, lane); continue; } r -= I_O;
            if (r < I_P) { tr_item(P.in[26], 256, 2048, (r / 32) * 64, (r % 32) * 64, (bf16_t*)(ws + WS_WT_P), MapId(), scr, lane); continue; } r -= I_P;
            if (r < NE * I_UP) { const int e = r / I_UP, q = r % I_UP;
                tr_item8(P.in[19] + (size_t)e * 2048 * 4096, 2048, 4096, (q / 64) * 64, (q % 64) * 64, (unsigned char*)(ws + WS_WT_UP) + (size_t)e * 4096 * 2048, MapUp(), scr, lane); continue; } r -= NE * I_UP;
            { const int e = r / I_DN, q = r % I_DN;
              tr_item8(P.in[21] + (size_t)e * 2048 * 2048, 2048, 2048, (q / 32) * 64, (q % 32) * 64, (unsigned char*)(ws + WS_WT_DN) + (size_t)e * 2048 * 2048, MapId(), scr, lane); }
        }
    }
    if (KFLAGS & F_LN0) {
        float* H0F = (float*)(ws + WS_H0F); bf16_t* H0B = (bf16_t*)(ws + WS_H0B); bf16_t* PB = (bf16_t*)(ws + WS_PB);
        for (int row = gw; row < T; row += NGW) { float4 v[8]; load_row(v, P.in[0] + (size_t)row * D, lane); ln_row(v, P.in[2], P.in[3], lane);
            store_row_f32(v, H0F + (size_t)row * D, lane); store_row_bf16(v, H0B + (size_t)row * D, lane); }
        for (int i = gw * 64 + lane; i < T * PLE / 4; i += NGW * 64) { const float4 v = ((const float4*)P.in[1])[i]; uint2 w; w.x = pg8::cvt_pk_bf16(v.x, v.y); w.y = pg8::cvt_pk_bf16(v.z, v.w); ((uint2*)PB)[i] = w; }
    }
}

__device__ __forceinline__ void ph_prep(const MegaArgs& P, LAS unsigned char* lds, int c, int gw, int NGW, int lane) {
    unsigned char* ws = P.ws;
    const bf16_t *QAR = (const bf16_t*)(ws + WS_QAR), *KAR = (const bf16_t*)(ws + WS_KAR); bf16_t *QA = (bf16_t*)(ws + WS_QA), *KA = (bf16_t*)(ws + WS_KA);
    const float *qn = P.in[5], *kn = P.in[6];
    for (int it = gw; it < T * 10; it += NGW) { const int t = it / 10, hd = it % 10;
        const bf16_t* src; bf16_t* dst; const float* gn;
        if (hd < 8) { src = QAR + (size_t)t * 1024 + hd * 128; dst = QA + (size_t)t * 1024 + hd * 128; gn = qn; }
        else { src = KAR + (size_t)t * 256 + (hd - 8) * 128; dst = KA + (size_t)t * 256 + (hd - 8) * 128; gn = kn; }
        const unsigned pr = ((const unsigned*)src)[lane];
        float x0 = pg8::bflo(pr), x1 = pg8::bfhi(pr);
        const float ss = wave_sum(x0 * x0 + x1 * x1), r = 1.f / sqrtf(ss * (1.f / 128.f) + RMS_EPS);
        x0 = x0 * r * gn[2 * lane]; x1 = x1 * r * gn[2 * lane + 1];
        const int s = t & (SEQ - 1), pos = (lane < 32) ? (s >> 6) : (s & 63);
        const float invf = exp2f(-(float)(lane & 31) * (13.287712379549449f / 32.f));
        float rev = (float)pos * invf * 0.15915494309189535f; rev -= floorf(rev);
        const float sn = __builtin_amdgcn_sinf(rev), cs = __builtin_amdgcn_cosf(rev);
        ((unsigned*)dst)[lane] = pg8::cvt_pk_bf16(x0 * cs - x1 * sn, x0 * sn + x1 * cs); }
    { const float* LR = (const float*)(ws + WS_LR); float* BCF = (float*)(ws + WS_BCF); float* BCB = (float*)(ws + WS_BCB);
      LAS float* lrs = (LAS float*)lds;
      const int tid = threadIdx.x;
      for (int u = c; u < NB * 32 * 4; u += gridDim.x) {
        const int h = u & 3, ck = u >> 2, t0 = ck * 128;
        __syncthreads();
        for (int i = tid; i < 128 * 32; i += NTHR) lrs[i] = LR[(size_t)t0 * 32 + i];
        __syncthreads();
        if (tid < 256) { const int dir = tid >> 7, d = tid & 127, ch = h * 128 + d;
            const float* W = dir ? P.in[9] : P.in[7]; const float bias = dir ? P.in[10][ch] : P.in[8][ch];
            float w[16];
#pragma unroll
            for (int r = 0; r < 16; ++r) w[r] = W[r * 512 + ch];
            float acc = 0.f; float* out = dir ? BCB : BCF;
            for (int ii = 0; ii < 128; ++ii) { const int i = dir ? 127 - ii : ii; float x = bias;
#pragma unroll
                for (int r = 0; r < 16; ++r) x += lrs[i * 32 + dir * 16 + r] * w[r];
                acc += logsig(x) * (1.f / 16.f); out[(size_t)(t0 + i) * 512 + ch] = acc; } }
      }
      __syncthreads(); }
}

__device__ __forceinline__ void gla_state_scan(const MegaArgs& P, LAS unsigned char* lds, int c) {
    unsigned char* ws = P.ws;
    const bf16_t *KBp = (const bf16_t*)(ws + WS_KB), *VBp = (const bf16_t*)(ws + WS_VB); bf16_t* SST = (bf16_t*)(ws + WS_SST);
    const int tid = threadIdx.x, w = __builtin_amdgcn_readfirstlane(tid >> 6), lane = tid & 63, fr = lane & 15, fq = lane >> 4;
    const int chain = c >> 4, sub = c & 15, b = chain >> 3, h = (chain >> 1) & 3, dir = chain & 1, d0 = (sub >> 2) * 32, e0 = (sub & 3) * 64, et = w >> 1, dt = w & 1;
    const float* BC = (const float*)(ws + (dir ? WS_BCB : WS_BCF));
    LAS bf16_t* Vt = (LAS bf16_t*)lds;
    LAS bf16_t* Kt = (LAS bf16_t*)(lds + 64 * 272);
    const int sj = tid >> 2, sec = (tid & 3) * 16, sdc = (tid & 3) * 8;
    f32x4 acc = (f32x4){0.f, 0.f, 0.f, 0.f};
    bf16x8 v0, v1, kk; f32x4 b0, b1, bl0, bl1; float gdec;
#define GLA_LOAD(ck_) do { const int t0_ = b * SEQ + 128 * (ck_), tr_ = t0_ + sj, tl_ = t0_ + (dir ? 0 : 127); \
        v0 = *(const bf16x8*)(VBp + (size_t)tr_ * 1024 + h * 256 + e0 + sec); v1 = *(const bf16x8*)(VBp + (size_t)tr_ * 1024 + h * 256 + e0 + sec + 8); \
        kk = *(const bf16x8*)(KBp + (size_t)tr_ * 512 + h * 128 + d0 + sdc); \
        b0 = *(const f32x4*)(BC + (size_t)tr_ * 512 + h * 128 + d0 + sdc); b1 = *(const f32x4*)(BC + (size_t)tr_ * 512 + h * 128 + d0 + sdc + 4); \
        bl0 = *(const f32x4*)(BC + (size_t)tl_ * 512 + h * 128 + d0 + sdc); bl1 = *(const f32x4*)(BC + (size_t)tl_ * 512 + h * 128 + d0 + sdc + 4); \
        gdec = BC[(size_t)tl_ * 512 + h * 128 + d0 + 16 * dt + fr]; } while (0)
    GLA_LOAD(dir ? 31 : 0);
    for (int cc = 0; cc < 32; ++cc) { const int ck = dir ? 31 - cc : cc;
        { bf16_t* sp = SST + ((size_t)(chain * 32 + ck) * 256 + e0 + 16 * et + 4 * fq) * 128 + d0 + 16 * dt + fr;
#pragma unroll
          for (int r = 0; r < 4; ++r) sp[r * 128] = f2bf(acc[r]); }
#pragma unroll
        for (int i = 0; i < 8; ++i) { Vt[(sec + i) * 136 + sj] = (bf16_t)v0[i]; Vt[(sec + 8 + i) * 136 + sj] = (bf16_t)v1[i]; }
#pragma unroll
        for (int i = 0; i < 8; ++i) { const float bl = i < 4 ? bl0[i & 3] : bl1[i & 3], bb = i < 4 ? b0[i & 3] : b1[i & 3];
            Kt[(sdc + i) * 136 + sj] = f2bf(bf2f((bf16_t)kk[i]) * __expf(bl - bb)); }
        const float g = __expf(gdec);
        if (cc + 1 < 32) GLA_LOAD(dir ? 30 - cc : cc + 1);
        __syncthreads();
        acc = acc * g;
#pragma unroll
        for (int ks = 0; ks < 4; ++ks) { const bf16x8 a = *(const LAS bf16x8*)(Vt + (16 * et + fr) * 136 + 32 * ks + 8 * fq), bb = *(const LAS bf16x8*)(Kt + (16 * dt + fr) * 136 + 32 * ks + 8 * fq);
            acc = __builtin_amdgcn_mfma_f32_16x16x32_bf16(a, bb, acc, 0, 0, 0); }
        __syncthreads(); }
#undef GLA_LOAD
}

__device__ __forceinline__ bf16x8 swz_frag(const LAS unsigned char* base, int row, int ks, int fq) { return *(const LAS bf16x8*)(base + row * 256 + ((64 * ks + 16 * fq) ^ ((row & 7) << 4))); }
__device__ __forceinline__ void gla_output(const MegaArgs& P, LAS unsigned char* lds, int c) {
    unsigned char* ws = P.ws;
    const bf16_t *QBp = (const bf16_t*)(ws + WS_QB), *KBp = (const bf16_t*)(ws + WS_KB), *VBp = (const bf16_t*)(ws + WS_VB), *OGp = (const bf16_t*)(ws + WS_OG), *SST = (const bf16_t*)(ws + WS_SST);
    bf16_t* A2 = (bf16_t*)(ws + WS_A2); const float* gnorm = P.in[11];
    const int tid = threadIdx.x, w = __builtin_amdgcn_readfirstlane(tid >> 6), lane = tid & 63, fr = lane & 15, fq = lane >> 4;
    const int b = c >> 7, h = (c >> 5) & 3, ck = c & 31, t0 = b * SEQ + 128 * ck;
    LAS unsigned char* X0 = lds; LAS unsigned char* X1 = lds + 32768; LAS unsigned char* VT = lds + 65536;
#pragma unroll 2
    for (int u = 0; u < 8; ++u) { const int id = tid + NTHR * u, j = id >> 5, ec = (id & 31) * 8;
        const bf16x8 vv = *(const bf16x8*)(VBp + (size_t)(t0 + j) * 1024 + h * 256 + ec);
#pragma unroll
        for (int i = 0; i < 8; ++i) { const int e = ec + i; *(LAS bf16_t*)(VT + e * 256 + ((j * 2) ^ ((e & 7) << 4))) = (bf16_t)vv[i]; } }
#define GLA_STAGE_QK(BCp) do { _Pragma("unroll") for (int u = 0; u < 4; ++u) { const int id = tid + NTHR * u, row = id >> 4, dc = (id & 15) * 8; \
        const bf16x8 q8 = *(const bf16x8*)(QBp + (size_t)(t0 + row) * 512 + h * 128 + dc), k8 = *(const bf16x8*)(KBp + (size_t)(t0 + row) * 512 + h * 128 + dc); \
        const f32x4 ba = *(const f32x4*)((BCp) + (size_t)(t0 + row) * 512 + h * 128 + dc), bb = *(const f32x4*)((BCp) + (size_t)(t0 + row) * 512 + h * 128 + dc + 4); \
        float qt[8], kt[8]; \
        _Pragma("unroll") for (int i = 0; i < 8; ++i) { const float bv = i < 4 ? ba[i & 3] : bb[i & 3]; qt[i] = bf2f((bf16_t)q8[i]) * __expf(bv) * 0.08838834764831845f; kt[i] = bf2f((bf16_t)k8[i]) * __expf(-bv); } \
        pg8::u32x4 wq, wk; wq.x = pg8::cvt_pk_bf16(qt[0], qt[1]); wq.y = pg8::cvt_pk_bf16(qt[2], qt[3]); wq.z = pg8::cvt_pk_bf16(qt[4], qt[5]); wq.w = pg8::cvt_pk_bf16(qt[6], qt[7]); \
        wk.x = pg8::cvt_pk_bf16(kt[0], kt[1]); wk.y = pg8::cvt_pk_bf16(kt[2], kt[3]); wk.z = pg8::cvt_pk_bf16(kt[4], kt[5]); wk.w = pg8::cvt_pk_bf16(kt[6], kt[7]); \
        const int off_ = row * 256 + ((dc * 2) ^ ((row & 7) << 4)); *(LAS pg8::u32x4*)(X0 + off_) = wq; *(LAS pg8::u32x4*)(X1 + off_) = wk; } } while (0)
    const float* BCF = (const float*)(ws + WS_BCF); const float* BCB = (const float*)(ws + WS_BCB);
    GLA_STAGE_QK(BCF);
    __syncthreads();
    f32x4 accP[8], accO[16];
#pragma unroll
    for (int i = 0; i < 8; ++i) accP[i] = (f32x4){0.f, 0.f, 0.f, 0.f};
#pragma unroll
    for (int i = 0; i < 16; ++i) accO[i] = (f32x4){0.f, 0.f, 0.f, 0.f};
    bf16x8 af[4];
#pragma unroll
    for (int ks = 0; ks < 4; ++ks) af[ks] = swz_frag(X0, 16 * w + fr, ks, fq);
#pragma unroll
    for (int jt = 0; jt < 8; ++jt) { if (jt <= w) {
#pragma unroll
        for (int ks = 0; ks < 4; ++ks) accP[jt] = __builtin_amdgcn_mfma_f32_16x16x32_bf16(af[ks], swz_frag(X1, 16 * jt + fr, ks, fq), accP[jt], 0, 0, 0);
        if (jt == w) {
#pragma unroll
            for (int r = 0; r < 4; ++r) if (fr > 4 * fq + r) accP[jt][r] = 0.f; } } }
    { const bf16_t* Sf = SST + (size_t)(((b * 4 + h) * 2 + 0) * 32 + ck) * 256 * 128;
#pragma unroll
      for (int et = 0; et < 16; ++et)
#pragma unroll
          for (int ks = 0; ks < 4; ++ks) { const bf16x8 bb = *(const bf16x8*)(Sf + (size_t)(16 * et + fr) * 128 + 32 * ks + 8 * fq);
              accO[et] = __builtin_amdgcn_mfma_f32_16x16x32_bf16(af[ks], bb, accO[et], 0, 0, 0); } }
    __syncthreads();
    GLA_STAGE_QK(BCB);
    __syncthreads();
#pragma unroll
    for (int ks = 0; ks < 4; ++ks) af[ks] = swz_frag(X0, 16 * w + fr, ks, fq);
#pragma unroll
    for (int jt = 0; jt < 8; ++jt) { if (jt >= w) { f32x4 tt = (f32x4){0.f, 0.f, 0.f, 0.f};
#pragma unroll
        for (int ks = 0; ks < 4; ++ks) tt = __builtin_amdgcn_mfma_f32_16x16x32_bf16(af[ks], swz_frag(X1, 16 * jt + fr, ks, fq), tt, 0, 0, 0);
        if (jt == w) {
#pragma unroll
            for (int r = 0; r < 4; ++r) if (fr < 4 * fq + r) tt[r] = 0.f; }
        accP[jt] = accP[jt] + tt; } }
    { const bf16_t* Sb = SST + (size_t)(((b * 4 + h) * 2 + 1) * 32 + ck) * 256 * 128;
#pragma unroll
      for (int et = 0; et < 16; ++et)
#pragma unroll
          for (int ks = 0; ks < 4; ++ks) { const bf16x8 bb = *(const bf16x8*)(Sb + (size_t)(16 * et + fr) * 128 + 32 * ks + 8 * fq);
              accO[et] = __builtin_amdgcn_mfma_f32_16x16x32_bf16(af[ks], bb, accO[et], 0, 0, 0); } }
    LDS_WAIT();
#pragma unroll
    for (int jt = 0; jt < 8; ++jt)
#pragma unroll
        for (int r = 0; r < 4; ++r) { const int row = 16 * w + 4 * fq + r, j = 16 * jt + fr; *(LAS bf16_t*)(X0 + row * 256 + ((j * 2) ^ ((row & 7) << 4))) = f2bf(accP[jt][r]); }
    LDS_WAIT();
#pragma unroll
    for (int ks = 0; ks < 4; ++ks) af[ks] = swz_frag(X0, 16 * w + fr, ks, fq);
#pragma unroll
    for (int et = 0; et < 16; ++et)
#pragma unroll
        for (int ks = 0; ks < 4; ++ks) accO[et] = __builtin_amdgcn_mfma_f32_16x16x32_bf16(af[ks], swz_frag(VT, 16 * et + fr, ks, fq), accO[et], 0, 0, 0);
    float rr[4];
#pragma unroll
    for (int r = 0; r < 4; ++r) { float ss = 0.f;
#pragma unroll
        for (int et = 0; et < 16; ++et) ss += accO[et][r] * accO[et][r];
        ss += __shfl_xor(ss, 1); ss += __shfl_xor(ss, 2); ss += __shfl_xor(ss, 4); ss += __shfl_xor(ss, 8);
        rr[r] = 1.f / sqrtf(ss * (1.f / 256.f) + RMS_EPS); }
#pragma unroll
    for (int et = 0; et < 16; ++et) { const int e = 16 * et + fr; const float gn = gnorm[e];
#pragma unroll
        for (int r = 0; r < 4; ++r) { const size_t t = (size_t)(t0 + 16 * w + 4 * fq + r); const float g = bf2f(OGp[t * 1024 + h * 256 + e]);
            A2[t * 2048 + 1024 + h * 256 + e] = f2bf(accO[et][r] * rr[r] * gn * (g * sigm(g))); } }
#undef GLA_STAGE_QK
    __syncthreads();
}

__device__ __forceinline__ void ph_ln1_router(const MegaArgs& P, LAS unsigned char* lds, int c) {
    unsigned char* ws = P.ws; unsigned* ctl = (unsigned*)(ws + WS_CTL);
    const float* PRE1 = (const float*)(ws + WS_PRE1); float* H1F = (float*)(ws + WS_H1F); unsigned char* XROWS = (unsigned char*)(ws + WS_XROWS); int* DEST = (int*)(ws + WS_DEST); float* GATE = (float*)(ws + WS_GATE);
    const float *g1 = P.in[15], *b1 = P.in[16], *wr = P.in[17], *br = P.in[18];
    const int tid = threadIdx.x, w = __builtin_amdgcn_readfirstlane(tid >> 6), lane = tid & 63, e = lane & 31, half = lane >> 5;
    LAS float* hrow = (LAS float*)lds;
    LAS float* part = (LAS float*)(lds + 65536);
    LAS int* etab = (LAS int*)(lds + 81920);
    LAS float* gtab = (LAS float*)(lds + 81920 + 512);
    LAS int* slot = (LAS int*)(lds + 81920 + 1024);
    LAS int* lbase = (LAS int*)(lds + 81920 + 1536);
    float wreg[128];
#pragma unroll
    for (int i = 0; i < 128; ++i) wreg[i] = wr[(size_t)(256 * w + 128 * half + i) * NE + e];
    for (int rb = c * 32; rb < T; rb += gridDim.x * 32) {
        for (int gI = 0; gI < 4; ++gI) {
            const int row = rb + 8 * gI + w;
            { float4 v[8]; load_row(v, PRE1 + (size_t)row * D, lane); ln_row_lowreg(v, g1, b1, lane); store_row_f32(v, H1F + (size_t)row * D, lane);
#pragma unroll
              for (int j = 0; j < 8; ++j) *(LAS f32x4*)(hrow + w * 2048 + (lane + 64 * j) * 4) = (f32x4){v[j].x, v[j].y, v[j].z, v[j].w}; }
            __syncthreads();
            float acc[8];
#pragma unroll
            for (int r = 0; r < 8; ++r) acc[r] = 0.f;
#pragma unroll
            for (int i = 0; i < 128; i += 4) {
#pragma unroll
                for (int r = 0; r < 8; ++r) { const f32x4 h4 = *(const LAS f32x4*)(hrow + r * 2048 + 256 * w + 128 * half + i);
                    acc[r] += h4[0] * wreg[i] + h4[1] * wreg[i + 1] + h4[2] * wreg[i + 2] + h4[3] * wreg[i + 3]; }
                asm volatile("" ::: "memory"); }
#pragma unroll
            for (int r = 0; r < 8; ++r) part[(w * 8 + r) * 64 + lane] = acc[r];
            __syncthreads();
            float lg = -1e30f;
            if (lane < 32) { float s = br[lane];
#pragma unroll
                for (int ww = 0; ww < 8; ++ww) s += part[(ww * 8 + w) * 64 + lane] + part[(ww * 8 + w) * 64 + lane + 32];
                lg = s; }
            float cur = lg, tv0, tv1, tv2, tv3; int ti0, ti1, ti2, ti3;
#define TOP1(TV, TI) do { float bv = cur; int bi = lane; \
                _Pragma("unroll") for (int o = 1; o < 64; o <<= 1) { const float ov = __shfl_xor(bv, o); const int oi = __shfl_xor(bi, o); if (ov > bv || (ov == bv && oi < bi)) { bv = ov; bi = oi; } } \
                TV = bv; TI = bi; if (lane == bi) cur = -1e30f; } while (0)
            TOP1(tv0, ti0); TOP1(tv1, ti1); TOP1(tv2, ti2); TOP1(tv3, ti3);
#undef TOP1
            const float ge0 = 1.f, ge1 = __expf(tv1 - tv0), ge2 = __expf(tv2 - tv0), ge3 = __expf(tv3 - tv0), gs = (ge0 + ge1) + (ge2 + ge3);
            if (lane < 4) { int ee = ti0; float gg = ge0;
                if (lane == 1) { ee = ti1; gg = ge1; } if (lane == 2) { ee = ti2; gg = ge2; } if (lane == 3) { ee = ti3; gg = ge3; }
                etab[(8 * gI + w) * 4 + lane] = ee; gtab[(8 * gI + w) * 4 + lane] = gg / gs; }
        }
        VM_WAIT();
        __syncthreads();
        if (w == 0) { int cnt = 0;
            for (int a = 0; a < 128; ++a) { const int ea = etab[a]; if (ea == lane) { slot[a] = cnt; ++cnt; } }
            if (lane < 32) { unsigned base = 0; if (cnt) base = __hip_atomic_fetch_add(ctl + CW_CNT + 64 * lane, (unsigned)cnt, __ATOMIC_RELAXED, __HIP_MEMORY_SCOPE_AGENT); lbase[lane] = (int)base; } }
        __syncthreads();
        for (int rr = 0; rr < 4; ++rr) { const int rl = 4 * w + rr, row = rb + rl;
            float4 v[8]; load_row(v, H1F + (size_t)row * D, lane);
#pragma unroll
            for (int k = 0; k < 4; ++k) { const int ee = etab[rl * 4 + k]; const int dst = ee * CAP + lbase[ee] + slot[rl * 4 + k];
                store_row_fp8(v, XROWS + (size_t)dst * D, lane);
                if (lane == k) { DEST[row * 4 + k] = dst; GATE[row * 4 + k] = gtab[rl * 4 + k]; } } }
        __syncthreads();
    }
}
__device__ __forceinline__ void build_moe_table(const MegaArgs& P, LAS unsigned char* lds) {
    unsigned* ctl = (unsigned*)(P.ws + WS_CTL); LAS int* tp = (LAS int*)(lds + LDS_TAB);
    __syncthreads();
    if (threadIdx.x == 0) { int run = 0; tp[0] = 0;
        for (int e = 0; e < NE; ++e) { const unsigned cnt = __hip_atomic_load(ctl + CW_CNT + 64 * e, __ATOMIC_RELAXED, __HIP_MEMORY_SCOPE_AGENT); run += (int)((cnt + 255u) >> 8); tp[e + 1] = run; } }
    __syncthreads();
}
__device__ __forceinline__ void ph_combine_ln2(const MegaArgs& P, int gw, int NGW, int lane) {
    unsigned char* ws = P.ws; const float* H1F = (const float*)(ws + WS_H1F); const bf16_t* Y = (const bf16_t*)(ws + WS_XROWS); const int* DEST = (const int*)(ws + WS_DEST); const float* GATE = (const float*)(ws + WS_GATE);
    float* H2F = (float*)(ws + WS_H2F); bf16_t* H2B = (bf16_t*)(ws + WS_H2B);
    for (int row = gw; row < T; row += NGW) {
        float4 v[8]; load_row(v, H1F + (size_t)row * D, lane);
#pragma unroll
        for (int j = 0; j < 8; ++j) { v[j].x *= DN_ALPHA; v[j].y *= DN_ALPHA; v[j].z *= DN_ALPHA; v[j].w *= DN_ALPHA; }
#pragma unroll
        for (int k = 0; k < 4; ++k) { const bf16_t* yr = Y + (size_t)DEST[row * 4 + k] * D; const float gk = GATE[row * 4 + k];
#pragma unroll
            for (int j = 0; j < 8; ++j) { const uint2 q = ((const uint2*)yr)[lane + 64 * j];
                v[j].x += gk * pg8::bflo(q.x); v[j].y += gk * pg8::bfhi(q.x); v[j].z += gk * pg8::bflo(q.y); v[j].w += gk * pg8::bfhi(q.y); } }
        ln_row(v, P.in[23], P.in[24], lane); store_row_f32(v, H2F + (size_t)row * D, lane); store_row_bf16(v, H2B + (size_t)row * D, lane); }
}

__global__ void __launch_bounds__(NTHR, 2) mega(MegaArgs P) {
    extern __shared__ __attribute__((aligned(16))) unsigned char lds_raw[];
    LAS unsigned char* lds = (LAS unsigned char*)lds_raw;
    const int tid = threadIdx.x, lane = tid & 63, wave = __builtin_amdgcn_readfirstlane(tid >> 6), c = blockIdx.x, G = gridDim.x;
    const int gw = c * NWAVES + wave, NGW = G * NWAVES;
    unsigned char* ws = P.ws; unsigned* ctl = (unsigned*)(ws + WS_CTL);
    if (tid == 0) *(LAS pg8::u32x4*)(lds + LDS_BARW) = (pg8::u32x4){0u, 0u, 0u, 0u};
    __syncthreads();
    XcdBarrier bar = xcd_barrier_post(ctl + CW_BAR + P.li * XCD_BAR_WORDS, (volatile LAS unsigned*)(lds + LDS_BARW));
    const int lo = P.ph_lo, hi = P.ph_hi;
#define IN(k) (lo <= (k) && (k) < hi)
#define SEAM(k) do { if (IN(k) && IN((k) + 1)) xcd_barrier(bar); } while (0)
    bf16_t *H0B = (bf16_t*)(ws + WS_H0B), *A2 = (bf16_t*)(ws + WS_A2), *MB = (bf16_t*)(ws + WS_MB), *SG = (bf16_t*)(ws + WS_SG), *H2B = (bf16_t*)(ws + WS_H2B), *PB = (bf16_t*)(ws + WS_PB);
    float *M1 = (float*)(ws + WS_M1), *PRE1 = (float*)(ws + WS_PRE1), *H0F = (float*)(ws + WS_H0F), *H2F = (float*)(ws + WS_H2F), *PP = (float*)(ws + WS_PP), *PRE3 = (float*)(ws + WS_PRE3);

    if (IN(0)) { ph_prologue(P, lds, gw, NGW, wave, lane); } SEAM(0);
    if (IN(1)) { if (KFLAGS & F_INPROJ) {
        pg8::Gemm g{H0B, (const bf16_t*)(ws + WS_WT_IN), T, NIN, D}; pg8::StaticOrder S; S.init(T, NIN, G, c);
        pg8::EpiInprojF E{(bf16_t*)(ws + WS_QAR), (bf16_t*)(ws + WS_KAR), (bf16_t*)(ws + WS_VA), (bf16_t*)(ws + WS_QB), (bf16_t*)(ws + WS_KB), (bf16_t*)(ws + WS_VB), (bf16_t*)(ws + WS_OG), SG, (float*)(ws + WS_LR)};
        pg8::gemm_phase<pg8::EpiInprojF, pg8::StaticOrder>(lds, g, S, E, nullptr); } } SEAM(1);
    if (IN(2)) { if (KFLAGS & F_PREP) ph_prep(P, lds, c, gw, NGW, lane); } SEAM(2);
    if (IN(3)) {
        if (KFLAGS & F_ATTN) { for (int u = c; u < 256; u += G) {
            const int xcd = u & 7, off = u >> 3, grp = xcd >> 1, b = grp >> 1, kvh = grp & 1, idx = (xcd & 1) * 32 + off, gq = idx >> 4, qb = idx & 15, hq = kvh * 4 + gq;
            const bf16_t* QA = (const bf16_t*)(ws + WS_QA); const bf16_t* KA = (const bf16_t*)(ws + WS_KA); const bf16_t* VA = (const bf16_t*)(ws + WS_VA);
            attn::attn_dense_body(QA + ((size_t)(b * SEQ + qb * 256) * 1024 + hq * 128), KA + ((size_t)b * SEQ * 256 + kvh * 128), VA + ((size_t)b * SEQ * 256 + kvh * 128),
                                  A2 + ((size_t)(b * SEQ + qb * 256) * 2048 + hq * 128), SEQ, (char*)lds_raw);
            __syncthreads(); } }
        if (KFLAGS & F_GLA) { for (int u = c; u < 256; u += G) gla_state_scan(P, lds, u); }
    } SEAM(3);
    if (IN(4)) {
        if (KFLAGS & F_GLA) { for (int u = c; u < 256; u += G) gla_output(P, lds, u); }
    }
    if (IN(4) && (KFLAGS & F_YA)) { pg8::Gemm g{A2, (const bf16_t*)(ws + WS_WT_A), T, D, 1024}; pg8::StaticOrder S; S.init(T, D, G, c); pg8::EpiYaF E{SG, M1};
        pg8::gemm_phase<pg8::EpiYaF, pg8::StaticOrder>(lds, g, S, E, nullptr, 2048); } SEAM(4);
    if (IN(5)) { if (KFLAGS & F_YB) { pg8::Gemm g{A2 + 1024, (const bf16_t*)(ws + WS_WT_B), T, D, 1024}; pg8::StaticOrder S; S.init(T, D, G, c); pg8::EpiYbF E{SG, M1, MB};
        pg8::gemm_phase<pg8::EpiYbF, pg8::StaticOrder>(lds, g, S, E, nullptr, 2048); } } SEAM(5);
    if (IN(6)) { if (KFLAGS & F_WO) { pg8::Gemm g{MB, (const bf16_t*)(ws + WS_WT_O), T, D, D}; pg8::StaticOrder S; S.init(T, D, G, c); pg8::EpiF32F<1> E{H0F, nullptr, PRE1};
        pg8::gemm_phase<pg8::EpiF32F<1>, pg8::StaticOrder>(lds, g, S, E, nullptr); } } SEAM(6);
    if (IN(7)) { if (KFLAGS & F_LN1) ph_ln1_router(P, lds, c); } SEAM(7);
    if (IN(8)) { if (KFLAGS & F_UP) { build_moe_table(P, lds);
        pg8::Gemm g{(const bf16_t*)(ws + WS_XROWS), (const bf16_t*)(ws + WS_WT_UP), NE * CAP, 4096, D / 2}; pg8::MoeOrder S{(const PG8_LAS int*)(lds + LDS_TAB), 16, G, c, (size_t)4096 * 2048};
        pg8::EpiUpF8 E{P.in[20], (unsigned char*)(ws + WS_ACT)};
        pg8::gemm_phase<pg8::EpiUpF8, pg8::MoeOrder, false, true>(lds, g, S, E, nullptr); } } SEAM(8);
    if (IN(9)) { if (KFLAGS & F_DOWN) { build_moe_table(P, lds);
        pg8::Gemm g{(const bf16_t*)(ws + WS_ACT), (const bf16_t*)(ws + WS_WT_DN), NE * CAP, D, D / 2}; pg8::MoeOrder S{(const PG8_LAS int*)(lds + LDS_TAB), 8, G, c, (size_t)2048 * 2048};
        pg8::EpiDownF8 E{P.in[22], (bf16_t*)(ws + WS_XROWS)};
        pg8::gemm_phase<pg8::EpiDownF8, pg8::MoeOrder, false, true>(lds, g, S, E, nullptr); } } SEAM(9);
    if (IN(10)) { if (KFLAGS & F_LN2) ph_combine_ln2(P, gw, NGW, lane); } SEAM(10);
    if (IN(11)) { if (KFLAGS & F_PLE) {
        { pg8::Gemm g{PB, (const bf16_t*)(ws + WS_WT_P), T, D, PLE}; pg8::StaticOrder S; S.init(T, D, G, c); pg8::EpiF32F<0> E{nullptr, nullptr, PP};
          pg8::gemm_phase<pg8::EpiF32F<0>, pg8::StaticOrder>(lds, g, S, E, nullptr); }
        { pg8::Gemm g{H2B, (const bf16_t*)(ws + WS_WT_G), T, D, D}; pg8::StaticOrder S; S.init(T, D, G, c); pg8::EpiF32F<2> E{H2F, PP, PRE3};
          pg8::gemm_phase<pg8::EpiF32F<2>, pg8::StaticOrder>(lds, g, S, E, nullptr); } } } SEAM(11);
    if (IN(12)) { if (KFLAGS & F_LN3) { for (int row = gw; row < T; row += NGW) { float4 v[8]; load_row(v, PRE3 + (size_t)row * D, lane); ln_row(v, P.in[27], P.in[28], lane); store_row_f32(v, P.out + (size_t)row * D, lane); } } }
#undef IN
#undef SEAM
}

extern "C" void kernel_launch(void* const* d_in, const int* in_sizes, int n_in, void* d_out, int out_size, void* d_ws, size_t ws_size, hipStream_t stream) {
    static int grid = 0;
    if (grid == 0) {
        if (n_in != 29 || ws_size < WS_END2) { fprintf(stderr, "kernel_launch: unexpected n_in %d or ws %zu < %zu\n", n_in, ws_size, (size_t)WS_END2); grid = -1; return; }
        int dev = 0, cus = 0, per_cu = 0;
        if (hipGetDevice(&dev) != hipSuccess || hipDeviceGetAttribute(&cus, hipDeviceAttributeMultiprocessorCount, dev) != hipSuccess) { grid = -1; return; }
        if (hipFuncSetAttribute((const void*)mega, hipFuncAttributeMaxDynamicSharedMemorySize, LDS_BYTES) != hipSuccess) { fprintf(stderr, "kernel_launch: hipFuncSetAttribute failed\n"); grid = -1; return; }
        if (hipOccupancyMaxActiveBlocksPerMultiprocessor(&per_cu, (const void*)mega, NTHR, LDS_BYTES) != hipSuccess || per_cu < 1) fprintf(stderr, "kernel_launch: occupancy query says %d\n", per_cu);
        (void)hipGetLastError();
        grid = cus;
    }
    if (grid < 0) return;
    const float* x = (const float*)d_in[0]; const float* p = (const float*)d_in[1];
    const float *in_g = (const float*)d_in[2], *in_b = (const float*)d_in[3], *w_in = (const float*)d_in[4], *qn = (const float*)d_in[5], *kn = (const float*)d_in[6];
    const float *wlf = (const float*)d_in[7], *blf = (const float*)d_in[8], *wlb = (const float*)d_in[9], *blb = (const float*)d_in[10], *gn = (const float*)d_in[11];
    const float *wba = (const float*)d_in[12], *wbb = (const float*)d_in[13], *wo = (const float*)d_in[14], *l1g = (const float*)d_in[15], *l1b = (const float*)d_in[16];
    const float *wr = (const float*)d_in[17], *br = (const float*)d_in[18], *wup = (const float*)d_in[19], *bup = (const float*)d_in[20], *wdn = (const float*)d_in[21], *bdn = (const float*)d_in[22];
    const float *l2g = (const float*)d_in[23], *l2b = (const float*)d_in[24], *wpg = (const float*)d_in[25], *wpp = (const float*)d_in[26], *l3g = (const float*)d_in[27], *l3b = (const float*)d_in[28];
    char* ws = (char*)d_ws; float* out = (float*)d_out;
    unsigned* ctl = (unsigned*)(ws + WS_CTL);
    float* H0F = (float*)(ws + WS_H0F); bf16_t* H0B = (bf16_t*)(ws + WS_H0B);
    bf16_t *QAR = (bf16_t*)(ws + WS_QAR), *KAR = (bf16_t*)(ws + WS_KAR), *VA = (bf16_t*)(ws + WS_VA), *QB = (bf16_t*)(ws + WS_QB), *KB = (bf16_t*)(ws + WS_KB), *VB = (bf16_t*)(ws + WS_VB);
    bf16_t *OG = (bf16_t*)(ws + WS_OG), *SG = (bf16_t*)(ws + WS_SG), *QA = (bf16_t*)(ws + WS_QA), *KA = (bf16_t*)(ws + WS_KA), *A2 = (bf16_t*)(ws + WS_A2), *MB = (bf16_t*)(ws + WS_MB);
    float *LR = (float*)(ws + WS_LR), *BCF = (float*)(ws + WS_BCF), *BCB = (float*)(ws + WS_BCB), *OF = (float*)(ws + WS_OF), *OB = (float*)(ws + WS_OB), *M1 = (float*)(ws + WS_M1);
    float *PRE1 = (float*)(ws + WS_PRE1), *H1F = (float*)(ws + WS_H1F), *GATE = (float*)(ws + WS_GATE), *H2F = (float*)(ws + WS_H2F), *PP = (float*)(ws + WS_PP), *PRE3 = (float*)(ws + WS_PRE3);
    int* DEST = (int*)(ws + WS_DEST); bf16_t *H2B = (bf16_t*)(ws + WS_H2B), *PB = (bf16_t*)(ws + WS_PB), *XROWS = (bf16_t*)(ws + WS_XROWS), *YROWS = (bf16_t*)(ws + WS_XROWS), *ACT = (bf16_t*)(ws + WS_ACT);
    float* SC = (float*)(ws + WS_ACT);
    (void)hipMemsetAsync(ws + WS_CTL, 0, 1 * MiB, stream);

    constexpr int FAST = FAST_MASK;
    static const int stage_flags[13] = {F_TR | F_LN0, F_INPROJ, F_PREP, F_ATTN | F_GLA, F_GLA | F_YA, F_YB, F_WO, F_LN1, F_UP, F_DOWN, F_LN2, F_PLE, F_LN3};
    int pend_lo = -1, li = 0;
    MegaArgs a{};
    for (int i = 0; i < 29; ++i) a.in[i] = (const float*)d_in[i];
    a.out = out; a.ws = (unsigned char*)d_ws; a.flags = FAST;
#define FLUSH(hi_) do { if (pend_lo >= 0) { a.ph_lo = pend_lo; a.ph_hi = (hi_); a.li = li++; hipLaunchKernelGGL(mega, dim3(grid), dim3(NTHR), LDS_BYTES, stream, a); pend_lo = -1; } } while (0)
    for (int s = 0; s < 13; ++s) {
        switch (s) {
        case 0: if (!(FAST & F_LN0)) { FLUSH(s); hipLaunchKernelGGL(k_ln0, dim3(T / 4), dim3(256), 0, stream, x, in_g, in_b, H0F, H0B);
                    hipLaunchKernelGGL(k_cvt, dim3(2048), dim3(256), 0, stream, p, PB, (size_t)T * PLE); } break;
        case 1: if (!(FAST & F_INPROJ)) { FLUSH(s); EpiInproj e{QAR, KAR, VA, QB, KB, VB, OG, SG, LR};
                    hipLaunchKernelGGL((naive_gemm<bf16_t, float, false, false, EpiInproj>), dim3((INW + 63) / 64, T / 64, 1), dim3(256), 0, stream, H0B, (size_t)D, (size_t)0, w_in, (size_t)INW, (size_t)0, (const float*)nullptr, T, (const unsigned*)nullptr, INW, D, e); } break;
        case 2: if (!(FAST & F_PREP)) { FLUSH(s); hipLaunchKernelGGL(k_qkprep, dim3(T * 10 / 4), dim3(256), 0, stream, QAR, KAR, qn, kn, QA, KA);
                    hipLaunchKernelGGL(k_glacum, dim3(NB * 32 * 4), dim3(256), 0, stream, LR, wlf, blf, wlb, blb, BCF, BCB); } break;
        case 3: if (!(FAST & F_ATTN)) { FLUSH(s);
                    for (int b = 0; b < NB; ++b) for (int kvh = 0; kvh < 2; ++kvh) { EpiScores es{SC + (size_t)(b * 8 + kvh * 4) * SEQ * SEQ};
                        hipLaunchKernelGGL((naive_gemm<bf16_t, bf16_t, true, false, EpiScores>), dim3(SEQ / 64, SEQ / 64, 4), dim3(256), 0, stream, QA + (size_t)b * SEQ * 1024 + kvh * 4 * 128, (size_t)1024, (size_t)128,
                                           KA + (size_t)b * SEQ * 256 + kvh * 128, (size_t)256, (size_t)0, (const bf16_t*)nullptr, SEQ, (const unsigned*)nullptr, SEQ, 128, es); }
                    hipLaunchKernelGGL(k_softmax_rows, dim3(16 * SEQ / 4), dim3(256), 0, stream, SC);
                    for (int b = 0; b < NB; ++b) for (int kvh = 0; kvh < 2; ++kvh) { EpiAttnOut eo{A2, b, kvh};
                        hipLaunchKernelGGL((naive_gemm<float, bf16_t, false, false, EpiAttnOut>), dim3(128 / 64, SEQ / 64, 4), dim3(256), 0, stream, SC + (size_t)(b * 8 + kvh * 4) * SEQ * SEQ, (size_t)SEQ, (size_t)SEQ * SEQ,
                                           VA + (size_t)b * SEQ * 256 + kvh * 128, (size_t)256, (size_t)0, (const bf16_t*)nullptr, SEQ, (const unsigned*)nullptr, 128, SEQ, eo); } }
                if (!(FAST & F_GLA)) { FLUSH(s); hipLaunchKernelGGL(k_gla_naive, dim3(16), dim3(256), 0, stream, QB, KB, VB, LR, wlf, blf, wlb, blb, OF, OB); } break;
        case 4: if (!(FAST & F_GLA)) { FLUSH(s); hipLaunchKernelGGL(k_gla_combine, dim3(T * 4 / 4), dim3(256), 0, stream, OF, OB, OG, gn, A2); }
                if (!(FAST & F_YA)) { FLUSH(s); EpiYa e{SG, M1}; hipLaunchKernelGGL((naive_gemm<bf16_t, float, false, false, EpiYa>), dim3(D / 64, T / 64, 1), dim3(256), 0, stream, A2, (size_t)2048, (size_t)0, wba, (size_t)D, (size_t)0, (const float*)nullptr, T, (const unsigned*)nullptr, D, 1024, e); } break;
        case 5: if (!(FAST & F_YB)) { FLUSH(s); EpiYb e{SG, M1, MB}; hipLaunchKernelGGL((naive_gemm<bf16_t, float, false, false, EpiYb>), dim3(D / 64, T / 64, 1), dim3(256), 0, stream, A2 + 1024, (size_t)2048, (size_t)0, wbb, (size_t)D, (size_t)0, (const float*)nullptr, T, (const unsigned*)nullptr, D, 1024, e); } break;
        case 6: if (!(FAST & F_WO)) { FLUSH(s); EpiRes e{H0F, PRE1}; hipLaunchKernelGGL((naive_gemm<bf16_t, float, false, false, EpiRes>), dim3(D / 64, T / 64, 1), dim3(256), 0, stream, MB, (size_t)D, (size_t)0, wo, (size_t)D, (size_t)0, (const float*)nullptr, T, (const unsigned*)nullptr, D, D, e); } break;
        case 7: if (!(FAST & F_LN1)) { FLUSH(s); hipLaunchKernelGGL(k_ln1_router, dim3(T / 4), dim3(256), 0, stream, PRE1, l1g, l1b, wr, br, H1F, XROWS, DEST, GATE, ctl); } break;
        case 8: if (!(FAST & F_UP)) { FLUSH(s); EpiUp e{bup, ACT}; hipLaunchKernelGGL((naive_gemm<bf16_t, float, false, true, EpiUp>), dim3(2048 / 64, CAP / 64, NE), dim3(256), 0, stream, XROWS, (size_t)D, (size_t)CAP * D, wup, (size_t)4096, (size_t)D * 4096, wup + 2048, CAP, (const unsigned*)(ctl + CW_CNT), 2048, D, e); } break;
        case 9: if (!(FAST & F_DOWN)) { FLUSH(s); EpiDown e{bdn, YROWS}; hipLaunchKernelGGL((naive_gemm<bf16_t, float, false, false, EpiDown>), dim3(2048 / 64, CAP / 64, NE), dim3(256), 0, stream, ACT, (size_t)D, (size_t)CAP * D, wdn, (size_t)D, (size_t)D * D, (const float*)nullptr, CAP, (const unsigned*)(ctl + CW_CNT), D, D, e); } break;
        case 10: if (!(FAST & F_LN2)) { FLUSH(s); hipLaunchKernelGGL(k_combine_ln2, dim3(T / 4), dim3(256), 0, stream, H1F, YROWS, DEST, GATE, l2g, l2b, H2F, H2B); } break;
        case 11: if (!(FAST & F_PLE)) { FLUSH(s); { EpiF32 e{PP}; hipLaunchKernelGGL((naive_gemm<bf16_t, float, false, false, EpiF32>), dim3(D / 64, T / 64, 1), dim3(256), 0, stream, PB, (size_t)PLE, (size_t)0, wpp, (size_t)D, (size_t)0, (const float*)nullptr, T, (const unsigned*)nullptr, D, PLE, e); }
                     { EpiPle e{H2F, PP, PRE3}; hipLaunchKernelGGL((naive_gemm<bf16_t, float, false, false, EpiPle>), dim3(D / 64, T / 64, 1), dim3(256), 0, stream, H2B, (size_t)D, (size_t)0, wpg, (size_t)D, (size_t)0, (const float*)nullptr, T, (const unsigned*)nullptr, D, D, e); } } break;
        case 12: if (!(FAST & F_LN3)) { FLUSH(s); hipLaunchKernelGGL(k_ln_out, dim3(T / 4), dim3(256), 0, stream, PRE3, l3g, l3b, out); } break;
        }
        if (FAST & stage_flags[s]) { if (pend_lo < 0) pend_lo = s; } else { FLUSH(s); }
    }
    FLUSH(13);
#ifdef PROBE_LO
    { a.ph_lo = PROBE_LO; a.ph_hi = PROBE_HI; a.li = li++; hipLaunchKernelGGL(mega, dim3(grid), dim3(NTHR), LDS_BYTES, stream, a); }
#endif
#undef FLUSH
}
```

```cpp
#include <hip/hip_runtime.h>
#include <cstdio>
#include <cstdint>
#ifndef FAST_MASK
#define FAST_MASK 32767
#endif

typedef unsigned short bf16_t;
typedef short bf16x8 __attribute__((ext_vector_type(8)));
typedef float f32x4 __attribute__((ext_vector_type(4)));

constexpr int T = 8192, D = 2048, SEQ = 4096, NB = 2;
constexpr int INW = 8736, PLE = 256, NE = 32, TOPK = 4, CAP = 8192;
constexpr float DN_ALPHA = 1.189207115002721f;
constexpr float LN_EPS = 1e-5f, RMS_EPS = 1e-6f;

constexpr size_t MiB = 1ull << 20;
constexpr size_t WS_CTL = 0;
constexpr size_t WS_H0F = 16 * MiB;
constexpr size_t WS_H0B = WS_H0F + 64 * MiB;
constexpr size_t WS_QAR = WS_H0B + 32 * MiB;
constexpr size_t WS_KAR = WS_QAR + 16 * MiB;
constexpr size_t WS_VA  = WS_KAR + 4 * MiB;
constexpr size_t WS_QB  = WS_VA + 4 * MiB;
constexpr size_t WS_KB  = WS_QB + 8 * MiB;
constexpr size_t WS_VB  = WS_KB + 8 * MiB;
constexpr size_t WS_OG  = WS_VB + 16 * MiB;
constexpr size_t WS_SG  = WS_OG + 16 * MiB;
constexpr size_t WS_LR  = WS_SG + 64 * MiB;
constexpr size_t WS_QA  = WS_LR + 1 * MiB;
constexpr size_t WS_KA  = WS_QA + 16 * MiB;
constexpr size_t WS_BCF = WS_KA + 4 * MiB;
constexpr size_t WS_BCB = WS_BCF + 16 * MiB;
constexpr size_t WS_OF  = WS_BCB + 16 * MiB;
constexpr size_t WS_OB  = WS_OF + 32 * MiB;
constexpr size_t WS_A2  = WS_OB + 32 * MiB;
constexpr size_t WS_M1  = WS_A2 + 32 * MiB;
constexpr size_t WS_MB  = WS_M1 + 64 * MiB;
constexpr size_t WS_PRE1 = WS_MB + 32 * MiB;
constexpr size_t WS_H1F = WS_PRE1 + 64 * MiB;
constexpr size_t WS_DEST = WS_H1F + 64 * MiB;
constexpr size_t WS_GATE = WS_DEST + 1 * MiB;
constexpr size_t WS_H2F = WS_GATE + 1 * MiB;
constexpr size_t WS_H2B = WS_H2F + 64 * MiB;
constexpr size_t WS_PB  = WS_H2B + 32 * MiB;
constexpr size_t WS_PP  = WS_PB + 4 * MiB;
constexpr size_t WS_PRE3 = WS_PP + 64 * MiB;
constexpr size_t WS_XROWS = 1024 * MiB;
constexpr size_t WS_ACT = 2048 * MiB;
constexpr size_t WS_END = 3072 * MiB;
static_assert(WS_PRE3 + 64 * MiB <= WS_XROWS, "ws map");
constexpr int CW_CNT = 1024;

__device__ __forceinline__ float bf2f(bf16_t b) { return __uint_as_float(((unsigned)b) << 16); }
__device__ __forceinline__ bf16_t f2bf(float f) { unsigned u = __float_as_uint(f); u += 0x7fffu + ((u >> 16) & 1u); return (bf16_t)(u >> 16); }
__device__ __forceinline__ float wave_sum(float v) {
#pragma unroll
    for (int o = 1; o < 64; o <<= 1) v += __shfl_xor(v, o);
    return v;
}
__device__ __forceinline__ float sigm(float x) { return 1.f / (1.f + __expf(-x)); }
__device__ __forceinline__ float tof(float x) { return x; }
__device__ __forceinline__ float tof(bf16_t x) { return bf2f(x); }

__device__ __forceinline__ void ln_row(float4 (&v)[8], const float* g, const float* b, int lane) {
    float s = 0.f;
#pragma unroll
    for (int j = 0; j < 8; ++j) s += (v[j].x + v[j].y) + (v[j].z + v[j].w);
    const float mean = wave_sum(s) * (1.f / D);
    float s2 = 0.f;
#pragma unroll
    for (int j = 0; j < 8; ++j) { v[j].x -= mean; v[j].y -= mean; v[j].z -= mean; v[j].w -= mean; s2 += (v[j].x * v[j].x + v[j].y * v[j].y) + (v[j].z * v[j].z + v[j].w * v[j].w); }
    const float rstd = 1.f / sqrtf(wave_sum(s2) * (1.f / D) + LN_EPS);
#pragma unroll
    for (int j = 0; j < 8; ++j) { const float4 gg = ((const float4*)g)[lane + 64 * j], bb = ((const float4*)b)[lane + 64 * j];
        v[j].x = v[j].x * rstd * gg.x + bb.x; v[j].y = v[j].y * rstd * gg.y + bb.y; v[j].z = v[j].z * rstd * gg.z + bb.z; v[j].w = v[j].w * rstd * gg.w + bb.w; }
}
__device__ __forceinline__ void store_row_fp8(const float4 (&v)[8], unsigned char* p, int lane) {
#pragma unroll
    for (int j = 0; j < 8; ++j) { int w = 0; w = __builtin_amdgcn_cvt_pk_fp8_f32(v[j].x, v[j].y, w, false); w = __builtin_amdgcn_cvt_pk_fp8_f32(v[j].z, v[j].w, w, true); ((unsigned*)p)[lane + 64 * j] = (unsigned)w; }
}
__device__ __forceinline__ void ln_row_lowreg(float4 (&v)[8], const float* g, const float* b, int lane) {
    float s = 0.f;
#pragma unroll
    for (int j = 0; j < 8; ++j) s += (v[j].x + v[j].y) + (v[j].z + v[j].w);
    const float mean = wave_sum(s) * (1.f / D);
    float s2 = 0.f;
#pragma unroll
    for (int j = 0; j < 8; ++j) { v[j].x -= mean; v[j].y -= mean; v[j].z -= mean; v[j].w -= mean; s2 += (v[j].x * v[j].x + v[j].y * v[j].y) + (v[j].z * v[j].z + v[j].w * v[j].w); }
    const float rstd = 1.f / sqrtf(wave_sum(s2) * (1.f / D) + LN_EPS);
#pragma unroll
    for (int j = 0; j < 8; ++j) { const float4 gg = ((const float4*)g)[lane + 64 * j], bb = ((const float4*)b)[lane + 64 * j];
        v[j].x = v[j].x * rstd * gg.x + bb.x; v[j].y = v[j].y * rstd * gg.y + bb.y; v[j].z = v[j].z * rstd * gg.z + bb.z; v[j].w = v[j].w * rstd * gg.w + bb.w;
        asm volatile("" ::: "memory"); }
}
__device__ __forceinline__ void load_row(float4 (&v)[8], const float* p, int lane) {
#pragma unroll
    for (int j = 0; j < 8; ++j) v[j] = ((const float4*)p)[lane + 64 * j];
}
__device__ __forceinline__ void store_row_f32(const float4 (&v)[8], float* p, int lane) {
#pragma unroll
    for (int j = 0; j < 8; ++j) ((float4*)p)[lane + 64 * j] = v[j];
}
__device__ __forceinline__ void store_row_bf16(const float4 (&v)[8], bf16_t* p, int lane) {
#pragma unroll
    for (int j = 0; j < 8; ++j) { uint2 w; w.x = (unsigned)f2bf(v[j].x) | ((unsigned)f2bf(v[j].y) << 16); w.y = (unsigned)f2bf(v[j].z) | ((unsigned)f2bf(v[j].w) << 16);
        ((uint2*)p)[lane + 64 * j] = w; }
}

__global__ __launch_bounds__(256) void k_ln0(const float* x, const float* g, const float* b, float* h0f, bf16_t* h0b) {
    const int lane = threadIdx.x & 63, row = blockIdx.x * 4 + (threadIdx.x >> 6);
    float4 v[8]; load_row(v, x + (size_t)row * D, lane); ln_row(v, g, b, lane);
    store_row_f32(v, h0f + (size_t)row * D, lane); store_row_bf16(v, h0b + (size_t)row * D, lane);
}
__global__ __launch_bounds__(256) void k_cvt(const float* in, bf16_t* out, size_t n) {
    for (size_t i = (size_t)blockIdx.x * 256 + threadIdx.x; i < n; i += (size_t)gridDim.x * 256) out[i] = f2bf(in[i]);
}

template <class AT, class BT, bool BTRANS, bool DUAL, class Epi>
__global__ __launch_bounds__(256) void naive_gemm(const AT* A, size_t lda, size_t sA, const BT* B, size_t ldb, size_t sB, const BT* B2,
                                                  int M, const unsigned* Mdev, int N, int K, Epi epi) {
    __shared__ __attribute__((aligned(16))) bf16_t sa[64][40];
    __shared__ __attribute__((aligned(16))) bf16_t sb[64][40];
    __shared__ __attribute__((aligned(16))) bf16_t sb2[DUAL ? 64 : 1][40];
    const int batch = blockIdx.z;
    if (Mdev) M = (int)Mdev[64 * batch];
    const int m0 = blockIdx.y * 64, n0 = blockIdx.x * 64;
    if (m0 >= M) return;
    A += (size_t)batch * sA; B += (size_t)batch * sB; if (DUAL) B2 += (size_t)batch * sB;
    const int tid = threadIdx.x, w = tid >> 6, lane = tid & 63, fr = lane & 15, fq = lane >> 4;
    f32x4 acc[4], acc2[4];
#pragma unroll
    for (int c = 0; c < 4; ++c) { acc[c] = (f32x4){0.f, 0.f, 0.f, 0.f}; acc2[c] = (f32x4){0.f, 0.f, 0.f, 0.f}; }
    for (int k0 = 0; k0 < K; k0 += 32) {
        { const int r = tid >> 2, c0 = (tid & 3) * 8; const bool ok = (m0 + r) < M;
#pragma unroll
          for (int j = 0; j < 8; ++j) sa[r][c0 + j] = ok ? f2bf(tof(A[(size_t)(m0 + r) * lda + k0 + c0 + j])) : (bf16_t)0; }
        if (BTRANS) { const int r = tid >> 2, c0 = (tid & 3) * 8; const bool ok = (n0 + r) < N;
#pragma unroll
          for (int j = 0; j < 8; ++j) { sb[r][c0 + j] = ok ? f2bf(tof(B[(size_t)(n0 + r) * ldb + k0 + c0 + j])) : (bf16_t)0;
              if (DUAL) sb2[r][c0 + j] = ok ? f2bf(tof(B2[(size_t)(n0 + r) * ldb + k0 + c0 + j])) : (bf16_t)0; } }
        else { const int k = tid >> 3, nc = (tid & 7) * 8;
#pragma unroll
          for (int j = 0; j < 8; ++j) { const bool ok = (n0 + nc + j) < N; sb[nc + j][k] = ok ? f2bf(tof(B[(size_t)(k0 + k) * ldb + n0 + nc + j])) : (bf16_t)0;
              if (DUAL) sb2[nc + j][k] = ok ? f2bf(tof(B2[(size_t)(k0 + k) * ldb + n0 + nc + j])) : (bf16_t)0; } }
        __syncthreads();
        const bf16x8 a = *(const bf16x8*)&sa[16 * w + fr][8 * fq];
#pragma unroll
        for (int c = 0; c < 4; ++c) { const bf16x8 b = *(const bf16x8*)&sb[16 * c + fr][8 * fq];
            acc[c] = __builtin_amdgcn_mfma_f32_16x16x32_bf16(a, b, acc[c], 0, 0, 0);
            if (DUAL) { const bf16x8 b2 = *(const bf16x8*)&sb2[16 * c + fr][8 * fq]; acc2[c] = __builtin_amdgcn_mfma_f32_16x16x32_bf16(a, b2, acc2[c], 0, 0, 0); } }
        __syncthreads();
    }
#pragma unroll
    for (int c = 0; c < 4; ++c)
#pragma unroll
        for (int j = 0; j < 4; ++j) { const int row = m0 + 16 * w + 4 * fq + j, col = n0 + 16 * c + fr;
            if (row < M && col < N) epi(row, col, acc[c][j], acc2[c][j], batch); }
}

struct EpiInproj { bf16_t *qar, *kar, *va, *qb, *kb, *vb, *og, *sg; float* lr;
    __device__ void operator()(int row, int col, float v, float, int) const {
        const size_t r = (size_t)row;
        if (col < 1024) qar[r * 1024 + col] = f2bf(v);
        else if (col < 1280) kar[r * 256 + col - 1024] = f2bf(v);
        else if (col < 1536) va[r * 256 + col - 1280] = f2bf(v);
        else if (col < 2048) qb[r * 512 + col - 1536] = f2bf(v);
        else if (col < 2560) kb[r * 512 + col - 2048] = f2bf(v);
        else if (col < 3584) vb[r * 1024 + col - 2560] = f2bf(v);
        else if (col < 4608) og[r * 1024 + col - 3584] = f2bf(v);
        else if (col < 4640) lr[r * 32 + col - 4608] = v;
        else if (col < 6688) sg[r * 4096 + col - 4640] = f2bf(sigm(v));
        else sg[r * 4096 + 2048 + col - 6688] = f2bf(sigm(v));
    } };

__global__ __launch_bounds__(256) void k_qkprep(const bf16_t* qar, const bf16_t* kar, const float* qn, const float* kn, bf16_t* qa, bf16_t* ka) {
    const int lane = threadIdx.x & 63, gw = blockIdx.x * 4 + (threadIdx.x >> 6), t = gw / 10, hd = gw % 10;
    const bf16_t* src; bf16_t* dst; const float* gn;
    if (hd < 8) { src = qar + (size_t)t * 1024 + hd * 128; dst = qa + (size_t)t * 1024 + hd * 128; gn = qn; }
    else { src = kar + (size_t)t * 256 + (hd - 8) * 128; dst = ka + (size_t)t * 256 + (hd - 8) * 128; gn = kn; }
    const unsigned pr = ((const unsigned*)src)[lane];
    float x0 = bf2f((bf16_t)(pr & 0xffff)), x1 = bf2f((bf16_t)(pr >> 16));
    const float ss = wave_sum(x0 * x0 + x1 * x1), r = 1.f / sqrtf(ss * (1.f / 128.f) + RMS_EPS);
    x0 = x0 * r * gn[2 * lane]; x1 = x1 * r * gn[2 * lane + 1];
    const int s = t & (SEQ - 1), pos = (lane < 32) ? (s >> 6) : (s & 63);
    const float invf = exp2f(-(float)(lane & 31) * (13.287712379549449f / 32.f));
    float rev = (float)pos * invf * 0.15915494309189535f; rev -= floorf(rev);
    const float sn = __builtin_amdgcn_sinf(rev), cs = __builtin_amdgcn_cosf(rev);
    const float o0 = x0 * cs - x1 * sn, o1 = x0 * sn + x1 * cs;
    ((unsigned*)dst)[lane] = (unsigned)f2bf(o0) | ((unsigned)f2bf(o1) << 16);
}

__device__ __forceinline__ float logsig(float x) { return fminf(x, 0.f) - __logf(1.f + __expf(-fabsf(x))); }
__global__ __launch_bounds__(256) void k_glacum(const float* lr, const float* wf, const float* bfv, const float* wb, const float* bbv, float* bcf, float* bcb) {
    __shared__ float lrs[128][32];
    const int h = blockIdx.x & 3, ck = blockIdx.x >> 2, t0 = ck * 128, tid = threadIdx.x, dir = tid >> 7, d = tid & 127, ch = h * 128 + d;
    for (int i = tid; i < 128 * 32; i += 256) lrs[i >> 5][i & 31] = lr[(size_t)t0 * 32 + i];
    float w[16]; const float* W = dir ? wb : wf;
#pragma unroll
    for (int r = 0; r < 16; ++r) w[r] = W[r * 512 + ch];
    const float bias = dir ? bbv[ch] : bfv[ch];
    __syncthreads();
    float acc = 0.f; float* out = dir ? bcb : bcf;
    for (int ii = 0; ii < 128; ++ii) { const int i = dir ? 127 - ii : ii; float x = bias;
#pragma unroll
        for (int r = 0; r < 16; ++r) x += lrs[i][dir * 16 + r] * w[r];
        acc += logsig(x) * (1.f / 16.f); out[(size_t)(t0 + i) * 512 + ch] = acc; }
}
__global__ __launch_bounds__(256) void k_gla_naive(const bf16_t* qb, const bf16_t* kb, const bf16_t* vb, const float* lr, const float* wf, const float* bfv, const float* wb, const float* bbv,
                                                   float* of, float* ob) {
    __shared__ float qs[128], ks[128], dec[128];
    const int dir = blockIdx.x & 1, h = (blockIdx.x >> 1) & 3, b = blockIdx.x >> 3, e = threadIdx.x;
    float w[16]; float bias = 0.f;
    if (e < 128) { const float* W = dir ? wb : wf;
#pragma unroll
        for (int r = 0; r < 16; ++r) w[r] = W[r * 512 + h * 128 + e];
        bias = dir ? bbv[h * 128 + e] : bfv[h * 128 + e]; }
    else {
#pragma unroll
        for (int r = 0; r < 16; ++r) w[r] = 0.f; }
    float S[128];
#pragma unroll
    for (int d = 0; d < 128; ++d) S[d] = 0.f;
    float* out = dir ? ob : of;
    for (int ii = 0; ii < SEQ; ++ii) { const int t = b * SEQ + (dir ? SEQ - 1 - ii : ii);
        if (e < 128) { float x = bias;
#pragma unroll
            for (int r = 0; r < 16; ++r) x += lr[(size_t)t * 32 + dir * 16 + r] * w[r];
            dec[e] = __expf(logsig(x) * (1.f / 16.f));
            qs[e] = bf2f(qb[(size_t)t * 512 + h * 128 + e]) * 0.08838834764831845f; ks[e] = bf2f(kb[(size_t)t * 512 + h * 128 + e]); }
        __syncthreads();
        const float v = bf2f(vb[(size_t)t * 1024 + h * 256 + e]); float o = 0.f;
#pragma unroll
        for (int d = 0; d < 128; ++d) { S[d] = S[d] * dec[d] + ks[d] * v; o += qs[d] * S[d]; }
        out[(size_t)t * 1024 + h * 256 + e] = o;
        __syncthreads(); }
}
__global__ __launch_bounds__(256) void k_gla_combine(const float* of, const float* ob, const bf16_t* og, const float* gn, bf16_t* a2) {
    const int lane = threadIdx.x & 63, gw = blockIdx.x * 4 + (threadIdx.x >> 6), t = gw >> 2, h = gw & 3;
    const size_t base = (size_t)t * 1024 + h * 256 + lane * 4;
    const float4 a = *(const float4*)(of + base), c = *(const float4*)(ob + base);
    float o[4] = {a.x + c.x, a.y + c.y, a.z + c.z, a.w + c.w};
    const float ss = wave_sum(o[0] * o[0] + o[1] * o[1] + o[2] * o[2] + o[3] * o[3]), r = 1.f / sqrtf(ss * (1.f / 256.f) + RMS_EPS);
#pragma unroll
    for (int j = 0; j < 4; ++j) { const float g = bf2f(og[base + j]); a2[(size_t)t * 2048 + 1024 + h * 256 + lane * 4 + j] = f2bf(o[j] * r * gn[lane * 4 + j] * (g * sigm(g))); }
}
struct EpiScores { float* sc; __device__ void operator()(int row, int col, float v, float, int batch) const { sc[((size_t)batch * SEQ + row) * SEQ + col] = v * 0.08838834764831845f; } };
__global__ __launch_bounds__(256) void k_softmax_rows(float* sc) {
    const int lane = threadIdx.x & 63; float* p = sc + ((size_t)blockIdx.x * 4 + (threadIdx.x >> 6)) * SEQ;
    float m = -1e30f; for (int i = lane; i < SEQ; i += 64) m = fmaxf(m, p[i]);
#pragma unroll
    for (int o = 1; o < 64; o <<= 1) m = fmaxf(m, __shfl_xor(m, o));
    float s = 0.f; for (int i = lane; i < SEQ; i += 64) { const float e = __expf(p[i] - m); p[i] = e; s += e; }
    s = 1.f / wave_sum(s); for (int i = lane; i < SEQ; i += 64) p[i] *= s;
}
struct EpiAttnOut { bf16_t* a2; int b, kvh; __device__ void operator()(int row, int col, float v, float, int g) const { a2[((size_t)b * SEQ + row) * 2048 + (kvh * 4 + g) * 128 + col] = f2bf(v); } };
struct EpiYa { const bf16_t* sg; float* m1; __device__ void operator()(int row, int col, float v, float, int) const { m1[(size_t)row * 2048 + col] = bf2f(sg[(size_t)row * 4096 + col]) * v; } };
struct EpiYb { const bf16_t* sg; const float* m1; bf16_t* mb; __device__ void operator()(int row, int col, float v, float, int) const {
    mb[(size_t)row * 2048 + col] = f2bf(m1[(size_t)row * 2048 + col] + bf2f(sg[(size_t)row * 4096 + 2048 + col]) * v); } };
struct EpiRes { const float* base; float* out; __device__ void operator()(int row, int col, float v, float, int) const { const size_t i = (size_t)row * 2048 + col; out[i] = DN_ALPHA * base[i] + v; } };

__global__ __launch_bounds__(256) void k_ln1_router(const float* pre1, const float* g, const float* b, const float* wr, const float* br, float* h1f, bf16_t* xrows,
                                                    int* dest, float* gate, unsigned* ctl) {
    const int lane = threadIdx.x & 63, row = blockIdx.x * 4 + (threadIdx.x >> 6);
    float4 v[8]; load_row(v, pre1 + (size_t)row * D, lane); ln_row(v, g, b, lane); store_row_f32(v, h1f + (size_t)row * D, lane);
    float mylogit = -1e30f;
    for (int e = 0; e < NE; ++e) { float s = 0.f;
#pragma unroll
        for (int j = 0; j < 8; ++j) { const int d0 = (lane + 64 * j) * 4; s += v[j].x * wr[(d0 + 0) * NE + e] + v[j].y * wr[(d0 + 1) * NE + e] + v[j].z * wr[(d0 + 2) * NE + e] + v[j].w * wr[(d0 + 3) * NE + e]; }
        s = wave_sum(s) + br[e]; if (lane == e) mylogit = s; }
    float tv[4]; int ti[4]; float cur = mylogit;
#pragma unroll
    for (int k = 0; k < 4; ++k) { float bv = cur; int bi = lane;
#pragma unroll
        for (int o = 1; o < 64; o <<= 1) { const float ov = __shfl_xor(bv, o); const int oi = __shfl_xor(bi, o); if (ov > bv || (ov == bv && oi < bi)) { bv = ov; bi = oi; } }
        tv[k] = bv; ti[k] = bi; if (lane == bi) cur = -1e30f; }
    float ge[4], gs = 0.f;
#pragma unroll
    for (int k = 0; k < 4; ++k) { ge[k] = __expf(tv[k] - tv[0]); gs += ge[k]; }
    int dst[4];
#pragma unroll
    for (int k = 0; k < 4; ++k) { unsigned slot = 0; if (lane == 0) slot = __hip_atomic_fetch_add(ctl + CW_CNT + 64 * ti[k], 1u, __ATOMIC_RELAXED, __HIP_MEMORY_SCOPE_AGENT);
        slot = __shfl(slot, 0); dst[k] = ti[k] * CAP + (int)slot; }
    if (lane < 4) { const int k = lane; int dd = dst[0]; float gg = ge[0];
        if (k == 1) { dd = dst[1]; gg = ge[1]; } if (k == 2) { dd = dst[2]; gg = ge[2]; } if (k == 3) { dd = dst[3]; gg = ge[3]; }
        dest[row * 4 + k] = dd; gate[row * 4 + k] = gg / gs; }
#pragma unroll
    for (int k = 0; k < 4; ++k) store_row_bf16(v, xrows + (size_t)dst[k] * D, lane);
}
struct EpiUp { const float* bup; bf16_t* act; __device__ void operator()(int row, int col, float g, float lin, int e) const {
    g += bup[e * 4096 + col]; lin += bup[e * 4096 + 2048 + col]; g = fminf(g, 7.f); lin = fminf(fmaxf(lin, -7.f), 7.f);
    act[((size_t)e * CAP + row) * 2048 + col] = f2bf(g * sigm(1.702f * g) * (lin + 1.f)); } };
struct EpiDown { const float* bdn; bf16_t* y; __device__ void operator()(int row, int col, float v, float, int e) const { y[((size_t)e * CAP + row) * 2048 + col] = f2bf(v + bdn[e * 2048 + col]); } };
__global__ __launch_bounds__(256) void k_combine_ln2(const float* h1f, const bf16_t* y, const int* dest, const float* gate, const float* g, const float* b, float* h2f, bf16_t* h2b) {
    const int lane = threadIdx.x & 63, row = blockIdx.x * 4 + (threadIdx.x >> 6);
    float4 v[8]; load_row(v, h1f + (size_t)row * D, lane);
#pragma unroll
    for (int j = 0; j < 8; ++j) { v[j].x *= DN_ALPHA; v[j].y *= DN_ALPHA; v[j].z *= DN_ALPHA; v[j].w *= DN_ALPHA; }
    for (int k = 0; k < 4; ++k) { const bf16_t* yr = y + (size_t)dest[row * 4 + k] * D; const float gk = gate[row * 4 + k];
#pragma unroll
        for (int j = 0; j < 8; ++j) { const uint2 w = ((const uint2*)yr)[lane + 64 * j];
            v[j].x += gk * bf2f((bf16_t)(w.x & 0xffff)); v[j].y += gk * bf2f((bf16_t)(w.x >> 16)); v[j].z += gk * bf2f((bf16_t)(w.y & 0xffff)); v[j].w += gk * bf2f((bf16_t)(w.y >> 16)); } }
    ln_row(v, g, b, lane); store_row_f32(v, h2f + (size_t)row * D, lane); store_row_bf16(v, h2b + (size_t)row * D, lane);
}
struct EpiF32 { float* out; __device__ void operator()(int row, int col, float v, float, int) const { out[(size_t)row * 2048 + col] = v; } };
struct EpiPle { const float* h2f; const float* pp; float* out; __device__ void operator()(int row, int col, float v, float, int) const { const size_t i = (size_t)row * 2048 + col; out[i] = DN_ALPHA * h2f[i] + sigm(v) * pp[i]; } };
__global__ __launch_bounds__(256) void k_ln_out(const float* in, const float* g, const float* b, float* out) {
    const int lane = threadIdx.x & 63, row = blockIdx.x * 4 + (threadIdx.x >> 6);
    float4 v[8]; load_row(v, in + (size_t)row * D, lane); ln_row(v, g, b, lane); store_row_f32(v, out + (size_t)row * D, lane);
}

namespace pg8 {
#define PG8_LAS __attribute__((address_space(3)))
typedef unsigned u32x4 __attribute__((ext_vector_type(4)));
constexpr int BM = 256, BK = 64, HALF = 128, HTB = HALF * BK * 2  , STAGE_BYTES = 8 * HTB, NXCD = 8, WGM = 8;
__host__ __device__ __forceinline__ int lds_byte(int r, int c) { const int st = (r >> 4) * 2 + (c >> 5), rr = r & 15, cc = c & 31, ob = rr * 64 + cc * 2; return st * 1024 + (ob ^ (((ob >> 9) & 1) << 5)); }
__host__ __device__ __forceinline__ void stage_rc(int b, int& R, int& C) { const int st = b / 1024, sb = b % 1024, swz = sb ^ (((sb >> 9) & 1) << 5); R = (st >> 1) * 16 + swz / 64; C = (st & 1) * 32 + (swz % 64) / 2; }
__host__ __device__ __forceinline__ int perm32(int rho) { const int n = rho >> 4, i = rho & 15; return 8 * (i >> 2) + 4 * n + (i & 3); }
struct Unit { int pm, pn; };
struct Gemm { const bf16_t* A; const bf16_t* Bt; int M, N, K; };
struct StaticOrder {
    int nM, nN, nwg, G, c;
    __host__ __device__ void init(int M, int N, int G_, int c_) { nM = M / BM; nN = N / BM; nwg = nM * nN; G = G_; c = c_; }
    __host__ __device__ bool next(int i, Unit& u) const {
        const long L = (long)i * G + c; if (L >= nwg) return false;
        int wgid = (int)L; { const int q = nwg / NXCD, r = nwg % NXCD, xcd = wgid % NXCD, off = wgid / NXCD; wgid = (xcd < r ? xcd * (q + 1) : r * (q + 1) + (xcd - r) * q) + off; }
        const int nig = WGM * nN, gid = wgid / nig, fm = gid * WGM, gsz = (nM - fm) < WGM ? (nM - fm) : WGM;
        u.pm = fm + ((wgid % nig) % gsz); u.pn = (wgid % nig) / gsz; return true;
    }
    __device__ __forceinline__ const char* abase(const Gemm& g, const Unit& u, size_t tstep) const { return (const char*)g.A + (size_t)u.pm * tstep; }
    __device__ __forceinline__ const char* bbase(const Gemm& g, const Unit& u, size_t tstep) const { return (const char*)g.Bt + (size_t)u.pn * tstep; }
    __device__ __forceinline__ void a_ready(const Unit&) const {}
    __device__ __forceinline__ void done(const Unit&) const {}
};
struct RangeOrder {
    StaticOrder S; int i0, n;
    __device__ __forceinline__ bool next(int i, Unit& u) const { return i < n && S.next(i0 + i, u); }
    __device__ __forceinline__ const char* abase(const Gemm& g, const Unit& u, size_t tstep) const { return S.abase(g, u, tstep); }
    __device__ __forceinline__ const char* bbase(const Gemm& g, const Unit& u, size_t tstep) const { return S.bbase(g, u, tstep); }
    __device__ __forceinline__ void a_ready(const Unit&) const {}
    __device__ __forceinline__ void done(const Unit&) const {}
};
struct MoeOrder {
    const PG8_LAS int* tp; int NT, G, c; size_t bstride;
    __device__ __forceinline__ int tpr(int i) const { return __builtin_amdgcn_readfirstlane(tp[i]); }
    __device__ bool next(int i, Unit& u) const {
        const int total = NT * tpr(32); const long L = (long)i * G + c; if (L >= total) return false;
        int wgid = (int)L; { const int q = total / NXCD, r = total % NXCD, xcd = wgid % NXCD, off = wgid / NXCD; wgid = (xcd < r ? xcd * (q + 1) : r * (q + 1) + (xcd - r) * q) + off; }
        int e = 0; while (e < 31 && wgid >= NT * tpr(e + 1)) ++e;
        const int t0 = tpr(e), local = wgid - NT * t0, nte = tpr(e + 1) - t0;
        u.pn = local / nte; u.pm = e * 32 + local % nte; return true;
    }
    __device__ __forceinline__ const char* abase(const Gemm& g, const Unit& u, size_t tstep) const { return (const char*)g.A + (size_t)u.pm * tstep; }
    __device__ __forceinline__ const char* bbase(const Gemm& g, const Unit& u, size_t tstep) const { return (const char*)g.Bt + (size_t)(u.pm >> 5) * bstride + (size_t)u.pn * tstep; }
    __device__ __forceinline__ void a_ready(const Unit&) const {}
    __device__ __forceinline__ void done(const Unit&) const {}
};
__device__ __forceinline__ unsigned cvt_pk_bf16(float lo, float hi) { unsigned r; asm volatile("v_cvt_pk_bf16_f32 %0, %1, %2" : "=v"(r) : "v"(lo), "v"(hi)); return r; }
typedef int v8i __attribute__((ext_vector_type(8)));
typedef int v4i __attribute__((ext_vector_type(4)));
__device__ __forceinline__ v8i cat8(bf16x8 a, bf16x8 b) { const v4i x = __builtin_bit_cast(v4i, a), y = __builtin_bit_cast(v4i, b); return __builtin_shufflevector(x, y, 0, 1, 2, 3, 4, 5, 6, 7); }
__device__ __forceinline__ unsigned pk_fp8x4(float a, float b, float c, float d) { int w = 0; w = __builtin_amdgcn_cvt_pk_fp8_f32(a, b, w, false); w = __builtin_amdgcn_cvt_pk_fp8_f32(c, d, w, true); return (unsigned)w; }
constexpr float W8_SCALE = 256.f, W8_INV = 1.f / 256.f;
__device__ __forceinline__ float bflo(unsigned w) { return __uint_as_float(w << 16); }
__device__ __forceinline__ float bfhi(unsigned w) { return __uint_as_float(w & 0xffff0000u); }
typedef const f32x4 (&AccRef)[2][2][4][2];

struct EpiInprojF { static constexpr bool PERM = true, AFTER_DRAIN = false;
    bf16_t *qar, *kar, *va, *qb, *kb, *vb, *og, *sg; float* lr;
    __device__ __forceinline__ void operator()(AccRef acc, const Unit& u, int wr, int wc, int fr, int fq) const {
        const int pn = u.pn, row0 = u.pm * BM + wr * 64 + fr;
        if (pn >= 34) {
            if (wc == 0) {
#pragma unroll
                for (int ai = 0; ai < 2; ++ai)
#pragma unroll
                    for (int m = 0; m < 4; ++m) { float* rp = lr + (size_t)(row0 + ai * HALF + m * 16) * 32 + 8 * fq;
                        *(f32x4*)(rp) = acc[ai][0][m][0]; *(f32x4*)(rp + 4) = acc[ai][0][m][1]; } }
            return; }
        bf16_t* base; int ld, coff; bool sgm = false;
        if (pn < 4) { base = qar; ld = 1024; coff = pn * 256; }
        else if (pn == 4) { base = kar; ld = 256; coff = 0; }
        else if (pn == 5) { base = va; ld = 256; coff = 0; }
        else if (pn < 8) { base = qb; ld = 512; coff = (pn - 6) * 256; }
        else if (pn < 10) { base = kb; ld = 512; coff = (pn - 8) * 256; }
        else if (pn < 14) { base = vb; ld = 1024; coff = (pn - 10) * 256; }
        else if (pn < 18) { base = og; ld = 1024; coff = (pn - 14) * 256; }
        else { base = sg; ld = 4096; coff = (pn - 18) * 256; sgm = true; }
        const int col0 = coff + wc * 32 + 8 * fq;
#pragma unroll
        for (int ai = 0; ai < 2; ++ai)
#pragma unroll
            for (int m = 0; m < 4; ++m) { bf16_t* rowp = base + (size_t)(row0 + ai * HALF + m * 16) * ld + col0;
#pragma unroll
                for (int bj = 0; bj < 2; ++bj) { f32x4 v0 = acc[ai][bj][m][0], v1 = acc[ai][bj][m][1];
                    if (sgm) {
#pragma unroll
                        for (int j = 0; j < 4; ++j) { v0[j] = sigm(v0[j]); v1[j] = sigm(v1[j]); } }
                    u32x4 w; w.x = cvt_pk_bf16(v0[0], v0[1]); w.y = cvt_pk_bf16(v0[2], v0[3]); w.z = cvt_pk_bf16(v1[0], v1[1]); w.w = cvt_pk_bf16(v1[2], v1[3]);
                    *(u32x4*)(rowp + bj * HALF) = w; } }
    } };
struct EpiYaF { static constexpr bool PERM = true, AFTER_DRAIN = false; const bf16_t* sg; float* m1;
    __device__ __forceinline__ void operator()(AccRef acc, const Unit& u, int wr, int wc, int fr, int fq) const {
        const int row0 = u.pm * BM + wr * 64 + fr, col0 = u.pn * BM + wc * 32 + 8 * fq;
#pragma unroll
        for (int ai = 0; ai < 2; ++ai)
#pragma unroll
            for (int m = 0; m < 4; ++m) { const size_t r = (size_t)(row0 + ai * HALF + m * 16);
#pragma unroll
                for (int bj = 0; bj < 2; ++bj) { const int c = col0 + bj * HALF; const u32x4 s = *(const u32x4*)(sg + r * 4096 + c);
                    f32x4 o0, o1; o0[0] = bflo(s.x) * acc[ai][bj][m][0][0]; o0[1] = bfhi(s.x) * acc[ai][bj][m][0][1]; o0[2] = bflo(s.y) * acc[ai][bj][m][0][2]; o0[3] = bfhi(s.y) * acc[ai][bj][m][0][3];
                    o1[0] = bflo(s.z) * acc[ai][bj][m][1][0]; o1[1] = bfhi(s.z) * acc[ai][bj][m][1][1]; o1[2] = bflo(s.w) * acc[ai][bj][m][1][2]; o1[3] = bfhi(s.w) * acc[ai][bj][m][1][3];
                    *(f32x4*)(m1 + r * 2048 + c) = o0; *(f32x4*)(m1 + r * 2048 + c + 4) = o1; } }
    } };
struct EpiYbF { static constexpr bool PERM = true, AFTER_DRAIN = false; const bf16_t* sg; const float* m1; bf16_t* mb;
    __device__ __forceinline__ void operator()(AccRef acc, const Unit& u, int wr, int wc, int fr, int fq) const {
        const int row0 = u.pm * BM + wr * 64 + fr, col0 = u.pn * BM + wc * 32 + 8 * fq;
#pragma unroll
        for (int ai = 0; ai < 2; ++ai)
#pragma unroll
            for (int m = 0; m < 4; ++m) { const size_t r = (size_t)(row0 + ai * HALF + m * 16);
#pragma unroll
                for (int bj = 0; bj < 2; ++bj) { const int c = col0 + bj * HALF; const u32x4 s = *(const u32x4*)(sg + r * 4096 + 2048 + c);
                    const f32x4 a0 = *(const f32x4*)(m1 + r * 2048 + c), a1 = *(const f32x4*)(m1 + r * 2048 + c + 4);
                    const float o0 = a0[0] + bflo(s.x) * acc[ai][bj][m][0][0], o1 = a0[1] + bfhi(s.x) * acc[ai][bj][m][0][1], o2 = a0[2] + bflo(s.y) * acc[ai][bj][m][0][2], o3 = a0[3] + bfhi(s.y) * acc[ai][bj][m][0][3];
                    const float o4 = a1[0] + bflo(s.z) * acc[ai][bj][m][1][0], o5 = a1[1] + bfhi(s.z) * acc[ai][bj][m][1][1], o6 = a1[2] + bflo(s.w) * acc[ai][bj][m][1][2], o7 = a1[3] + bfhi(s.w) * acc[ai][bj][m][1][3];
                    u32x4 w; w.x = cvt_pk_bf16(o0, o1); w.y = cvt_pk_bf16(o2, o3); w.z = cvt_pk_bf16(o4, o5); w.w = cvt_pk_bf16(o6, o7);
                    *(u32x4*)(mb + r * 2048 + c) = w; } }
    } };
struct EpiMergeF { static constexpr bool PERM = true, AFTER_DRAIN = false, MIDK = true; const bf16_t* sg; bf16_t* mb;
    __device__ __forceinline__ void mid(f32x4 (&acc)[2][2][4][2], const Unit& u, int wr, int wc, int fr, int fq) const {
        int row0 = u.pm * BM + wr * 64 + fr, col0 = u.pn * BM + wc * 32 + 8 * fq;
        asm volatile("" : "+v"(row0), "+v"(col0));
#pragma unroll
        for (int ai = 0; ai < 2; ++ai)
#pragma unroll
            for (int m = 0; m < 4; ++m) { const size_t r = (size_t)(row0 + ai * HALF + m * 16);
#pragma unroll
                for (int bj = 0; bj < 2; ++bj) { const int c = col0 + bj * HALF; const u32x4 a = *(const u32x4*)(sg + r * 4096 + c), b = *(const u32x4*)(sg + r * 4096 + 2048 + c);
                    acc[ai][bj][m][0][0] *= bflo(a.x) * __builtin_amdgcn_rcpf(bflo(b.x)); acc[ai][bj][m][0][1] *= bfhi(a.x) * __builtin_amdgcn_rcpf(bfhi(b.x));
                    acc[ai][bj][m][0][2] *= bflo(a.y) * __builtin_amdgcn_rcpf(bflo(b.y)); acc[ai][bj][m][0][3] *= bfhi(a.y) * __builtin_amdgcn_rcpf(bfhi(b.y));
                    acc[ai][bj][m][1][0] *= bflo(a.z) * __builtin_amdgcn_rcpf(bflo(b.z)); acc[ai][bj][m][1][1] *= bfhi(a.z) * __builtin_amdgcn_rcpf(bfhi(b.z));
                    acc[ai][bj][m][1][2] *= bflo(a.w) * __builtin_amdgcn_rcpf(bflo(b.w)); acc[ai][bj][m][1][3] *= bfhi(a.w) * __builtin_amdgcn_rcpf(bfhi(b.w)); }
                asm volatile("" ::: "memory"); }
    }
    __device__ __forceinline__ void operator()(AccRef acc, const Unit& u, int wr, int wc, int fr, int fq) const {
        const int row0 = u.pm * BM + wr * 64 + fr, col0 = u.pn * BM + wc * 32 + 8 * fq;
#pragma unroll
        for (int ai = 0; ai < 2; ++ai)
#pragma unroll
            for (int m = 0; m < 4; ++m) { const size_t r = (size_t)(row0 + ai * HALF + m * 16);
#pragma unroll
                for (int bj = 0; bj < 2; ++bj) { const int c = col0 + bj * HALF; const u32x4 b = *(const u32x4*)(sg + r * 4096 + 2048 + c);
                    u32x4 w; w.x = cvt_pk_bf16(acc[ai][bj][m][0][0] * bflo(b.x), acc[ai][bj][m][0][1] * bfhi(b.x)); w.y = cvt_pk_bf16(acc[ai][bj][m][0][2] * bflo(b.y), acc[ai][bj][m][0][3] * bfhi(b.y));
                    w.z = cvt_pk_bf16(acc[ai][bj][m][1][0] * bflo(b.z), acc[ai][bj][m][1][1] * bfhi(b.z)); w.w = cvt_pk_bf16(acc[ai][bj][m][1][2] * bflo(b.w), acc[ai][bj][m][1][3] * bfhi(b.w));
                    *(u32x4*)(mb + r * 2048 + c) = w; } }
    } };
template <class E, class = void> struct HasMid { static constexpr bool value = false; };
template <class E> struct HasMid<E, decltype((void)E::MIDK)> { static constexpr bool value = E::MIDK; };
template <int MODE> struct EpiF32F { static constexpr bool PERM = false, AFTER_DRAIN = false; const float* base; const float* pp; float* out;
    __device__ __forceinline__ void operator()(AccRef acc, const Unit& u, int wr, int wc, int fr, int fq) const {
        const int row0 = u.pm * BM + wr * 64 + fr, col0 = u.pn * BM + wc * 32 + 4 * fq;
#pragma unroll
        for (int ai = 0; ai < 2; ++ai)
#pragma unroll
            for (int m = 0; m < 4; ++m) { const size_t ro = (size_t)(row0 + ai * HALF + m * 16) * 2048 + col0;
#pragma unroll
                for (int bj = 0; bj < 2; ++bj)
#pragma unroll
                    for (int n = 0; n < 2; ++n) { const size_t o = ro + bj * HALF + n * 16; f32x4 v = acc[ai][bj][m][n];
                        if (MODE == 1) { const f32x4 b = *(const f32x4*)(base + o); v = b * DN_ALPHA + v; }
                        if (MODE == 2) { const f32x4 b = *(const f32x4*)(base + o), q = *(const f32x4*)(pp + o);
#pragma unroll
                            for (int j = 0; j < 4; ++j) v[j] = DN_ALPHA * b[j] + sigm(v[j]) * q[j]; }
                        *(f32x4*)(out + o) = v; } }
    } };
struct EpiUpF { static constexpr bool PERM = true, AFTER_DRAIN = false; const float* bup; bf16_t* act;
    __device__ __forceinline__ void operator()(AccRef acc, const Unit& u, int wr, int wc, int fr, int fq) const {
        const int e = u.pm >> 5, row0 = u.pm * BM + wr * 64 + fr, cj = u.pn * 128 + wc * 32 + 8 * fq;
        const f32x4 bg0 = *(const f32x4*)(bup + e * 4096 + cj), bg1 = *(const f32x4*)(bup + e * 4096 + cj + 4), bl0 = *(const f32x4*)(bup + e * 4096 + 2048 + cj), bl1 = *(const f32x4*)(bup + e * 4096 + 2048 + cj + 4);
#pragma unroll
        for (int ai = 0; ai < 2; ++ai)
#pragma unroll
            for (int m = 0; m < 4; ++m) { const size_t r = (size_t)(row0 + ai * HALF + m * 16);
                const f32x4 g0 = acc[ai][0][m][0] + bg0, g1 = acc[ai][0][m][1] + bg1, l0 = acc[ai][1][m][0] + bl0, l1 = acc[ai][1][m][1] + bl1; float o[8];
#pragma unroll
                for (int j = 0; j < 4; ++j) { const float ga = fminf(g0[j], 7.f), la = fminf(fmaxf(l0[j], -7.f), 7.f); o[j] = ga * sigm(1.702f * ga) * (la + 1.f);
                    const float gb = fminf(g1[j], 7.f), lb = fminf(fmaxf(l1[j], -7.f), 7.f); o[4 + j] = gb * sigm(1.702f * gb) * (lb + 1.f); }
                u32x4 w; w.x = cvt_pk_bf16(o[0], o[1]); w.y = cvt_pk_bf16(o[2], o[3]); w.z = cvt_pk_bf16(o[4], o[5]); w.w = cvt_pk_bf16(o[6], o[7]);
                *(u32x4*)(act + r * 2048 + cj) = w; }
    } };
struct EpiUpF8 { static constexpr bool PERM = true, AFTER_DRAIN = false; const float* bup; unsigned char* act;
    __device__ __forceinline__ void operator()(AccRef acc, const Unit& u, int wr, int wc, int fr, int fq) const {
        const int e = u.pm >> 5, row0 = u.pm * BM + wr * 64 + fr, cj = u.pn * 128 + wc * 32 + 8 * fq;
        const f32x4 bg0 = *(const f32x4*)(bup + e * 4096 + cj), bg1 = *(const f32x4*)(bup + e * 4096 + cj + 4), bl0 = *(const f32x4*)(bup + e * 4096 + 2048 + cj), bl1 = *(const f32x4*)(bup + e * 4096 + 2048 + cj + 4);
#pragma unroll
        for (int ai = 0; ai < 2; ++ai)
#pragma unroll
            for (int m = 0; m < 4; ++m) { const size_t r = (size_t)(row0 + ai * HALF + m * 16);
                const f32x4 g0 = acc[ai][0][m][0] * W8_INV + bg0, g1 = acc[ai][0][m][1] * W8_INV + bg1, l0 = acc[ai][1][m][0] * W8_INV + bl0, l1 = acc[ai][1][m][1] * W8_INV + bl1; float o[8];
#pragma unroll
                for (int j = 0; j < 4; ++j) { const float ga = fminf(g0[j], 7.f), la = fminf(fmaxf(l0[j], -7.f), 7.f); o[j] = ga * sigm(1.702f * ga) * (la + 1.f);
                    const float gb = fminf(g1[j], 7.f), lb = fminf(fmaxf(l1[j], -7.f), 7.f); o[4 + j] = gb * sigm(1.702f * gb) * (lb + 1.f); }
                uint2 w; w.x = pk_fp8x4(o[0], o[1], o[2], o[3]); w.y = pk_fp8x4(o[4], o[5], o[6], o[7]);
                *(uint2*)(act + r * 2048 + cj) = w; }
    } };
struct EpiDownF8 { static constexpr bool PERM = true, AFTER_DRAIN = false; const float* bdn; bf16_t* y;
    __device__ __forceinline__ void operator()(AccRef acc, const Unit& u, int wr, int wc, int fr, int fq) const {
        const int e = u.pm >> 5, row0 = u.pm * BM + wr * 64 + fr, col0 = u.pn * BM + wc * 32 + 8 * fq;
        f32x4 bv[2][2];
#pragma unroll
        for (int bj = 0; bj < 2; ++bj)
#pragma unroll
            for (int n = 0; n < 2; ++n) bv[bj][n] = *(const f32x4*)(bdn + e * 2048 + col0 + bj * HALF + 4 * n);
#pragma unroll
        for (int ai = 0; ai < 2; ++ai)
#pragma unroll
            for (int m = 0; m < 4; ++m) { bf16_t* rowp = y + (size_t)(row0 + ai * HALF + m * 16) * 2048 + col0;
#pragma unroll
                for (int bj = 0; bj < 2; ++bj) { const f32x4 v0 = acc[ai][bj][m][0] * W8_INV + bv[bj][0], v1 = acc[ai][bj][m][1] * W8_INV + bv[bj][1];
                    u32x4 w; w.x = cvt_pk_bf16(v0[0], v0[1]); w.y = cvt_pk_bf16(v0[2], v0[3]); w.z = cvt_pk_bf16(v1[0], v1[1]); w.w = cvt_pk_bf16(v1[2], v1[3]);
                    *(u32x4*)(rowp + bj * HALF) = w; } }
    } };
struct EpiDownF { static constexpr bool PERM = true, AFTER_DRAIN = false; const float* bdn; bf16_t* y;
    __device__ __forceinline__ void operator()(AccRef acc, const Unit& u, int wr, int wc, int fr, int fq) const {
        const int e = u.pm >> 5, row0 = u.pm * BM + wr * 64 + fr, col0 = u.pn * BM + wc * 32 + 8 * fq;
        f32x4 bv[2][2];
#pragma unroll
        for (int bj = 0; bj < 2; ++bj)
#pragma unroll
            for (int n = 0; n < 2; ++n) bv[bj][n] = *(const f32x4*)(bdn + e * 2048 + col0 + bj * HALF + 4 * n);
#pragma unroll
        for (int ai = 0; ai < 2; ++ai)
#pragma unroll
            for (int m = 0; m < 4; ++m) { bf16_t* rowp = y + (size_t)(row0 + ai * HALF + m * 16) * 2048 + col0;
#pragma unroll
                for (int bj = 0; bj < 2; ++bj) { const f32x4 v0 = acc[ai][bj][m][0] + bv[bj][0], v1 = acc[ai][bj][m][1] + bv[bj][1];
                    u32x4 w; w.x = cvt_pk_bf16(v0[0], v0[1]); w.y = cvt_pk_bf16(v0[2], v0[3]); w.z = cvt_pk_bf16(v1[0], v1[1]); w.w = cvt_pk_bf16(v1[2], v1[3]);
                    *(u32x4*)(rowp + bj * HALF) = w; } }
    } };

template <class Epi, class Sched, bool STAMP = false, bool FP8 = false>
__device__ __forceinline__ void gemm_phase(PG8_LAS unsigned char* lds, const Gemm g, const Sched& S, const Epi& E, unsigned long long* stamps, int lda = 0) {
    const int tid = threadIdx.x, wid = __builtin_amdgcn_readfirstlane(tid >> 6), lane = tid & 63, wr = wid >> 2, wc = wid & 3, fr = lane & 15, fq = lane >> 4;
    const int K = g.K, nt = K / BK, LDA = lda ? lda : K;
    int ts_lo = 0, ts_hi = 0, nts = 0; const unsigned long long rt_entry = STAMP ? (unsigned long long)wall_clock64() : 0ull;
#define PG8_STAMP() do { if (STAMP && wid == 0 && nts < 64) { const unsigned long long _c = (unsigned long long)clock64(); \
        ts_lo = (lane == nts) ? (int)(unsigned)_c : ts_lo; ts_hi = (lane == nts) ? (int)(unsigned)(_c >> 32) : ts_hi; ++nts; } } while (0)
    PG8_STAMP();
    unsigned voffA[2], voffB[2];
#pragma unroll
    for (int i = 0; i < 2; ++i) { int R, C; stage_rc(tid * 16 + i * 8192, R, C); const int Rb = Epi::PERM ? ((R & ~31) + perm32(R & 31)) : R;
        voffA[i] = (unsigned)(R * LDA + C) * 2u; voffB[i] = (unsigned)(Rb * K + C) * 2u; }
    const size_t kstep = (size_t)(BK * 2);
    const size_t hstep = (size_t)HALF * K * 2;
    const size_t tstep = 2 * hstep;
    const size_t hstepA = (size_t)HALF * LDA * 2, tstepA = 2 * hstepA;
    const unsigned ldsw = (unsigned)wid * 1024u;
    const int aoff = lds_byte(wr * 64 + fr, fq * 8), boff = lds_byte(wc * 32 + fr, fq * 8);
#define PG8_SA(b, h) (((b) * 2 + (h)) * HTB)
#define PG8_SB(b, h) ((4 + (b) * 2 + (h)) * HTB)
#define PG8_STAGE(bufoff, gbase, voff) do { _Pragma("unroll") for (int _i = 0; _i < 2; ++_i) \
        __builtin_amdgcn_global_load_lds((const unsigned*)((const char*)(gbase) + (voff)[_i]), (PG8_LAS unsigned*)(lds + (bufoff) + ldsw + _i * 8192), 16, 0, 0); } while (0)
#define PG8_LDA(dst, b, h) do { _Pragma("unroll") for (int m = 0; m < 4; ++m) { const bf16x8 x0_ = *(const PG8_LAS bf16x8*)(lds + PG8_SA(b, h) + aoff + m * 2048), x1_ = *(const PG8_LAS bf16x8*)(lds + PG8_SA(b, h) + aoff + m * 2048 + 1024); \
        if constexpr (FP8) dst##8[m] = cat8(x0_, x1_); else { dst[m][0] = x0_; dst[m][1] = x1_; } } } while (0)
#define PG8_LDB(dst, b, h) do { _Pragma("unroll") for (int n = 0; n < 2; ++n) { const bf16x8 x0_ = *(const PG8_LAS bf16x8*)(lds + PG8_SB(b, h) + boff + n * 2048), x1_ = *(const PG8_LAS bf16x8*)(lds + PG8_SB(b, h) + boff + n * 2048 + 1024); \
        if constexpr (FP8) dst##8[n] = cat8(x0_, x1_); else { dst[n][0] = x0_; dst[n][1] = x1_; } } } while (0)
#define PG8_MMA(ai, bj, At, Bt) do { __builtin_amdgcn_s_setprio(1); _Pragma("unroll") for (int m = 0; m < 4; ++m) _Pragma("unroll") for (int n = 0; n < 2; ++n) { \
        if constexpr (FP8) asm volatile("v_mfma_f32_16x16x128_f8f6f4 %0, %1, %2, %0" : "+v"(acc[ai][bj][m][n]) : "v"(Bt##8[n]), "v"(At##8[m]));   \
        else { _Pragma("unroll") for (int k = 0; k < 2; ++k) acc[ai][bj][m][n] = __builtin_amdgcn_mfma_f32_16x16x32_bf16(Bt[n][k], At[m][k], acc[ai][bj][m][n], 0, 0, 0); } } __builtin_amdgcn_s_setprio(0); } while (0)
#define PG8_WAIT_V(n) asm volatile("s_waitcnt vmcnt(" #n ")" ::: "memory")
#define PG8_WAIT_L(n) asm volatile("s_waitcnt lgkmcnt(" #n ")" ::: "memory")
#define PG8_BAR __builtin_amdgcn_s_barrier()
#define PG8_SCHED __builtin_amdgcn_sched_barrier(0)
    Unit cur, nxt; int ui = 0;
    if (!S.next(0, cur)) return;
    f32x4 acc[2][2][4][2];
#pragma unroll
    for (int a = 0; a < 2; ++a)
#pragma unroll
        for (int b = 0; b < 2; ++b)
#pragma unroll
            for (int m = 0; m < 4; ++m)
#pragma unroll
                for (int n = 0; n < 2; ++n) acc[a][b][m][n] = (f32x4){0.f, 0.f, 0.f, 0.f};
    bf16x8 At[4][2], B0[2][2], B1[2][2]; v8i At8[4], B08[2], B18[2];
    const char* cA = S.abase(g, cur, tstepA); const char* cB = S.bbase(g, cur, tstep);
    S.a_ready(cur);
    PG8_STAGE(PG8_SB(0, 0), cB, voffB); PG8_STAGE(PG8_SA(0, 0), cA, voffA); PG8_STAGE(PG8_SB(0, 1), cB + hstep, voffB); PG8_STAGE(PG8_SA(0, 1), cA + hstepA, voffA);
    if (wr == 1) PG8_BAR;
    PG8_WAIT_V(4); PG8_BAR;
    PG8_STAGE(PG8_SB(1, 0), cB + kstep, voffB); PG8_STAGE(PG8_SA(1, 0), cA + kstep, voffA); PG8_STAGE(PG8_SB(1, 1), cB + hstep + kstep, voffB);
    PG8_WAIT_V(6); PG8_BAR;
    PG8_STAMP();
    for (;;) {
        const bool has_next = S.next(ui + 1, nxt);
        const char* nA = has_next ? S.abase(g, nxt, tstepA) : cA; const char* nB = has_next ? S.bbase(g, nxt, tstep) : cB;
        for (int t = 0; t < nt; t += 2) {
            const bool last = (t == nt - 2);
            const char* a1 = cA + (size_t)(t + 1) * kstep;
            const char* a2 = last ? nA : cA + (size_t)(t + 2) * kstep; const char* b2 = last ? nB : cB + (size_t)(t + 2) * kstep;
            const char* a3 = a2 + kstep; const char* b3 = b2 + kstep;
            if (last && has_next) S.a_ready(nxt);
            if constexpr (HasMid<Epi>::value) { if (t == (nt >> 1)) { PG8_SCHED; E.mid(acc, cur, wr, wc, fr, fq); PG8_SCHED; } }
            PG8_LDB(B0, 0, 0); PG8_SCHED; PG8_LDA(At, 0, 0); PG8_STAGE(PG8_SA(1, 1), a1 + hstepA, voffA);
            PG8_WAIT_L(8); PG8_BAR; PG8_WAIT_L(0); PG8_MMA(0, 0, At, B0); PG8_BAR; PG8_SCHED;
            PG8_LDB(B1, 0, 1); PG8_STAGE(PG8_SB(0, 0), b2, voffB);
            PG8_BAR; PG8_WAIT_L(0); PG8_MMA(0, 1, At, B1); PG8_BAR;
            PG8_LDA(At, 0, 1); PG8_STAGE(PG8_SA(0, 0), a2, voffA);
            PG8_BAR; PG8_WAIT_L(0); PG8_MMA(1, 0, At, B0); PG8_BAR; PG8_SCHED;
            PG8_STAGE(PG8_SB(0, 1), b2 + hstep, voffB);
            PG8_WAIT_V(6); PG8_BAR; PG8_MMA(1, 1, At, B1); PG8_BAR;
            PG8_LDB(B0, 1, 0); PG8_SCHED; PG8_LDA(At, 1, 0); PG8_STAGE(PG8_SA(0, 1), a2 + hstepA, voffA);
            PG8_WAIT_L(8); PG8_BAR; PG8_WAIT_L(0); PG8_MMA(0, 0, At, B0); PG8_BAR; PG8_SCHED;
            PG8_LDB(B1, 1, 1); PG8_STAGE(PG8_SB(1, 0), b3, voffB);
            PG8_BAR; PG8_WAIT_L(0); PG8_MMA(0, 1, At, B1); PG8_BAR;
            PG8_LDA(At, 1, 1); PG8_STAGE(PG8_SA(1, 0), a3, voffA);
            PG8_BAR; PG8_WAIT_L(0); PG8_MMA(1, 0, At, B0); PG8_BAR; PG8_SCHED;
            PG8_STAGE(PG8_SB(1, 1), b3 + hstep, voffB);
            PG8_WAIT_V(6); PG8_BAR; PG8_MMA(1, 1, At, B1); PG8_BAR;
        }
        PG8_STAMP();
        if constexpr (!Epi::AFTER_DRAIN) { E(acc, cur, wr, wc, fr, fq); S.done(cur); }
        PG8_STAMP();
        if (!has_next) break;
#pragma unroll
        for (int a = 0; a < 2; ++a)
#pragma unroll
            for (int b = 0; b < 2; ++b)
#pragma unroll
                for (int m = 0; m < 4; ++m)
#pragma unroll
                    for (int n = 0; n < 2; ++n) acc[a][b][m][n] = (f32x4){0.f, 0.f, 0.f, 0.f};
        cur = nxt; cA = nA; cB = nB; ++ui;
    }
    PG8_WAIT_V(0);
    if (wr == 0) PG8_BAR;
    PG8_BAR;
    if constexpr (Epi::AFTER_DRAIN) { E.fused(acc, cur, wr, wc, fr, fq, lds, wid, lane); S.done(cur); }
    PG8_STAMP();
    if (STAMP && wid == 0) { stamps[lane] = lane < nts ? (((unsigned long long)(unsigned)ts_hi << 32) | (unsigned)ts_lo) : 0ull;
        if (lane == 62) stamps[62] = rt_entry; if (lane == 63) stamps[63] = (unsigned long long)wall_clock64(); }
#undef PG8_STAMP
#undef PG8_SA
#undef PG8_SB
#undef PG8_STAGE
#undef PG8_LDA
#undef PG8_LDB
#undef PG8_MMA
#undef PG8_WAIT_V
#undef PG8_WAIT_L
#undef PG8_BAR
#undef PG8_SCHED
}

}

namespace attn {
using bf16 = bf16_t;
constexpr int   D = 128, NW = 8, QBLK = 32, KVBLK = 64;
constexpr float SCALE = 0.088388347648318440f;
constexpr float THR = 8.f;
constexpr int SDEPTH = 2;
constexpr int LDQ = 1024, LDK = 256, LDO = 2048;
constexpr size_t SHM_V = KVBLK * D * 2, SHM_K = KVBLK * D * 2, SHM_ATTN = 2 * SHM_V + 2 * SHM_K + NW * 64 * 4;
using bf16x8 = __attribute__((ext_vector_type(8))) short;
using s16x4  = __attribute__((ext_vector_type(4))) short;
using f32x16 = __attribute__((ext_vector_type(16))) float;
using f32x8  = __attribute__((ext_vector_type(8))) float;
using u32x4  = __attribute__((ext_vector_type(4))) unsigned;
#define KSWZ(row, colB) ((row) * 256 + ((colB) ^ (((row) & 7) << 4)))
#define SBAR() __builtin_amdgcn_sched_barrier(0)
__device__ __forceinline__ int crow(int r, int hi) { return (r & 3) + 8 * (r >> 2) + 4 * hi; }
__device__ __forceinline__ unsigned cvtpk(float lo, float hi) {
  unsigned r; asm volatile("v_cvt_pk_bf16_f32 %0, %1, %2" : "=v"(r) : "v"(lo), "v"(hi)); return r;
}
__device__ __forceinline__ void partialSM(f32x16& p0, f32x16& p1, float& m_reg, float& mn, float& alpha) {
  constexpr float C = SCALE * 1.4426950408889634f;
  float pmax = p0[0]; for (int r = 1; r < 16; ++r) pmax = fmaxf(pmax, p0[r]); for (int r = 0; r < 16; ++r) pmax = fmaxf(pmax, p1[r]);
  { auto rr = __builtin_amdgcn_permlane32_swap(__float_as_uint(pmax), __float_as_uint(pmax), false, false);
    pmax = fmaxf(__uint_as_float(rr[0]), __uint_as_float(rr[1])); }
  if (__builtin_expect(__all(pmax - m_reg <= THR / SCALE), 1)) { mn = m_reg; alpha = 1.f; }
  else { mn = fmaxf(m_reg, pmax); alpha = __builtin_amdgcn_exp2f((m_reg - mn) * C); m_reg = mn; }
  float mnC = -mn * C;
  for (int r = 0; r < 16; ++r) p0[r] = fmaf(p0[r], C, mnC); for (int r = 0; r < 16; ++r) p1[r] = fmaf(p1[r], C, mnC);
  for (int r = 0; r < 16; ++r) p0[r] = __builtin_amdgcn_exp2f(p0[r]);
}
__device__ __forceinline__ void finishSM(f32x16& p0, f32x16& p1, float alpha, float& l_reg, bf16x8& pa0, bf16x8& pa1, bf16x8& pa2, bf16x8& pa3) {
  for (int r = 0; r < 16; ++r) p1[r] = __builtin_amdgcn_exp2f(p1[r]);
  float ps = 0; for (int r = 0; r < 16; ++r) ps += p0[r]; for (int r = 0; r < 16; ++r) ps += p1[r];
  { auto rr = __builtin_amdgcn_permlane32_swap(__float_as_uint(ps), __float_as_uint(ps), false, false);
    ps = __uint_as_float(rr[0]) + __uint_as_float(rr[1]); }
  l_reg = l_reg * alpha + ps;
#define PK4(P, BASE, OUT) do { unsigned a0 = cvtpk(P[BASE + 0], P[BASE + 1]), a1 = cvtpk(P[BASE + 2], P[BASE + 3]);   \
    unsigned b0 = cvtpk(P[BASE + 4], P[BASE + 5]), b1 = cvtpk(P[BASE + 6], P[BASE + 7]);                              \
    auto r0 = __builtin_amdgcn_permlane32_swap(a0, b0, false, false); auto r1 = __builtin_amdgcn_permlane32_swap(a1, b1, false, false); \
    u32x4 w = {r0[0], r1[0], r0[1], r1[1]}; OUT = *reinterpret_cast<bf16x8*>(&w); } while (0)
  PK4(p0, 0, pa0); PK4(p0, 8, pa1); PK4(p1, 0, pa2); PK4(p1, 8, pa3);
#undef PK4
}
__device__ __forceinline__ void qkt(f32x16& p0, f32x16& p1, const bf16* Ks, const bf16x8* qr, int r32, int hi) {
  p0 = f32x16{}; p1 = f32x16{};
  for (int d0 = 0; d0 < 8; ++d0) { int cb = (d0 * 16 + hi * 8) * 2;
    bf16x8 b0 = *reinterpret_cast<const bf16x8*>((const char*)Ks + KSWZ(r32, cb));
    bf16x8 b1 = *reinterpret_cast<const bf16x8*>((const char*)Ks + KSWZ(32 + r32, cb));
    p0 = __builtin_amdgcn_mfma_f32_32x32x16_bf16(b0, qr[d0], p0, 0, 0, 0);
    p1 = __builtin_amdgcn_mfma_f32_32x32x16_bf16(b1, qr[d0], p1, 0, 0, 0); }
}
__device__ __forceinline__ int v_st(int k, int c) { const int kk = (k & ~0xC) | ((k & 4) << 1) | ((k & 8) >> 1); return ((kk >> 3) * 4 + (c >> 5)) * 512 + ((kk & 7) * 32 + (c & 31)) * 2; }
__device__ __forceinline__ int v_rd_base(int lane) { return ((lane & 3) << 3) | (((lane >> 2) & 3) << 6) | (((lane >> 4) & 1) << 5) | (((lane >> 5) & 1) << 8); }
constexpr int v_rd_off(int d0, int ks, int half) { return d0 * 512 + ks * 4096 + half * 2048; }
template <int OFF> __device__ __forceinline__ s16x4 tr_read(int vb) {
  s16x4 r; asm volatile("ds_read_b64_tr_b16 %0, %1 offset:%2" : "=&v"(r) : "v"(vb), "i"(OFF) : "memory"); return r;
}
template <int D0> __device__ __forceinline__ void pv_one(f32x16& od, int vb, bf16x8 pa0, bf16x8 pa1, bf16x8 pa2, bf16x8 pa3) {
  const s16x4 l0 = tr_read<v_rd_off(D0, 0, 0)>(vb), h0 = tr_read<v_rd_off(D0, 0, 1)>(vb), l1 = tr_read<v_rd_off(D0, 1, 0)>(vb), h1 = tr_read<v_rd_off(D0, 1, 1)>(vb);
  const s16x4 l2 = tr_read<v_rd_off(D0, 2, 0)>(vb), h2 = tr_read<v_rd_off(D0, 2, 1)>(vb), l3 = tr_read<v_rd_off(D0, 3, 0)>(vb), h3 = tr_read<v_rd_off(D0, 3, 1)>(vb);
  asm volatile("s_waitcnt lgkmcnt(0)" ::: "memory"); SBAR();
#define PK(L, H) (bf16x8){L[0], L[1], L[2], L[3], H[0], H[1], H[2], H[3]}
  od = __builtin_amdgcn_mfma_f32_32x32x16_bf16(pa0, PK(l0, h0), od, 0, 0, 0);
  od = __builtin_amdgcn_mfma_f32_32x32x16_bf16(pa1, PK(l1, h1), od, 0, 0, 0);
  od = __builtin_amdgcn_mfma_f32_32x32x16_bf16(pa2, PK(l2, h2), od, 0, 0, 0);
  od = __builtin_amdgcn_mfma_f32_32x32x16_bf16(pa3, PK(l3, h3), od, 0, 0, 0);
#undef PK
}
__device__ __forceinline__ void pv_d0(f32x16* o, int vb, bf16x8 pa0, bf16x8 pa1, bf16x8 pa2, bf16x8 pa3) {
  pv_one<0>(o[0], vb, pa0, pa1, pa2, pa3); pv_one<1>(o[1], vb, pa0, pa1, pa2, pa3); pv_one<2>(o[2], vb, pa0, pa1, pa2, pa3); pv_one<3>(o[3], vb, pa0, pa1, pa2, pa3);
}
__device__ __forceinline__ void attn_dense_body(const bf16* __restrict__ Qb, const bf16* __restrict__ Kh, const bf16* __restrict__ Vh,
                                                bf16* __restrict__ Ob, int seq, char* lds) {
  const int tid = threadIdx.x, wid = tid >> 6, lane = tid & 63, r32 = lane & 31, hi = lane >> 5;
  bf16* V_lds = (bf16*)lds; bf16* K_lds = (bf16*)(lds + 2 * SHM_V);
  float* ws = (float*)(lds + 2 * SHM_V + 2 * SHM_K) + wid * 64; float* li_l = ws; float* al_l = ws + 32;
  float m_reg = -1e30f, l_reg = 0; f32x16 o[4] = {}; bf16x8 qr[8];
  const bf16* Qw = Qb + (long)(wid * QBLK + r32) * LDQ + hi * 8;
#pragma unroll
  for (int d0 = 0; d0 < 8; ++d0) qr[d0] = *reinterpret_cast<const bf16x8*>(Qw + d0 * 16);
  const int sr = tid >> 4, sc = (tid & 15) * 8, vst0 = v_st(sr, sc), vst1 = v_st(32 + sr, sc);
  const int vb0 = (int)(uintptr_t)V_lds + v_rd_base(lane);
  struct { bf16x8 vs0, vs1, ks0, ks1; } sr_[SDEPTH];
#define SLOAD(i, k0) do { sr_[i].vs0 = *reinterpret_cast<const bf16x8*>(&Vh[(long)((k0) + sr) * LDK + sc]); sr_[i].vs1 = *reinterpret_cast<const bf16x8*>(&Vh[(long)((k0) + 32 + sr) * LDK + sc]); \
    sr_[i].ks0 = *reinterpret_cast<const bf16x8*>(&Kh[(long)((k0) + sr) * LDK + sc]); sr_[i].ks1 = *reinterpret_cast<const bf16x8*>(&Kh[(long)((k0) + 32 + sr) * LDK + sc]); } while (0)
#define SWRITE(b, i) do { *(bf16x8*)((char*)V_lds + (b) * SHM_V + vst0) = sr_[i].vs0;          \
    *(bf16x8*)((char*)V_lds + (b) * SHM_V + vst1) = sr_[i].vs1; int kc = sc * 2;               \
    *(bf16x8*)((char*)K_lds + (b) * SHM_K + KSWZ(sr, kc)) = sr_[i].ks0;                       \
    *(bf16x8*)((char*)K_lds + (b) * SHM_K + KSWZ(32 + sr, kc)) = sr_[i].ks1; } while (0)
#define SWAIT() do { if constexpr (SDEPTH == 2) asm volatile("s_waitcnt vmcnt(4)" ::: "memory"); else asm volatile("s_waitcnt vmcnt(0)" ::: "memory"); } while (0)
#define RESC(a) do { if (__any((a) < 1.f)) { if (hi == 0) al_l[r32] = (a); asm volatile("s_waitcnt lgkmcnt(0)" ::: "memory"); \
    for (int d = 0; d < 4; ++d) for (int r = 0; r < 16; ++r) o[d][r] *= al_l[crow(r, hi)]; } } while (0)
  f32x16 pA0, pA1, pB0, pB1; float mnA, mnB, alA, alB; bf16x8 pa0, pa1, pa2, pa3; const int NT = seq / KVBLK;
  constexpr int SE = 0, SO = SDEPTH - 1;
  SLOAD(SE, 0); asm volatile("s_waitcnt vmcnt(0)" ::: "memory"); SWRITE(0, SE); __syncthreads();
  qkt(pA0, pA1, K_lds, qr, r32, hi); partialSM(pA0, pA1, m_reg, mnA, alA);
  SLOAD(SO, KVBLK); if constexpr (SDEPTH == 2) { if (2 < NT) SLOAD(SE, 2 * KVBLK); }
  SWAIT(); SWRITE(1, SO); __syncthreads();
  for (int j = 1; j + 1 < NT; j += 2) {
    SBAR(); qkt(pB0, pB1, (bf16*)((char*)K_lds + SHM_K), qr, r32, hi);
    finishSM(pA0, pA1, alA, l_reg, pa0, pa1, pa2, pa3); SBAR();
    SLOAD(SO, (j + SDEPTH) * KVBLK); SBAR();
    pv_d0(o, vb0, pa0, pa1, pa2, pa3); partialSM(pB0, pB1, m_reg, mnB, alB);
    __syncthreads(); SWAIT(); SWRITE(0, SE);
    RESC(alB); __syncthreads();
    SBAR(); qkt(pA0, pA1, K_lds, qr, r32, hi);
    finishSM(pB0, pB1, alB, l_reg, pa0, pa1, pa2, pa3); SBAR();
    if (SDEPTH == 1 || j + 3 < NT) SLOAD(SE, (j + 1 + SDEPTH) * KVBLK); SBAR();
    pv_d0(o, vb0 + (int)SHM_V, pa0, pa1, pa2, pa3); partialSM(pA0, pA1, m_reg, mnA, alA);
    __syncthreads(); SWAIT(); SWRITE(1, SO);
    RESC(alA); __syncthreads();
  }
  SBAR(); qkt(pB0, pB1, (bf16*)((char*)K_lds + SHM_K), qr, r32, hi);
  finishSM(pA0, pA1, alA, l_reg, pa0, pa1, pa2, pa3); SBAR();
  pv_d0(o, vb0, pa0, pa1, pa2, pa3); partialSM(pB0, pB1, m_reg, mnB, alB);
  __syncthreads(); RESC(alB);
  finishSM(pB0, pB1, alB, l_reg, pa0, pa1, pa2, pa3); SBAR();
  pv_d0(o, vb0 + (int)SHM_V, pa0, pa1, pa2, pa3);
  if (hi == 0) li_l[r32] = l_reg; asm volatile("s_waitcnt lgkmcnt(0)" ::: "memory");
  float rli[16];
#pragma unroll
  for (int r = 0; r < 16; ++r) rli[r] = __builtin_amdgcn_rcpf(li_l[crow(r, hi)]);
  bf16* Ow = Ob + (long)(wid * QBLK) * LDO;
#pragma unroll
  for (int r = 0; r < 16; ++r) { int orow = crow(r, hi);
    for (int d0 = 0; d0 < 4; ++d0) Ow[(long)orow * LDO + d0 * 32 + r32] = f2bf(o[d0][r] * rli[r]); }
#undef SLOAD
#undef SWRITE
#undef SWAIT
#undef RESC
}
}

#define XB_TMO      128
#define XB_XCNT(j)  (256  + 64 * (j))
#define XB_XSUB(j)  (1280 + 64 * (j))
#define XB_XGEN(j)  (2304 + 64 * (j))
#define XB_TOP      3328
#define XB_TOPGEN   3392
#define XCD_BAR_WORDS 3456
#define XB_SPIN_CAP (1u << 18)
#ifndef LAS
#define LAS __attribute__((address_space(3)))
#endif

__device__ __forceinline__ unsigned xb_ld(unsigned* p)              { return __hip_atomic_load(p, __ATOMIC_RELAXED, __HIP_MEMORY_SCOPE_AGENT); }
__device__ __forceinline__ unsigned xb_add(unsigned* p, unsigned v) { return __hip_atomic_fetch_add(p, v, __ATOMIC_RELAXED, __HIP_MEMORY_SCOPE_AGENT); }
__device__ __forceinline__ unsigned xb_xcc_id() { return (unsigned)__builtin_amdgcn_s_getreg((3 << 11) | 20) & 0xFu; }
#define XB_SPIN(cond, bar) do { unsigned _sp = 0; while (cond) { __builtin_amdgcn_s_sleep(1); \
    if ((++_sp & 255u) == 0u) { if (xb_ld(&(bar)[XB_TMO])) break; if (_sp > XB_SPIN_CAP) { atomicAdd(&(bar)[XB_TMO], 1u); break; } } } } while (0)

struct XcdBarrier {
    unsigned* bar; unsigned x;
    volatile LAS unsigned* st;
};

__device__ __forceinline__ XcdBarrier xcd_barrier_post(unsigned* bar, volatile LAS unsigned* st) {
    XcdBarrier b; b.bar = bar; b.x = xb_xcc_id(); b.st = st;
    if (threadIdx.x == 0) (void)xb_add(&bar[XB_XCNT(b.x)], 1u);
    return b;
}
__device__ __forceinline__ void xcd_barrier_complete(unsigned* bar, unsigned x, unsigned& nloc, unsigned& nx) {
    const unsigned G = gridDim.x * gridDim.y * gridDim.z;
    unsigned sum, cnt, mine, sp = 0u;
    for (;;) {
        sum = 0u; cnt = 0u; mine = 0u;
#pragma unroll
        for (unsigned j = 0; j < 16; ++j) { const unsigned c = xb_ld(&bar[XB_XCNT(j)]); sum += c; cnt += (c > 0u) ? 1u : 0u; mine = (j == x) ? c : mine; }
        if (sum == G) break;
        __builtin_amdgcn_s_sleep(1);
        if ((++sp & 255u) == 0u) { if (xb_ld(&bar[XB_TMO])) break; if (sp > XB_SPIN_CAP) { atomicAdd(&bar[XB_TMO], 1u); break; } }
    }
    nloc = mine > 0u ? mine : 1u; nx = cnt > 0u ? cnt : 1u;
}

__device__ __forceinline__ void xcd_barrier(const XcdBarrier& b) {
    asm volatile("s_waitcnt vmcnt(0)" ::: "memory");
    __syncthreads();
    if (threadIdx.x == 0) {
        unsigned* bar = b.bar;
        __builtin_amdgcn_s_waitcnt(0);
        unsigned nloc = b.st[0], nx = b.st[1];
        if (nloc == 0u) { xcd_barrier_complete(bar, b.x, nloc, nx); b.st[0] = nloc; b.st[1] = nx; }
        const unsigned old = xb_add(&bar[XB_XSUB(b.x)], 1u);
        const unsigned gen = old / nloc;
        if (old + 1u == (gen + 1u) * nloc) {
            __builtin_amdgcn_fence(__ATOMIC_RELEASE, "agent");
            asm volatile("s_waitcnt vmcnt(0)" ::: "memory");
            const unsigned og = xb_add(&bar[XB_TOP], 1u);
            const unsigned tg = og / nx;
            if (og + 1u == (tg + 1u) * nx) xb_add(&bar[XB_TOPGEN], 1u);
            else XB_SPIN(xb_ld(&bar[XB_TOPGEN]) == tg, bar);
            __builtin_amdgcn_fence(__ATOMIC_ACQUIRE, "agent");
            xb_add(&bar[XB_XGEN(b.x)], 1u);
            asm volatile("s_waitcnt vmcnt(0)" ::: "memory");
        } else {
            XB_SPIN(xb_ld(&bar[XB_XGEN(b.x)]) == gen, bar);
            __builtin_amdgcn_fence(__ATOMIC_ACQUIRE, "agent");
            asm volatile("s_waitcnt vmcnt(0)" ::: "memory");
        }
    }
    __syncthreads();
}

constexpr int NWAVES = 8, NTHR = 512;
constexpr int LDS_BYTES = 155648;
constexpr int LDS_TAB = 139264;
constexpr int LDS_BARW = LDS_BYTES - 64;
constexpr size_t WS_SST = 860 * MiB;
constexpr size_t WS_WT_IN = 896 * MiB;
constexpr size_t WS_WT_A = 932 * MiB, WS_WT_B = 936 * MiB, WS_WT_O = 940 * MiB, WS_WT_G = 948 * MiB, WS_WT_P = 956 * MiB;
constexpr size_t WS_WT_UP = 3072 * MiB;
constexpr size_t WS_WT_DN = 3584 * MiB;
constexpr size_t WS_END2 = 3840 * MiB;
constexpr int CW_BAR = 4096;
constexpr int NIN = 8960;
enum { F_TR = 1, F_LN0 = 2, F_INPROJ = 4, F_PREP = 8, F_ATTN = 16, F_GLA = 32, F_YA = 64, F_YB = 128, F_WO = 256, F_LN1 = 512, F_UP = 1024, F_DOWN = 2048, F_LN2 = 4096, F_PLE = 8192, F_LN3 = 16384 };

constexpr int KFLAGS = FAST_MASK;
struct MegaArgs { const float* in[29]; float* out; unsigned char* ws; int ph_lo, ph_hi, flags, li; };

#define LDS_WAIT() asm volatile("s_waitcnt lgkmcnt(0)" ::: "memory")
#define VM_WAIT() asm volatile("s_waitcnt vmcnt(0)" ::: "memory")

struct MapId { __device__ __forceinline__ int operator()(int n) const { return n; } };
struct MapIn { __device__ __forceinline__ int operator()(int n) const { return n < 4608 ? n : (n < 4640 ? 8704 + (n - 4608) : n - 32); } };
struct MapUp { __device__ __forceinline__ int operator()(int n) const { return n < 2048 ? ((n >> 7) << 8) + (n & 127) : (((n - 2048) >> 7) << 8) + 128 + ((n - 2048) & 127); } };
template <class Map> __device__ __forceinline__ void tr_item(const float* W, int K, int N, int k0, int n0, bf16_t* WT, Map map, LAS float* scr, int lane, int kdoff = 0) {
    const int nc = (lane & 15) * 4, kr = lane >> 4; const bool okc = (n0 + nc) < N;
#pragma unroll 4
    for (int i = 0; i < 16; ++i) { const int k = kr + 4 * i; f32x4 v = (f32x4){0.f, 0.f, 0.f, 0.f};
        if (okc) v = *(const f32x4*)(W + (size_t)(k0 + k) * N + n0 + nc);
        scr[k * 65 + nc + 0] = v[0]; scr[k * 65 + nc + 1] = v[1]; scr[k * 65 + nc + 2] = v[2]; scr[k * 65 + nc + 3] = v[3]; }
    LDS_WAIT();
    const int c = lane & 7;
#pragma unroll 2
    for (int i = 0; i < 8; ++i) { const int n = (lane >> 3) + 8 * i;
        if (n0 + n < N) { const LAS float* s = scr + (8 * c) * 65 + n; pg8::u32x4 o;
            o.x = pg8::cvt_pk_bf16(s[0 * 65], s[1 * 65]); o.y = pg8::cvt_pk_bf16(s[2 * 65], s[3 * 65]); o.z = pg8::cvt_pk_bf16(s[4 * 65], s[5 * 65]); o.w = pg8::cvt_pk_bf16(s[6 * 65], s[7 * 65]);
            *(pg8::u32x4*)(WT + (size_t)map(n0 + n) * K + kdoff + k0 + 8 * c) = o; } }
    LDS_WAIT();
}
template <class Map> __device__ __forceinline__ void tr_item8(const float* W, int K, int N, int k0, int n0, unsigned char* WT, Map map, LAS float* scr, int lane) {
    const int nc = (lane & 15) * 4, kr = lane >> 4;
#pragma unroll 4
    for (int i = 0; i < 16; ++i) { const int k = kr + 4 * i; const f32x4 v = *(const f32x4*)(W + (size_t)(k0 + k) * N + n0 + nc);
        scr[k * 65 + nc + 0] = v[0]; scr[k * 65 + nc + 1] = v[1]; scr[k * 65 + nc + 2] = v[2]; scr[k * 65 + nc + 3] = v[3]; }
    LDS_WAIT();
    const int c = lane & 7;
#pragma unroll 2
    for (int i = 0; i < 8; ++i) { const int n = (lane >> 3) + 8 * i; const LAS float* s = scr + (8 * c) * 65 + n; uint2 o;
        o.x = pg8::pk_fp8x4(s[0 * 65] * pg8::W8_SCALE, s[1 * 65] * pg8::W8_SCALE, s[2 * 65] * pg8::W8_SCALE, s[3 * 65] * pg8::W8_SCALE);
        o.y = pg8::pk_fp8x4(s[4 * 65] * pg8::W8_SCALE, s[5 * 65] * pg8::W8_SCALE, s[6 * 65] * pg8::W8_SCALE, s[7 * 65] * pg8::W8_SCALE);
        *(uint2*)(WT + (size_t)map(n0 + n) * K + k0 + 8 * c) = o; }
    LDS_WAIT();
}
__device__ __forceinline__ void ph_prologue(const MegaArgs& P, LAS unsigned char* lds, int gw, int NGW, int wave, int lane) {
    unsigned char* ws = P.ws;
    if (KFLAGS & F_TR) {
        LAS float* scr = (LAS float*)(lds + wave * 16640);
        constexpr int I_IN = 32 * 137, I_A = 16 * 32, I_O = 32 * 32, I_P = 4 * 32;
        constexpr int NITEMS = I_IN + 2 * I_A + 2 * I_O + I_P;
        for (int it = gw; it < NITEMS; it += NGW) {
            int r = it;
            if (r < I_IN) { tr_item(P.in[4], 2048, INW, (r / 137) * 64, (r % 137) * 64, (bf16_t*)(ws + WS_WT_IN), MapIn(), scr, lane); continue; } r -= I_IN;
            if (r < I_A) { tr_item(P.in[12], 2048, 2048, (r / 32) * 64, (r % 32) * 64, (bf16_t*)(ws + WS_WT_A), MapId(), scr, lane, 0); continue; } r -= I_A;
            if (r < I_A) { tr_item(P.in[13], 2048, 2048, (r / 32) * 64, (r % 32) * 64, (bf16_t*)(ws + WS_WT_A), MapId(), scr, lane, 1024); continue; } r -= I_A;
            if (r < I_O) { tr_item(P.in[14], 2048, 2048, (r / 32) * 64, (r % 32) * 64, (bf16_t*)(ws + WS_WT_O), MapId(), scr, lane); continue; } r -= I_O;
            if (r < I_O) { tr_item(P.in[25], 2048, 2048, (r / 32) * 64, (r % 32) * 64, (bf16_t*)(ws + WS_WT_G), MapId(), scr, lane); continue; } r -= I_O;
            tr_item(P.in[26], 256, 2048, (r / 32) * 64, (r % 32) * 64, (bf16_t*)(ws + WS_WT_P), MapId(), scr, lane);
        }
    }
    if (KFLAGS & F_LN0) {
        float* H0F = (float*)(ws + WS_H0F); bf16_t* H0B = (bf16_t*)(ws + WS_H0B); bf16_t* PB = (bf16_t*)(ws + WS_PB);
        for (int row = gw; row < T; row += NGW) { float4 v[8]; load_row(v, P.in[0] + (size_t)row * D, lane); ln_row(v, P.in[2], P.in[3], lane);
            store_row_f32(v, H0F + (size_t)row * D, lane); store_row_bf16(v, H0B + (size_t)row * D, lane); }
        for (int i = gw * 64 + lane; i < T * PLE / 4; i += NGW * 64) { const float4 v = ((const float4*)P.in[1])[i]; uint2 w; w.x = pg8::cvt_pk_bf16(v.x, v.y); w.y = pg8::cvt_pk_bf16(v.z, v.w); ((uint2*)PB)[i] = w; }
    }
}

constexpr int XI_UP = 16 * 16, XI_DN = 16 * 8, XI_TOTAL = NE * (XI_UP + XI_DN);
__device__ __forceinline__ void xitem_src(const MegaArgs& P, int it, const float*& W, int& N, int& k0, int& n0, unsigned char*& WT, bool& up) {
    unsigned char* ws = P.ws;
    if (it < NE * XI_UP) { const int e = it / XI_UP, q = it % XI_UP; W = P.in[19] + (size_t)e * 2048 * 4096; N = 4096; k0 = (q / 16) * 128; n0 = (q % 16) * 256; WT = (unsigned char*)(ws + WS_WT_UP) + (size_t)e * 4096 * 2048; up = true; }
    else { const int r = it - NE * XI_UP, e = r / XI_DN, q = r % XI_DN; W = P.in[21] + (size_t)e * 2048 * 2048; N = 2048; k0 = (q / 8) * 128; n0 = (q % 8) * 256; WT = (unsigned char*)(ws + WS_WT_DN) + (size_t)e * 2048 * 2048; up = false; }
}
__device__ __forceinline__ void expert_convert(const MegaArgs& P, LAS unsigned char* lds, int c, int wave, int lane) {
    LAS float* scr = (LAS float*)lds;
    constexpr int NA = 96, CA = 44, CB = 51;
    const int start = c < NA ? c * CA : NA * CA + (c - NA) * CB; int end = start + (c < NA ? CA : CB); if (end > XI_TOTAL) end = XI_TOTAL;
    const int tid = threadIdx.x, ln = (tid & 63) * 4, lk = tid >> 6, rn = tid & 255, rk = (tid >> 8) * 64;
    f32x4 vA[16], vB[16];
#define XC_LOAD(V, it_) do { if ((it_) < end) { const float* W_; int N_, k0_, n0_; unsigned char* WT_; bool up_; xitem_src(P, (it_), W_, N_, k0_, n0_, WT_, up_); \
        _Pragma("unroll") for (int i = 0; i < 16; ++i) V[i] = *(const f32x4*)(W_ + (size_t)(k0_ + lk + 8 * i) * N_ + n0_ + ln); } } while (0)
#define XC_PROC(V, it_) do { if ((it_) < end) { const float* W_; int N_, k0_, n0_; unsigned char* WT_; bool up_; xitem_src(P, (it_), W_, N_, k0_, n0_, WT_, up_); \
        _Pragma("unroll") for (int i = 0; i < 16; ++i) *(LAS f32x4*)(scr + (lk + 8 * i) * 260 + ln) = V[i]; \
        __syncthreads(); \
        { const int nn = n0_ + rn, row = up_ ? MapUp()(nn) : nn; unsigned char* dst = WT_ + (size_t)row * 2048 + k0_ + rk; \
          _Pragma("unroll") for (int cc = 0; cc < 4; ++cc) { const LAS float* sp = scr + (rk + 16 * cc) * 260 + rn; pg8::u32x4 o; \
              o.x = pg8::pk_fp8x4(sp[0 * 260] * pg8::W8_SCALE, sp[1 * 260] * pg8::W8_SCALE, sp[2 * 260] * pg8::W8_SCALE, sp[3 * 260] * pg8::W8_SCALE); \
              o.y = pg8::pk_fp8x4(sp[4 * 260] * pg8::W8_SCALE, sp[5 * 260] * pg8::W8_SCALE, sp[6 * 260] * pg8::W8_SCALE, sp[7 * 260] * pg8::W8_SCALE); \
              o.z = pg8::pk_fp8x4(sp[8 * 260] * pg8::W8_SCALE, sp[9 * 260] * pg8::W8_SCALE, sp[10 * 260] * pg8::W8_SCALE, sp[11 * 260] * pg8::W8_SCALE); \
              o.w = pg8::pk_fp8x4(sp[12 * 260] * pg8::W8_SCALE, sp[13 * 260] * pg8::W8_SCALE, sp[14 * 260] * pg8::W8_SCALE, sp[15 * 260] * pg8::W8_SCALE); \
              *(pg8::u32x4*)(dst + 16 * cc) = o; } } \
        __syncthreads(); } } while (0)
    XC_LOAD(vA, start); XC_LOAD(vB, start + 1);
    for (int it = start; it < end; it += 2) {
        XC_PROC(vA, it); XC_LOAD(vA, it + 2);
        XC_PROC(vB, it + 1); XC_LOAD(vB, it + 3);
    }
#undef XC_LOAD
#undef XC_PROC
}

__device__ __forceinline__ void ph_prep(const MegaArgs& P, LAS unsigned char* lds, int c, int gw, int NGW, int lane) {
    unsigned char* ws = P.ws;
    const bf16_t *QAR = (const bf16_t*)(ws + WS_QAR), *KAR = (const bf16_t*)(ws + WS_KAR); bf16_t *QA = (bf16_t*)(ws + WS_QA), *KA = (bf16_t*)(ws + WS_KA);
    const float *qn = P.in[5], *kn = P.in[6];
    { const float invf = exp2f(-(float)(lane & 31) * (13.287712379549449f / 32.f));
      const float qg0 = qn[2 * lane], qg1 = qn[2 * lane + 1], kg0 = kn[2 * lane], kg1 = kn[2 * lane + 1];
      for (int it0 = gw * 4; it0 < T * 10; it0 += NGW * 4) {
        unsigned pr[4];
#pragma unroll
        for (int q = 0; q < 4; ++q) { const int it = it0 + q, t = it / 10, hd = it % 10;
            const bf16_t* src = hd < 8 ? QAR + (size_t)t * 1024 + hd * 128 : KAR + (size_t)t * 256 + (hd - 8) * 128; pr[q] = ((const unsigned*)src)[lane]; }
#pragma unroll
        for (int q = 0; q < 4; ++q) { const int it = it0 + q, t = it / 10, hd = it % 10;
            bf16_t* dst = hd < 8 ? QA + (size_t)t * 1024 + hd * 128 : KA + (size_t)t * 256 + (hd - 8) * 128;
            float x0 = pg8::bflo(pr[q]), x1 = pg8::bfhi(pr[q]);
            const float ss = wave_sum(x0 * x0 + x1 * x1), r = 1.f / sqrtf(ss * (1.f / 128.f) + RMS_EPS);
            x0 = x0 * r * (hd < 8 ? qg0 : kg0); x1 = x1 * r * (hd < 8 ? qg1 : kg1);
            const int sq = t & (SEQ - 1), pos = (lane < 32) ? (sq >> 6) : (sq & 63);
            float rev = (float)pos * invf * 0.15915494309189535f; rev -= floorf(rev);
            const float sn = __builtin_amdgcn_sinf(rev), cs = __builtin_amdgcn_cosf(rev);
            ((unsigned*)dst)[lane] = pg8::cvt_pk_bf16(x0 * cs - x1 * sn, x0 * sn + x1 * cs); } } }
    { const float* LR = (const float*)(ws + WS_LR); float* BCF = (float*)(ws + WS_BCF); float* BCB = (float*)(ws + WS_BCB);
      LAS float* lrs = (LAS float*)lds;
      const int tid = threadIdx.x;
      for (int u = c; u < NB * 32 * 4; u += gridDim.x) {
        const int h = u & 3, ck = u >> 2, t0 = ck * 128;
        __syncthreads();
        for (int i = tid; i < 128 * 32; i += NTHR) lrs[i] = LR[(size_t)t0 * 32 + i];
        __syncthreads();
        if (tid < 256) { const int dir = tid >> 7, d = tid & 127, ch = h * 128 + d;
            const float* W = dir ? P.in[9] : P.in[7]; const float bias = dir ? P.in[10][ch] : P.in[8][ch];
            float w[16];
#pragma unroll
            for (int r = 0; r < 16; ++r) w[r] = W[r * 512 + ch];
            float acc = 0.f; float* out = dir ? BCB : BCF;
#pragma unroll 4
            for (int ii = 0; ii < 128; ++ii) { const int i = dir ? 127 - ii : ii; float x = bias;
#pragma unroll
                for (int r4 = 0; r4 < 4; ++r4) { const f32x4 l4 = *(const LAS f32x4*)(lrs + i * 32 + dir * 16 + 4 * r4); x += l4[0] * w[4 * r4] + l4[1] * w[4 * r4 + 1] + l4[2] * w[4 * r4 + 2] + l4[3] * w[4 * r4 + 3]; }
                acc += logsig(x) * (1.f / 16.f); out[(size_t)(t0 + i) * 512 + ch] = acc; } }
      }
      __syncthreads(); }
}

__device__ __forceinline__ void gla_state_scan(const MegaArgs& P, LAS unsigned char* lds, int c) {
    unsigned char* ws = P.ws;
    const bf16_t *KBp = (const bf16_t*)(ws + WS_KB), *VBp = (const bf16_t*)(ws + WS_VB); bf16_t* SST = (bf16_t*)(ws + WS_SST);
    const int tid = threadIdx.x, w = __builtin_amdgcn_readfirstlane(tid >> 6), lane = tid & 63, fr = lane & 15, fq = lane >> 4;
    const int chain = c >> 4, sub = c & 15, b = chain >> 3, h = (chain >> 1) & 3, dir = chain & 1, d0 = (sub >> 2) * 32, e0 = (sub & 3) * 64, et = w >> 1, dt = w & 1;
    const float* BC = (const float*)(ws + (dir ? WS_BCB : WS_BCF));
    LAS bf16_t* Vt = (LAS bf16_t*)lds;
    LAS bf16_t* Kt = (LAS bf16_t*)(lds + 64 * 272);
    const int sj = tid & 127, sec = (tid >> 7) * 16, sdc = (tid >> 7) * 8;
    f32x4 acc = (f32x4){0.f, 0.f, 0.f, 0.f};
    bf16x8 v0, v1, kk; f32x4 b0, b1, bl0, bl1; float gdec;
#define GLA_LOAD(ck_) do { const int t0_ = b * SEQ + 128 * (ck_), tr_ = t0_ + sj, tl_ = t0_ + (dir ? 0 : 127); \
        v0 = *(const bf16x8*)(VBp + (size_t)tr_ * 1024 + h * 256 + e0 + sec); v1 = *(const bf16x8*)(VBp + (size_t)tr_ * 1024 + h * 256 + e0 + sec + 8); \
        kk = *(const bf16x8*)(KBp + (size_t)tr_ * 512 + h * 128 + d0 + sdc); \
        b0 = *(const f32x4*)(BC + (size_t)tr_ * 512 + h * 128 + d0 + sdc); b1 = *(const f32x4*)(BC + (size_t)tr_ * 512 + h * 128 + d0 + sdc + 4); \
        bl0 = *(const f32x4*)(BC + (size_t)tl_ * 512 + h * 128 + d0 + sdc); bl1 = *(const f32x4*)(BC + (size_t)tl_ * 512 + h * 128 + d0 + sdc + 4); \
        gdec = BC[(size_t)tl_ * 512 + h * 128 + d0 + 16 * dt + fr]; } while (0)
    GLA_LOAD(dir ? 31 : 0);
    for (int cc = 0; cc < 32; ++cc) { const int ck = dir ? 31 - cc : cc;
        { bf16_t* sp = SST + ((size_t)(chain * 32 + ck) * 256 + e0 + 16 * et + 4 * fq) * 128 + d0 + 16 * dt + fr;
#pragma unroll
          for (int r = 0; r < 4; ++r) sp[r * 128] = f2bf(acc[r]); }
#pragma unroll
        for (int i = 0; i < 8; ++i) { Vt[(sec + i) * 136 + sj] = (bf16_t)v0[i]; Vt[(sec + 8 + i) * 136 + sj] = (bf16_t)v1[i]; }
#pragma unroll
        for (int i = 0; i < 8; ++i) { const float bl = i < 4 ? bl0[i & 3] : bl1[i & 3], bb = i < 4 ? b0[i & 3] : b1[i & 3];
            Kt[(sdc + i) * 136 + sj] = f2bf(bf2f((bf16_t)kk[i]) * __expf(bl - bb)); }
        const float g = __expf(gdec);
        if (cc + 1 < 32) GLA_LOAD(dir ? 30 - cc : cc + 1);
        __syncthreads();
        acc = acc * g;
#pragma unroll
        for (int ks = 0; ks < 4; ++ks) { const bf16x8 a = *(const LAS bf16x8*)(Vt + (16 * et + fr) * 136 + 32 * ks + 8 * fq), bb = *(const LAS bf16x8*)(Kt + (16 * dt + fr) * 136 + 32 * ks + 8 * fq);
            acc = __builtin_amdgcn_mfma_f32_16x16x32_bf16(a, bb, acc, 0, 0, 0); }
        __syncthreads(); }
#undef GLA_LOAD
}

__device__ __forceinline__ bf16x8 swz_frag(const LAS unsigned char* base, int row, int ks, int fq) { return *(const LAS bf16x8*)(base + row * 256 + ((64 * ks + 16 * fq) ^ ((row & 7) << 4))); }
__device__ __forceinline__ void gla_output(const MegaArgs& P, LAS unsigned char* lds, int c) {
    unsigned char* ws = P.ws;
    const bf16_t *QBp = (const bf16_t*)(ws + WS_QB), *KBp = (const bf16_t*)(ws + WS_KB), *VBp = (const bf16_t*)(ws + WS_VB), *OGp = (const bf16_t*)(ws + WS_OG), *SST = (const bf16_t*)(ws + WS_SST);
    bf16_t* A2 = (bf16_t*)(ws + WS_A2); const float* gnorm = P.in[11];
    const int tid = threadIdx.x, w = __builtin_amdgcn_readfirstlane(tid >> 6), lane = tid & 63, fr = lane & 15, fq = lane >> 4;
    const int b = c >> 7, h = (c >> 5) & 3, ck = c & 31, t0 = b * SEQ + 128 * ck;
    LAS unsigned char* X0 = lds; LAS unsigned char* X1 = lds + 32768; LAS unsigned char* VT = lds + 65536;
#pragma unroll 2
    for (int u = 0; u < 8; ++u) { const int id = tid + NTHR * u, j = id & 127, ec = (id >> 7) * 8;
        const bf16x8 vv = *(const bf16x8*)(VBp + (size_t)(t0 + j) * 1024 + h * 256 + ec);
#pragma unroll
        for (int i = 0; i < 8; ++i) { const int e = ec + i; *(LAS bf16_t*)(VT + e * 256 + ((j * 2) ^ ((e & 7) << 4))) = (bf16_t)vv[i]; } }
#define GLA_STAGE_QK(BCp) do { _Pragma("unroll") for (int u = 0; u < 4; ++u) { const int id = tid + NTHR * u, row = id >> 4, dc = (id & 15) * 8; \
        const bf16x8 q8 = *(const bf16x8*)(QBp + (size_t)(t0 + row) * 512 + h * 128 + dc), k8 = *(const bf16x8*)(KBp + (size_t)(t0 + row) * 512 + h * 128 + dc); \
        const f32x4 ba = *(const f32x4*)((BCp) + (size_t)(t0 + row) * 512 + h * 128 + dc), bb = *(const f32x4*)((BCp) + (size_t)(t0 + row) * 512 + h * 128 + dc + 4); \
        float qt[8], kt[8]; \
        _Pragma("unroll") for (int i = 0; i < 8; ++i) { const float bv = i < 4 ? ba[i & 3] : bb[i & 3]; qt[i] = bf2f((bf16_t)q8[i]) * __expf(bv) * 0.08838834764831845f; kt[i] = bf2f((bf16_t)k8[i]) * __expf(-bv); } \
        pg8::u32x4 wq, wk; wq.x = pg8::cvt_pk_bf16(qt[0], qt[1]); wq.y = pg8::cvt_pk_bf16(qt[2], qt[3]); wq.z = pg8::cvt_pk_bf16(qt[4], qt[5]); wq.w = pg8::cvt_pk_bf16(qt[6], qt[7]); \
        wk.x = pg8::cvt_pk_bf16(kt[0], kt[1]); wk.y = pg8::cvt_pk_bf16(kt[2], kt[3]); wk.z = pg8::cvt_pk_bf16(kt[4], kt[5]); wk.w = pg8::cvt_pk_bf16(kt[6], kt[7]); \
        const int off_ = row * 256 + ((dc * 2) ^ ((row & 7) << 4)); *(LAS pg8::u32x4*)(X0 + off_) = wq; *(LAS pg8::u32x4*)(X1 + off_) = wk; } } while (0)
    const float* BCF = (const float*)(ws + WS_BCF); const float* BCB = (const float*)(ws + WS_BCB);
    GLA_STAGE_QK(BCF);
    __syncthreads();
    f32x4 accP[8], accO[16];
#pragma unroll
    for (int i = 0; i < 8; ++i) accP[i] = (f32x4){0.f, 0.f, 0.f, 0.f};
#pragma unroll
    for (int i = 0; i < 16; ++i) accO[i] = (f32x4){0.f, 0.f, 0.f, 0.f};
    bf16x8 af[4];
#pragma unroll
    for (int ks = 0; ks < 4; ++ks) af[ks] = swz_frag(X0, 16 * w + fr, ks, fq);
#pragma unroll
    for (int jt = 0; jt < 8; ++jt) { if (jt <= w) {
#pragma unroll
        for (int ks = 0; ks < 4; ++ks) accP[jt] = __builtin_amdgcn_mfma_f32_16x16x32_bf16(af[ks], swz_frag(X1, 16 * jt + fr, ks, fq), accP[jt], 0, 0, 0);
        if (jt == w) {
#pragma unroll
            for (int r = 0; r < 4; ++r) if (fr > 4 * fq + r) accP[jt][r] = 0.f; } } }
    { const bf16_t* Sf = SST + (size_t)(((b * 4 + h) * 2 + 0) * 32 + ck) * 256 * 128;
#pragma unroll
      for (int et = 0; et < 16; ++et)
#pragma unroll
          for (int ks = 0; ks < 4; ++ks) { const bf16x8 bb = *(const bf16x8*)(Sf + (size_t)(16 * et + fr) * 128 + 32 * ks + 8 * fq);
              accO[et] = __builtin_amdgcn_mfma_f32_16x16x32_bf16(af[ks], bb, accO[et], 0, 0, 0); } }
    __syncthreads();
    GLA_STAGE_QK(BCB);
    __syncthreads();
#pragma unroll
    for (int ks = 0; ks < 4; ++ks) af[ks] = swz_frag(X0, 16 * w + fr, ks, fq);
#pragma unroll
    for (int jt = 0; jt < 8; ++jt) { if (jt >= w) { f32x4 tt = (f32x4){0.f, 0.f, 0.f, 0.f};
#pragma unroll
        for (int ks = 0; ks < 4; ++ks) tt = __builtin_amdgcn_mfma_f32_16x16x32_bf16(af[ks], swz_frag(X1, 16 * jt + fr, ks, fq), tt, 0, 0, 0);
        if (jt == w) {
#pragma unroll
            for (int r = 0; r < 4; ++r) if (fr < 4 * fq + r) tt[r] = 0.f; }
        accP[jt] = accP[jt] + tt; } }
    { const bf16_t* Sb = SST + (size_t)(((b * 4 + h) * 2 + 1) * 32 + ck) * 256 * 128;
#pragma unroll
      for (int et = 0; et < 16; ++et)
#pragma unroll
          for (int ks = 0; ks < 4; ++ks) { const bf16x8 bb = *(const bf16x8*)(Sb + (size_t)(16 * et + fr) * 128 + 32 * ks + 8 * fq);
              accO[et] = __builtin_amdgcn_mfma_f32_16x16x32_bf16(af[ks], bb, accO[et], 0, 0, 0); } }
    LDS_WAIT();
#pragma unroll
    for (int jt = 0; jt < 8; ++jt)
#pragma unroll
        for (int r = 0; r < 4; ++r) { const int row = 16 * w + 4 * fq + r, j = 16 * jt + fr; *(LAS bf16_t*)(X0 + row * 256 + ((j * 2) ^ ((row & 7) << 4))) = f2bf(accP[jt][r]); }
    LDS_WAIT();
#pragma unroll
    for (int ks = 0; ks < 4; ++ks) af[ks] = swz_frag(X0, 16 * w + fr, ks, fq);
#pragma unroll
    for (int et = 0; et < 16; ++et)
#pragma unroll
        for (int ks = 0; ks < 4; ++ks) accO[et] = __builtin_amdgcn_mfma_f32_16x16x32_bf16(af[ks], swz_frag(VT, 16 * et + fr, ks, fq), accO[et], 0, 0, 0);
    float rr[4];
#pragma unroll
    for (int r = 0; r < 4; ++r) { float ss = 0.f;
#pragma unroll
        for (int et = 0; et < 16; ++et) ss += accO[et][r] * accO[et][r];
        ss += __shfl_xor(ss, 1); ss += __shfl_xor(ss, 2); ss += __shfl_xor(ss, 4); ss += __shfl_xor(ss, 8);
        rr[r] = 1.f / sqrtf(ss * (1.f / 256.f) + RMS_EPS); }
#pragma unroll
    for (int et = 0; et < 16; ++et) { const int e = 16 * et + fr; const float gn = gnorm[e];
#pragma unroll
        for (int r = 0; r < 4; ++r) { const size_t t = (size_t)(t0 + 16 * w + 4 * fq + r); const float g = bf2f(OGp[t * 1024 + h * 256 + e]);
            A2[t * 2048 + 1024 + h * 256 + e] = f2bf(accO[et][r] * rr[r] * gn * (g * sigm(g))); } }
#undef GLA_STAGE_QK
    __syncthreads();
}

__device__ __forceinline__ void ph_ln1_router(const MegaArgs& P, LAS unsigned char* lds, int c) {
    unsigned char* ws = P.ws; unsigned* ctl = (unsigned*)(ws + WS_CTL);
    const float* PRE1 = (const float*)(ws + WS_PRE1); float* H1F = (float*)(ws + WS_H1F); unsigned char* XROWS = (unsigned char*)(ws + WS_XROWS); int* DEST = (int*)(ws + WS_DEST); float* GATE = (float*)(ws + WS_GATE);
    const float *g1 = P.in[15], *b1 = P.in[16], *wr = P.in[17], *br = P.in[18];
    const int tid = threadIdx.x, w = __builtin_amdgcn_readfirstlane(tid >> 6), lane = tid & 63, e = lane & 31, half = lane >> 5;
    LAS float* hrow = (LAS float*)lds;
    LAS float* part = (LAS float*)(lds + 65536);
    LAS int* etab = (LAS int*)(lds + 81920);
    LAS float* gtab = (LAS float*)(lds + 81920 + 512);
    LAS int* slot = (LAS int*)(lds + 81920 + 1024);
    LAS int* lbase = (LAS int*)(lds + 81920 + 1536);
    LAS float* gbl = (LAS float*)(lds + 98304);
    for (int i = tid; i < 512; i += NTHR) { *(LAS f32x4*)(gbl + 4 * i) = *(const f32x4*)(g1 + 4 * i); *(LAS f32x4*)(gbl + 2048 + 4 * i) = *(const f32x4*)(b1 + 4 * i); }
    float wreg[128];
#pragma unroll
    for (int i = 0; i < 128; ++i) wreg[i] = wr[(size_t)(256 * w + 128 * half + i) * NE + e];
    __syncthreads();
    for (int rb = c * 32; rb < T; rb += gridDim.x * 32) {
        for (int gI = 0; gI < 4; ++gI) {
            const int row = rb + 8 * gI + w;
            { float4 v[8]; load_row(v, PRE1 + (size_t)row * D, lane);
              { float s1 = 0.f;
#pragma unroll
                for (int j = 0; j < 8; ++j) s1 += (v[j].x + v[j].y) + (v[j].z + v[j].w);
                const float mean = wave_sum(s1) * (1.f / D); float s2 = 0.f;
#pragma unroll
                for (int j = 0; j < 8; ++j) { v[j].x -= mean; v[j].y -= mean; v[j].z -= mean; v[j].w -= mean; s2 += (v[j].x * v[j].x + v[j].y * v[j].y) + (v[j].z * v[j].z + v[j].w * v[j].w); }
                const float rstd = 1.f / sqrtf(wave_sum(s2) * (1.f / D) + LN_EPS);
#pragma unroll
                for (int j = 0; j < 8; ++j) { const f32x4 gg = *(const LAS f32x4*)(gbl + (lane + 64 * j) * 4), bb = *(const LAS f32x4*)(gbl + 2048 + (lane + 64 * j) * 4);
                    v[j].x = v[j].x * rstd * gg[0] + bb[0]; v[j].y = v[j].y * rstd * gg[1] + bb[1]; v[j].z = v[j].z * rstd * gg[2] + bb[2]; v[j].w = v[j].w * rstd * gg[3] + bb[3];
                    if (j & 1) asm volatile("" ::: "memory"); } }
              store_row_f32(v, H1F + (size_t)row * D, lane);
#pragma unroll
              for (int j = 0; j < 8; ++j) *(LAS f32x4*)(hrow + w * 2048 + (lane + 64 * j) * 4) = (f32x4){v[j].x, v[j].y, v[j].z, v[j].w}; }
            __syncthreads();
            float acc[8];
#pragma unroll
            for (int r = 0; r < 8; ++r) acc[r] = 0.f;
#pragma unroll
            for (int i = 0; i < 128; i += 4) {
#pragma unroll
                for (int r = 0; r < 8; ++r) { const f32x4 h4 = *(const LAS f32x4*)(hrow + r * 2048 + 256 * w + 128 * half + i);
                    acc[r] += h4[0] * wreg[i] + h4[1] * wreg[i + 1] + h4[2] * wreg[i + 2] + h4[3] * wreg[i + 3]; }
                if (i & 4) asm volatile("" ::: "memory"); }
#pragma unroll
            for (int r = 0; r < 8; ++r) part[(w * 8 + r) * 64 + lane] = acc[r];
            __syncthreads();
            float lg = -1e30f;
            if (lane < 32) { float s = br[lane];
#pragma unroll
                for (int ww = 0; ww < 8; ++ww) s += part[(ww * 8 + w) * 64 + lane] + part[(ww * 8 + w) * 64 + lane + 32];
                lg = s; }
            float cur = lg, tv0, tv1, tv2, tv3; int ti0, ti1, ti2, ti3;
#define TOP1(TV, TI) do { float bv = cur; int bi = lane; \
                _Pragma("unroll") for (int o = 1; o < 64; o <<= 1) { const float ov = __shfl_xor(bv, o); const int oi = __shfl_xor(bi, o); if (ov > bv || (ov == bv && oi < bi)) { bv = ov; bi = oi; } } \
                TV = bv; TI = bi; if (lane == bi) cur = -1e30f; } while (0)
            TOP1(tv0, ti0); TOP1(tv1, ti1); TOP1(tv2, ti2); TOP1(tv3, ti3);
#undef TOP1
            const float ge0 = 1.f, ge1 = __expf(tv1 - tv0), ge2 = __expf(tv2 - tv0), ge3 = __expf(tv3 - tv0), gs = (ge0 + ge1) + (ge2 + ge3);
            if (lane < 4) { int ee = ti0; float gg = ge0;
                if (lane == 1) { ee = ti1; gg = ge1; } if (lane == 2) { ee = ti2; gg = ge2; } if (lane == 3) { ee = ti3; gg = ge3; }
                etab[(8 * gI + w) * 4 + lane] = ee; gtab[(8 * gI + w) * 4 + lane] = gg / gs; }
        }
        VM_WAIT();
        __syncthreads();
        if (w == 0) { int cnt = 0;
            for (int a = 0; a < 128; ++a) { const int ea = etab[a]; if (ea == lane) { slot[a] = cnt; ++cnt; } }
            if (lane < 32) { unsigned base = 0; if (cnt) base = __hip_atomic_fetch_add(ctl + CW_CNT + 64 * lane, (unsigned)cnt, __ATOMIC_RELAXED, __HIP_MEMORY_SCOPE_AGENT); lbase[lane] = (int)base; } }
        __syncthreads();
        for (int rr = 0; rr < 4; ++rr) { const int rl = 4 * w + rr, row = rb + rl;
            float4 v[8]; load_row(v, H1F + (size_t)row * D, lane);
#pragma unroll
            for (int k = 0; k < 4; ++k) { const int ee = etab[rl * 4 + k]; const int dst = ee * CAP + lbase[ee] + slot[rl * 4 + k];
                store_row_fp8(v, XROWS + (size_t)dst * D, lane);
                if (lane == k) { DEST[row * 4 + k] = dst; GATE[row * 4 + k] = gtab[rl * 4 + k]; } } }
        __syncthreads();
    }
}
__device__ __forceinline__ void build_moe_table(const MegaArgs& P, LAS unsigned char* lds) {
    unsigned* ctl = (unsigned*)(P.ws + WS_CTL); LAS int* tp = (LAS int*)(lds + LDS_TAB);
    __syncthreads();
    if (threadIdx.x == 0) { int run = 0; tp[0] = 0;
        for (int e = 0; e < NE; ++e) { const unsigned cnt = __hip_atomic_load(ctl + CW_CNT + 64 * e, __ATOMIC_RELAXED, __HIP_MEMORY_SCOPE_AGENT); run += (int)((cnt + 255u) >> 8); tp[e + 1] = run; } }
    __syncthreads();
}
__device__ __forceinline__ void ph_combine_ln2(const MegaArgs& P, int gw, int NGW, int lane) {
    unsigned char* ws = P.ws; const float* H1F = (const float*)(ws + WS_H1F); const bf16_t* Y = (const bf16_t*)(ws + WS_XROWS); const int* DEST = (const int*)(ws + WS_DEST); const float* GATE = (const float*)(ws + WS_GATE);
    float* H2F = (float*)(ws + WS_H2F); bf16_t* H2B = (bf16_t*)(ws + WS_H2B);
    for (int row = gw; row < T; row += NGW) {
        float4 v[8]; load_row(v, H1F + (size_t)row * D, lane);
#pragma unroll
        for (int j = 0; j < 8; ++j) { v[j].x *= DN_ALPHA; v[j].y *= DN_ALPHA; v[j].z *= DN_ALPHA; v[j].w *= DN_ALPHA; }
#pragma unroll
        for (int k = 0; k < 4; ++k) { const bf16_t* yr = Y + (size_t)DEST[row * 4 + k] * D; const float gk = GATE[row * 4 + k];
#pragma unroll
            for (int j = 0; j < 8; ++j) { const uint2 q = ((const uint2*)yr)[lane + 64 * j];
                v[j].x += gk * pg8::bflo(q.x); v[j].y += gk * pg8::bfhi(q.x); v[j].z += gk * pg8::bflo(q.y); v[j].w += gk * pg8::bfhi(q.y); } }
        ln_row(v, P.in[23], P.in[24], lane); store_row_f32(v, H2F + (size_t)row * D, lane); store_row_bf16(v, H2B + (size_t)row * D, lane); }
}

__global__ void __launch_bounds__(NTHR, 2) mega(MegaArgs P) {
    extern __shared__ __attribute__((aligned(16))) unsigned char lds_raw[];
    LAS unsigned char* lds = (LAS unsigned char*)lds_raw;
    const int tid = threadIdx.x, lane = tid & 63, wave = __builtin_amdgcn_readfirstlane(tid >> 6), c = blockIdx.x, G = gridDim.x;
    const int gw = c * NWAVES + wave, NGW = G * NWAVES;
    unsigned char* ws = P.ws; unsigned* ctl = (unsigned*)(ws + WS_CTL);
    if (tid == 0) *(LAS pg8::u32x4*)(lds + LDS_BARW) = (pg8::u32x4){0u, 0u, 0u, 0u};
    __syncthreads();
    XcdBarrier bar = xcd_barrier_post(ctl + CW_BAR + P.li * XCD_BAR_WORDS, (volatile LAS unsigned*)(lds + LDS_BARW));
    const int lo = P.ph_lo, hi = P.ph_hi;
#define IN(k) (lo <= (k) && (k) < hi)
#define SEAM(k) do { if (IN(k) && IN((k) + 1)) xcd_barrier(bar); } while (0)
    bf16_t *H0B = (bf16_t*)(ws + WS_H0B), *A2 = (bf16_t*)(ws + WS_A2), *MB = (bf16_t*)(ws + WS_MB), *SG = (bf16_t*)(ws + WS_SG), *H2B = (bf16_t*)(ws + WS_H2B), *PB = (bf16_t*)(ws + WS_PB);
    float *M1 = (float*)(ws + WS_M1), *PRE1 = (float*)(ws + WS_PRE1), *H0F = (float*)(ws + WS_H0F), *H2F = (float*)(ws + WS_H2F), *PP = (float*)(ws + WS_PP), *PRE3 = (float*)(ws + WS_PRE3);

    if (IN(0)) { ph_prologue(P, lds, gw, NGW, wave, lane); } SEAM(0);
    if (IN(1)) { if (KFLAGS & F_INPROJ) {
        pg8::Gemm g{H0B, (const bf16_t*)(ws + WS_WT_IN), T, NIN, D}; pg8::StaticOrder S; S.init(T, NIN, G, c);
        pg8::EpiInprojF E{(bf16_t*)(ws + WS_QAR), (bf16_t*)(ws + WS_KAR), (bf16_t*)(ws + WS_VA), (bf16_t*)(ws + WS_QB), (bf16_t*)(ws + WS_KB), (bf16_t*)(ws + WS_VB), (bf16_t*)(ws + WS_OG), SG, (float*)(ws + WS_LR)};
        const int sl = ((c >> 3) & 1) ? 0 : 64;
        { pg8::RangeOrder R{S, 0, sl}; pg8::gemm_phase<pg8::EpiInprojF, pg8::RangeOrder>(lds, g, R, E, nullptr); }
        __syncthreads(); if (KFLAGS & F_TR) expert_convert(P, lds, c, wave, lane); __syncthreads();
        { pg8::RangeOrder R{S, sl, 1 << 20}; pg8::gemm_phase<pg8::EpiInprojF, pg8::RangeOrder>(lds, g, R, E, nullptr); } } } SEAM(1);
    if (IN(2)) { if (KFLAGS & F_PREP) ph_prep(P, lds, c, gw, NGW, lane); } SEAM(2);
    if (IN(3)) {
        if (KFLAGS & F_ATTN) { for (int u = c; u < 256; u += G) {
            const int xcd = u & 7, off = u >> 3, grp = xcd >> 1, b = grp >> 1, kvh = grp & 1, idx = (xcd & 1) * 32 + off, gq = idx >> 4, qb = idx & 15, hq = kvh * 4 + gq;
            const bf16_t* QA = (const bf16_t*)(ws + WS_QA); const bf16_t* KA = (const bf16_t*)(ws + WS_KA); const bf16_t* VA = (const bf16_t*)(ws + WS_VA);
            attn::attn_dense_body(QA + ((size_t)(b * SEQ + qb * 256) * 1024 + hq * 128), KA + ((size_t)b * SEQ * 256 + kvh * 128), VA + ((size_t)b * SEQ * 256 + kvh * 128),
                                  A2 + ((size_t)(b * SEQ + qb * 256) * 2048 + hq * 128), SEQ, (char*)lds_raw);
            __syncthreads(); } }
        if (KFLAGS & F_GLA) { for (int u = c; u < 256; u += G) gla_state_scan(P, lds, u); }
    } SEAM(3);
    if (IN(4)) {
        if (KFLAGS & F_GLA) { for (int u = c; u < 256; u += G) gla_output(P, lds, u); }
    }
    SEAM(4);
    if (IN(5)) {
        if (KFLAGS & F_YA) { pg8::Gemm g{A2, (const bf16_t*)(ws + WS_WT_A), T, D, D}; pg8::StaticOrder S; S.init(T, D, G, c); pg8::EpiMergeF E{SG, MB};
            pg8::gemm_phase<pg8::EpiMergeF, pg8::StaticOrder>(lds, g, S, E, nullptr); } } SEAM(5);
    if (IN(6)) { if (KFLAGS & F_WO) { pg8::Gemm g{MB, (const bf16_t*)(ws + WS_WT_O), T, D, D}; pg8::StaticOrder S; S.init(T, D, G, c); pg8::EpiF32F<1> E{H0F, nullptr, PRE1};
        pg8::gemm_phase<pg8::EpiF32F<1>, pg8::StaticOrder>(lds, g, S, E, nullptr); } } SEAM(6);
    if (IN(7)) { if (KFLAGS & F_LN1) ph_ln1_router(P, lds, c); } SEAM(7);
    if (IN(8)) { if (KFLAGS & F_UP) { build_moe_table(P, lds);
        pg8::Gemm g{(const bf16_t*)(ws + WS_XROWS), (const bf16_t*)(ws + WS_WT_UP), NE * CAP, 4096, D / 2}; pg8::MoeOrder S{(const PG8_LAS int*)(lds + LDS_TAB), 16, G, c, (size_t)4096 * 2048};
        pg8::EpiUpF8 E{P.in[20], (unsigned char*)(ws + WS_ACT)};
        pg8::gemm_phase<pg8::EpiUpF8, pg8::MoeOrder, false, true>(lds, g, S, E, nullptr); } } SEAM(8);
    if (IN(9)) { if (KFLAGS & F_DOWN) { build_moe_table(P, lds);
        pg8::Gemm g{(const bf16_t*)(ws + WS_ACT), (const bf16_t*)(ws + WS_WT_DN), NE * CAP, D, D / 2}; pg8::MoeOrder S{(const PG8_LAS int*)(lds + LDS_TAB), 8, G, c, (size_t)2048 * 2048};
        pg8::EpiDownF8 E{P.in[22], (bf16_t*)(ws + WS_XROWS)};
        pg8::gemm_phase<pg8::EpiDownF8, pg8::MoeOrder, false, true>(lds, g, S, E, nullptr); } } SEAM(9);
    if (IN(10)) { if (KFLAGS & F_LN2) ph_combine_ln2(P, gw, NGW, lane); } SEAM(10);
    if (IN(11)) { if (KFLAGS & F_PLE) {
        { pg8::Gemm g{PB, (const bf16_t*)(ws + WS_WT_P), T, D, PLE}; pg8::StaticOrder S; S.init(T, D, G, c); pg8::EpiF32F<0> E{nullptr, nullptr, PP};
          pg8::gemm_phase<pg8::EpiF32F<0>, pg8::StaticOrder>(lds, g, S, E, nullptr); }
        { pg8::Gemm g{H2B, (const bf16_t*)(ws + WS_WT_G), T, D, D}; pg8::StaticOrder S; S.init(T, D, G, c); pg8::EpiF32F<2> E{H2F, PP, PRE3};
          pg8::gemm_phase<pg8::EpiF32F<2>, pg8::StaticOrder>(lds, g, S, E, nullptr); } } } SEAM(11);
    if (IN(12)) { if (KFLAGS & F_LN3) { for (int row = gw; row < T; row += NGW) { float4 v[8]; load_row(v, PRE3 + (size_t)row * D, lane); ln_row(v, P.in[27], P.in[28], lane); store_row_f32(v, P.out + (size_t)row * D, lane); } } }
#undef IN
#undef SEAM
}

extern "C" void kernel_launch(void* const* d_in, const int* in_sizes, int n_in, void* d_out, int out_size, void* d_ws, size_t ws_size, hipStream_t stream) {
    static int grid = 0;
    if (grid == 0) {
        if (n_in != 29 || ws_size < WS_END2) { fprintf(stderr, "kernel_launch: unexpected n_in %d or ws %zu < %zu\n", n_in, ws_size, (size_t)WS_END2); grid = -1; return; }
        int dev = 0, cus = 0, per_cu = 0;
        if (hipGetDevice(&dev) != hipSuccess || hipDeviceGetAttribute(&cus, hipDeviceAttributeMultiprocessorCount, dev) != hipSuccess) { grid = -1; return; }
        if (hipFuncSetAttribute((const void*)mega, hipFuncAttributeMaxDynamicSharedMemorySize, LDS_BYTES) != hipSuccess) { fprintf(stderr, "kernel_launch: hipFuncSetAttribute failed\n"); grid = -1; return; }
        if (hipOccupancyMaxActiveBlocksPerMultiprocessor(&per_cu, (const void*)mega, NTHR, LDS_BYTES) != hipSuccess || per_cu < 1) fprintf(stderr, "kernel_launch: occupancy query says %d\n", per_cu);
        (void)hipGetLastError();
        grid = cus;
    }
    if (grid < 0) return;
    const float* x = (const float*)d_in[0]; const float* p = (const float*)d_in[1];
    const float *in_g = (const float*)d_in[2], *in_b = (const float*)d_in[3], *w_in = (const float*)d_in[4], *qn = (const float*)d_in[5], *kn = (const float*)d_in[6];
    const float *wlf = (const float*)d_in[7], *blf = (const float*)d_in[8], *wlb = (const float*)d_in[9], *blb = (const float*)d_in[10], *gn = (const float*)d_in[11];
    const float *wba = (const float*)d_in[12], *wbb = (const float*)d_in[13], *wo = (const float*)d_in[14], *l1g = (const float*)d_in[15], *l1b = (const float*)d_in[16];
    const float *wr = (const float*)d_in[17], *br = (const float*)d_in[18], *wup = (const float*)d_in[19], *bup = (const float*)d_in[20], *wdn = (const float*)d_in[21], *bdn = (const float*)d_in[22];
    const float *l2g = (const float*)d_in[23], *l2b = (const float*)d_in[24], *wpg = (const float*)d_in[25], *wpp = (const float*)d_in[26], *l3g = (const float*)d_in[27], *l3b = (const float*)d_in[28];
    char* ws = (char*)d_ws; float* out = (float*)d_out;
    unsigned* ctl = (unsigned*)(ws + WS_CTL);
    float* H0F = (float*)(ws + WS_H0F); bf16_t* H0B = (bf16_t*)(ws + WS_H0B);
    bf16_t *QAR = (bf16_t*)(ws + WS_QAR), *KAR = (bf16_t*)(ws + WS_KAR), *VA = (bf16_t*)(ws + WS_VA), *QB = (bf16_t*)(ws + WS_QB), *KB = (bf16_t*)(ws + WS_KB), *VB = (bf16_t*)(ws + WS_VB);
    bf16_t *OG = (bf16_t*)(ws + WS_OG), *SG = (bf16_t*)(ws + WS_SG), *QA = (bf16_t*)(ws + WS_QA), *KA = (bf16_t*)(ws + WS_KA), *A2 = (bf16_t*)(ws + WS_A2), *MB = (bf16_t*)(ws + WS_MB);
    float *LR = (float*)(ws + WS_LR), *BCF = (float*)(ws + WS_BCF), *BCB = (float*)(ws + WS_BCB), *OF = (float*)(ws + WS_OF), *OB = (float*)(ws + WS_OB), *M1 = (float*)(ws + WS_M1);
    float *PRE1 = (float*)(ws + WS_PRE1), *H1F = (float*)(ws + WS_H1F), *GATE = (float*)(ws + WS_GATE), *H2F = (float*)(ws + WS_H2F), *PP = (float*)(ws + WS_PP), *PRE3 = (float*)(ws + WS_PRE3);
    int* DEST = (int*)(ws + WS_DEST); bf16_t *H2B = (bf16_t*)(ws + WS_H2B), *PB = (bf16_t*)(ws + WS_PB), *XROWS = (bf16_t*)(ws + WS_XROWS), *YROWS = (bf16_t*)(ws + WS_XROWS), *ACT = (bf16_t*)(ws + WS_ACT);
    float* SC = (float*)(ws + WS_ACT);
    (void)hipMemsetAsync(ws + WS_CTL, 0, 1 * MiB, stream);

    constexpr int FAST = FAST_MASK;
    static const int stage_flags[13] = {F_TR | F_LN0, F_INPROJ, F_PREP, F_ATTN | F_GLA, F_GLA, F_YA | F_YB, F_WO, F_LN1, F_UP, F_DOWN, F_LN2, F_PLE, F_LN3};
    int pend_lo = -1, li = 0;
    MegaArgs a{};
    for (int i = 0; i < 29; ++i) a.in[i] = (const float*)d_in[i];
    a.out = out; a.ws = (unsigned char*)d_ws; a.flags = FAST;
#define FLUSH(hi_) do { if (pend_lo >= 0) { a.ph_lo = pend_lo; a.ph_hi = (hi_); a.li = li++; hipLaunchKernelGGL(mega, dim3(grid), dim3(NTHR), LDS_BYTES, stream, a); pend_lo = -1; } } while (0)
    for (int s = 0; s < 13; ++s) {
        switch (s) {
        case 0: if (!(FAST & F_LN0)) { FLUSH(s); hipLaunchKernelGGL(k_ln0, dim3(T / 4), dim3(256), 0, stream, x, in_g, in_b, H0F, H0B);
                    hipLaunchKernelGGL(k_cvt, dim3(2048), dim3(256), 0, stream, p, PB, (size_t)T * PLE); } break;
        case 1: if (!(FAST & F_INPROJ)) { FLUSH(s); EpiInproj e{QAR, KAR, VA, QB, KB, VB, OG, SG, LR};
                    hipLaunchKernelGGL((naive_gemm<bf16_t, float, false, false, EpiInproj>), dim3((INW + 63) / 64, T / 64, 1), dim3(256), 0, stream, H0B, (size_t)D, (size_t)0, w_in, (size_t)INW, (size_t)0, (const float*)nullptr, T, (const unsigned*)nullptr, INW, D, e); } break;
        case 2: if (!(FAST & F_PREP)) { FLUSH(s); hipLaunchKernelGGL(k_qkprep, dim3(T * 10 / 4), dim3(256), 0, stream, QAR, KAR, qn, kn, QA, KA);
                    hipLaunchKernelGGL(k_glacum, dim3(NB * 32 * 4), dim3(256), 0, stream, LR, wlf, blf, wlb, blb, BCF, BCB); } break;
        case 3: if (!(FAST & F_ATTN)) { FLUSH(s);
                    for (int b = 0; b < NB; ++b) for (int kvh = 0; kvh < 2; ++kvh) { EpiScores es{SC + (size_t)(b * 8 + kvh * 4) * SEQ * SEQ};
                        hipLaunchKernelGGL((naive_gemm<bf16_t, bf16_t, true, false, EpiScores>), dim3(SEQ / 64, SEQ / 64, 4), dim3(256), 0, stream, QA + (size_t)b * SEQ * 1024 + kvh * 4 * 128, (size_t)1024, (size_t)128,
                                           KA + (size_t)b * SEQ * 256 + kvh * 128, (size_t)256, (size_t)0, (const bf16_t*)nullptr, SEQ, (const unsigned*)nullptr, SEQ, 128, es); }
                    hipLaunchKernelGGL(k_softmax_rows, dim3(16 * SEQ / 4), dim3(256), 0, stream, SC);
                    for (int b = 0; b < NB; ++b) for (int kvh = 0; kvh < 2; ++kvh) { EpiAttnOut eo{A2, b, kvh};
                        hipLaunchKernelGGL((naive_gemm<float, bf16_t, false, false, EpiAttnOut>), dim3(128 / 64, SEQ / 64, 4), dim3(256), 0, stream, SC + (size_t)(b * 8 + kvh * 4) * SEQ * SEQ, (size_t)SEQ, (size_t)SEQ * SEQ,
                                           VA + (size_t)b * SEQ * 256 + kvh * 128, (size_t)256, (size_t)0, (const bf16_t*)nullptr, SEQ, (const unsigned*)nullptr, 128, SEQ, eo); } }
                if (!(FAST & F_GLA)) { FLUSH(s); hipLaunchKernelGGL(k_gla_naive, dim3(16), dim3(256), 0, stream, QB, KB, VB, LR, wlf, blf, wlb, blb, OF, OB); } break;
        case 4: if (!(FAST & F_GLA)) { FLUSH(s); hipLaunchKernelGGL(k_gla_combine, dim3(T * 4 / 4), dim3(256), 0, stream, OF, OB, OG, gn, A2); }
                if (!(FAST & F_YA)) { FLUSH(s); EpiYa e{SG, M1}; hipLaunchKernelGGL((naive_gemm<bf16_t, float, false, false, EpiYa>), dim3(D / 64, T / 64, 1), dim3(256), 0, stream, A2, (size_t)2048, (size_t)0, wba, (size_t)D, (size_t)0, (const float*)nullptr, T, (const unsigned*)nullptr, D, 1024, e); } break;
        case 5: if (!(FAST & F_YB)) { FLUSH(s); EpiYb e{SG, M1, MB}; hipLaunchKernelGGL((naive_gemm<bf16_t, float, false, false, EpiYb>), dim3(D / 64, T / 64, 1), dim3(256), 0, stream, A2 + 1024, (size_t)2048, (size_t)0, wbb, (size_t)D, (size_t)0, (const float*)nullptr, T, (const unsigned*)nullptr, D, 1024, e); } break;
        case 6: if (!(FAST & F_WO)) { FLUSH(s); EpiRes e{H0F, PRE1}; hipLaunchKernelGGL((naive_gemm<bf16_t, float, false, false, EpiRes>), dim3(D / 64, T / 64, 1), dim3(256), 0, stream, MB, (size_t)D, (size_t)0, wo, (size_t)D, (size_t)0, (const float*)nullptr, T, (const unsigned*)nullptr, D, D, e); } break;
        case 7: if (!(FAST & F_LN1)) { FLUSH(s); hipLaunchKernelGGL(k_ln1_router, dim3(T / 4), dim3(256), 0, stream, PRE1, l1g, l1b, wr, br, H1F, XROWS, DEST, GATE, ctl); } break;
        case 8: if (!(FAST & F_UP)) { FLUSH(s); EpiUp e{bup, ACT}; hipLaunchKernelGGL((naive_gemm<bf16_t, float, false, true, EpiUp>), dim3(2048 / 64, CAP / 64, NE), dim3(256), 0, stream, XROWS, (size_t)D, (size_t)CAP * D, wup, (size_t)4096, (size_t)D * 4096, wup + 2048, CAP, (const unsigned*)(ctl + CW_CNT), 2048, D, e); } break;
        case 9: if (!(FAST & F_DOWN)) { FLUSH(s); EpiDown e{bdn, YROWS}; hipLaunchKernelGGL((naive_gemm<bf16_t, float, false, false, EpiDown>), dim3(2048 / 64, CAP / 64, NE), dim3(256), 0, stream, ACT, (size_t)D, (size_t)CAP * D, wdn, (size_t)D, (size_t)D * D, (const float*)nullptr, CAP, (const unsigned*)(ctl + CW_CNT), D, D, e); } break;
        case 10: if (!(FAST & F_LN2)) { FLUSH(s); hipLaunchKernelGGL(k_combine_ln2, dim3(T / 4), dim3(256), 0, stream, H1F, YROWS, DEST, GATE, l2g, l2b, H2F, H2B); } break;
        case 11: if (!(FAST & F_PLE)) { FLUSH(s); { EpiF32 e{PP}; hipLaunchKernelGGL((naive_gemm<bf16_t, float, false, false, EpiF32>), dim3(D / 64, T / 64, 1), dim3(256), 0, stream, PB, (size_t)PLE, (size_t)0, wpp, (size_t)D, (size_t)0, (const float*)nullptr, T, (const unsigned*)nullptr, D, PLE, e); }
                     { EpiPle e{H2F, PP, PRE3}; hipLaunchKernelGGL((naive_gemm<bf16_t, float, false, false, EpiPle>), dim3(D / 64, T / 64, 1), dim3(256), 0, stream, H2B, (size_t)D, (size_t)0, wpg, (size_t)D, (size_t)0, (const float*)nullptr, T, (const unsigned*)nullptr, D, D, e); } } break;
        case 12: if (!(FAST & F_LN3)) { FLUSH(s); hipLaunchKernelGGL(k_ln_out, dim3(T / 4), dim3(256), 0, stream, PRE3, l3g, l3b, out); } break;
        }
        if (FAST & stage_flags[s]) { if (pend_lo < 0) pend_lo = s; } else { FLUSH(s); }
    }
    FLUSH(13);
#ifdef PROBE_LO
    { a.ph_lo = PROBE_LO; a.ph_hi = PROBE_HI; a.li = li++; hipLaunchKernelGGL(mega, dim3(grid), dim3(NTHR), LDS_BYTES, stream, a); }
#endif
#undef FLUSH
}
```
